# Optimizing an MI355X kernel written in HIP

```python
import math
import jax, jax.numpy as jnp
from jax import lax
import numpy as np

D_MODEL = 1024
BATCH = 2
SEQ = 8192
DEPTH = 1
DEC_BATCH = 8
DEC_SEQ = 32
PAST_LEN = 1024

CHUNK = 64
N_PREV_CHUNKS = 8
BAND_CHUNKS = N_PREV_CHUNKS + 1
MIX_WIDTH = D_MODEL
A_WIDTH = MIX_WIDTH // 2
A_HEAD_DIM = 64
A_HEADS = A_WIDTH // A_HEAD_DIM
MAX_REL = 128
N_REL = 2 * MAX_REL + 1
B_WIDTH = MIX_WIDTH - A_WIDTH
B_HEAD_DIM = 64
B_HEADS = B_WIDTH // (2 * B_HEAD_DIM)
B_V_DIM = 2 * B_HEAD_DIM
ROPE_THETA = 500000.0
ROPE_DIM = B_HEAD_DIM // 4
EPS = 1e-6
Q_BLOCK = 128
IN_COLS = 4 * A_WIDTH + 4 * B_WIDTH
IN_SPLITS = tuple(int(v) for v in np.cumsum([A_WIDTH] * 4 + [B_WIDTH] * 4)[:-1])

kernel_name = "hybrid_chunkband_diffattn_stream_step"


def rmsnorm(x, g):
    xf = x.astype(jnp.float32)
    y = xf * lax.rsqrt(jnp.mean(xf * xf, axis=-1, keepdims=True) + EPS)
    return (y * g.astype(jnp.float32)).astype(x.dtype)


def partial_rope(x, pos):
    half = ROPE_DIM // 2
    inv = ROPE_THETA ** (-jnp.arange(0, ROPE_DIM, 2, dtype=jnp.float32) / ROPE_DIM)
    ang = pos.astype(jnp.float32)[:, None] * inv[None, :]
    cos = jnp.cos(ang)[:, None, None, :]
    sin = jnp.sin(ang)[:, None, None, :]
    xr = x[..., :ROPE_DIM].astype(jnp.float32)
    x1, x2 = xr[..., :half], xr[..., half:]
    rot = jnp.concatenate([x1 * cos - x2 * sin, x2 * cos + x1 * sin], axis=-1)
    return jnp.concatenate([rot.astype(x.dtype), x[..., ROPE_DIM:]], axis=-1)


def split_proj(h, w_in):
    z = jnp.einsum('bsd,dc->bsc', h, w_in)
    b, s, _ = z.shape
    qa, ka, va, ga, qb, kb, vb, gb = jnp.split(z, IN_SPLITS, axis=-1)
    qa = qa.reshape(b, s, A_HEADS, A_HEAD_DIM)
    ka = ka.reshape(b, s, A_HEADS, A_HEAD_DIM)
    va = va.reshape(b, s, A_HEADS, A_HEAD_DIM)
    qb = qb.reshape(b, s, B_HEADS, 2, B_HEAD_DIM)
    kb = kb.reshape(b, s, B_HEADS, 2, B_HEAD_DIM)
    vb = vb.reshape(b, s, B_HEADS, B_V_DIM)
    return qa, ka, va, ga, qb, kb, vb, gb


def rel_index(rel):
    return jnp.clip(rel, -MAX_REL, MAX_REL) + MAX_REL


def band_attention_prompt(q, k, v, rel_bias):
    b, s, h, d = q.shape
    nc = s // CHUNK
    pad = N_PREV_CHUNKS * CHUNK
    kp = jnp.pad(k, ((0, 0), (pad, 0), (0, 0), (0, 0))).reshape(b, nc + N_PREV_CHUNKS, CHUNK, h, d)
    vp = jnp.pad(v, ((0, 0), (pad, 0), (0, 0), (0, 0))).reshape(b, nc + N_PREV_CHUNKS, CHUNK, h, d)
    kband = jnp.concatenate([kp[:, j:j + nc] for j in range(BAND_CHUNKS)], axis=2)
    vband = jnp.concatenate([vp[:, j:j + nc] for j in range(BAND_CHUNKS)], axis=2)
    qc = q.reshape(b, nc, CHUNK, h, d)
    scores = jnp.einsum('bcqhd,bckhd->bchqk', qc, kband,
                        preferred_element_type=jnp.float32) * (d ** -0.5)
    band_len = BAND_CHUNKS * CHUNK
    i = jnp.arange(CHUNK)
    j = jnp.arange(band_len)
    rel = i[:, None] - j[None, :] + pad
    bias = rel_bias.astype(jnp.float32)[:, rel_index(rel)]
    k_pos = jnp.arange(nc)[:, None] * CHUNK - pad + j[None, :]
    valid = (k_pos >= 0)[None, :, None, None, :]
    scores = jnp.where(valid, scores + bias[None, None], -jnp.inf)
    p = jax.nn.softmax(scores, axis=-1)
    out = jnp.einsum('bchqk,bckhd->bcqhd', p.astype(v.dtype), vband)
    return out.reshape(b, s, h * d)


def band_attention_sample(q, k_new, v_new, k_cache, v_cache, rel_bias):
    b, t, h, d = q.shape
    L = k_cache.shape[1]
    keys = jnp.concatenate([k_cache.astype(k_new.dtype), k_new], axis=1)
    vals = jnp.concatenate([v_cache.astype(v_new.dtype), v_new], axis=1)
    scores = jnp.einsum('bqhd,bkhd->bhqk', q, keys,
                        preferred_element_type=jnp.float32) * (d ** -0.5)
    rel = (L + jnp.arange(t))[:, None] - jnp.arange(L + t)[None, :]
    bias = rel_bias.astype(jnp.float32)[:, rel_index(rel)]
    p = jax.nn.softmax(scores + bias[None], axis=-1)
    out = jnp.einsum('bhqk,bkhd->bqhd', p.astype(vals.dtype), vals).reshape(b, t, h * d)
    return out, keys[:, -L:], vals[:, -L:]


def diff_lambda(lq1, lk1, lq2, lk2, lambda_init):
    f32 = lambda a: a.astype(jnp.float32)
    return (jnp.exp(jnp.sum(f32(lq1) * f32(lk1))) - jnp.exp(jnp.sum(f32(lq2) * f32(lk2)))
            + lambda_init)


def diff_core(q, k, v, mask, lam):
    d = q.shape[-1]
    scores = jnp.einsum('bqhmd,bkhmd->bhmqk', q, k,
                        preferred_element_type=jnp.float32) * (d ** -0.5)
    scores = jnp.where(mask, scores, -jnp.inf)
    p = jax.nn.softmax(scores, axis=-1)
    attn = p[:, :, 0] - lam * p[:, :, 1]
    return jnp.einsum('bhqk,bkhe->bqhe', attn.astype(v.dtype), v)


def diff_attention_prompt(q, k, v, lam):
    b, s, h, _, d = q.shape
    nblk = s // Q_BLOCK
    qblocks = q.reshape(b, nblk, Q_BLOCK, h, 2, d).transpose(1, 0, 2, 3, 4, 5)
    k_chunk = jnp.arange(s) // CHUNK

    def one_block(args):
        qblk, idx = args
        q_chunk = (idx * Q_BLOCK + jnp.arange(Q_BLOCK)) // CHUNK
        mask = k_chunk[None, :] <= q_chunk[:, None]
        return diff_core(qblk, k, v, mask, lam)

    out = lax.map(one_block, (qblocks, jnp.arange(nblk)))
    return out.transpose(1, 0, 2, 3, 4).reshape(b, s, h, v.shape[-1])


def diff_attention_sample(q, k_new, v_new, k_cache, v_cache, lam):
    t = q.shape[1]
    keys = jnp.concatenate([k_cache.astype(k_new.dtype), k_new], axis=1)
    vals = jnp.concatenate([v_cache.astype(v_new.dtype), v_new], axis=1)
    mask = jnp.ones((t, keys.shape[1]), dtype=bool)
    return diff_core(q, keys, vals, mask, lam)


def diff_subnorm(o, g, lambda_init):
    b, s = o.shape[0], o.shape[1]
    return (rmsnorm(o, g) * (1.0 - lambda_init)).reshape(b, s, B_WIDTH)


def merge_out(oa, ga, ob, gb, w_out):
    o = jnp.concatenate([oa * jax.nn.silu(ga), ob * jax.nn.silu(gb)], axis=-1)
    return jnp.einsum('bsc,cd->bsd', o, w_out)


def setup_inputs(seed: int = 0) -> dict:
    key = jax.random.key(seed)
    ks = jax.random.split(key, 17)
    a_keep = min(N_PREV_CHUNKS * CHUNK, PAST_LEN)
    nrm = lambda k, shape, sc: jax.random.normal(k, shape, jnp.float32) * sc
    return {
        'x_prompt': nrm(ks[0], (BATCH, SEQ, D_MODEL), 1.0),
        'x_sample': nrm(ks[1], (DEC_BATCH, DEC_SEQ, D_MODEL), 1.0),
        'cache_a_k': nrm(ks[2], (DEPTH, DEC_BATCH, a_keep, A_HEADS, A_HEAD_DIM), 1.0),
        'cache_a_v': nrm(ks[3], (DEPTH, DEC_BATCH, a_keep, A_HEADS, A_HEAD_DIM), 1.0),
        'cache_b_k': nrm(ks[4], (DEPTH, DEC_BATCH, PAST_LEN, B_HEADS, 2, B_HEAD_DIM), 1.0),
        'cache_b_v': nrm(ks[5], (DEPTH, DEC_BATCH, PAST_LEN, B_HEADS, B_V_DIM), 1.0),
        'norm_gain': 1.0 + nrm(ks[6], (DEPTH, D_MODEL), 0.05),
        'w_in': nrm(ks[7], (DEPTH, D_MODEL, IN_COLS), D_MODEL ** -0.5),
        'w_out': nrm(ks[8], (DEPTH, MIX_WIDTH, D_MODEL), MIX_WIDTH ** -0.5),
        'rel_bias': nrm(ks[9], (DEPTH, A_HEADS, N_REL), 0.1),
        'lambda_q1': nrm(ks[10], (DEPTH, B_HEAD_DIM), 0.1),
        'lambda_k1': nrm(ks[11], (DEPTH, B_HEAD_DIM), 0.1),
        'lambda_q2': nrm(ks[12], (DEPTH, B_HEAD_DIM), 0.1),
        'lambda_k2': nrm(ks[13], (DEPTH, B_HEAD_DIM), 0.1),
        'subln_gain': 1.0 + nrm(ks[14], (DEPTH, B_V_DIM), 0.05),
        'final_gain': 1.0 + nrm(ks[15], (D_MODEL,), 0.05),
    }


def reference(x_prompt, x_sample, cache_a_k, cache_a_v, cache_b_k, cache_b_v,
              norm_gain, w_in, w_out, rel_bias, lambda_q1, lambda_k1, lambda_q2, lambda_k2,
              subln_gain, final_gain):
    s_prompt = x_prompt.shape[1]
    t_sample = x_sample.shape[1]
    past_len = cache_b_k.shape[2]
    a_keep_prompt = min(N_PREV_CHUNKS * CHUNK, s_prompt)
    pos_prompt = jnp.arange(s_prompt)
    pos_sample = past_len + jnp.arange(t_sample)
    yp, ys = x_prompt, x_sample
    akp, avp, bkp, bvp, aks, avs, bks, bvs = [], [], [], [], [], [], [], []
    for l in range(DEPTH):
        lambda_init = 0.8 - 0.6 * math.exp(-0.3 * l)
        lam = diff_lambda(lambda_q1[l], lambda_k1[l], lambda_q2[l], lambda_k2[l], lambda_init)
        h = rmsnorm(yp, norm_gain[l])
        qa, ka, va, ga, qb, kb, vb, gb = split_proj(h, w_in[l])
        qb = partial_rope(qb, pos_prompt)
        kb = partial_rope(kb, pos_prompt)
        oa = band_attention_prompt(qa, ka, va, rel_bias[l])
        ob = diff_subnorm(diff_attention_prompt(qb, kb, vb, lam), subln_gain[l], lambda_init)
        yp = yp + merge_out(oa, ga, ob, gb, w_out[l])
        akp.append(ka[:, s_prompt - a_keep_prompt:])
        avp.append(va[:, s_prompt - a_keep_prompt:])
        bkp.append(kb)
        bvp.append(vb)
        h = rmsnorm(ys, norm_gain[l])
        qa, ka, va, ga, qb, kb, vb, gb = split_proj(h, w_in[l])
        qb = partial_rope(qb, pos_sample)
        kb = partial_rope(kb, pos_sample)
        oa, ka_buf, va_buf = band_attention_sample(qa, ka, va, cache_a_k[l], cache_a_v[l], rel_bias[l])
        ob = diff_subnorm(diff_attention_sample(qb, kb, vb, cache_b_k[l], cache_b_v[l], lam),
                          subln_gain[l], lambda_init)
        ys = ys + merge_out(oa, ga, ob, gb, w_out[l])
        aks.append(ka_buf)
        avs.append(va_buf)
        bks.append(kb)
        bvs.append(vb)
    y_prompt = rmsnorm(yp, final_gain)
    y_sample = rmsnorm(ys, final_gain)
    return (y_prompt, y_sample,
            jnp.stack(akp), jnp.stack(avp), jnp.stack(bkp), jnp.stack(bvp),
            jnp.stack(aks), jnp.stack(avs), jnp.stack(bks), jnp.stack(bvs))
```

```cpp
#include <hip/hip_runtime.h>
#include <hip/hip_cooperative_groups.h>
#include <cstdio>
namespace cg = cooperative_groups;

typedef short bf16x8 __attribute__((ext_vector_type(8)));
typedef float f32x16 __attribute__((ext_vector_type(16)));
typedef __bf16 bf2_t __attribute__((ext_vector_type(2)));
typedef float f2_t __attribute__((ext_vector_type(2)));
typedef unsigned u32;
typedef unsigned short u16;
#define DI __device__ __forceinline__
#define MFMA(a, b, c) __builtin_amdgcn_mfma_f32_32x32x16_bf16((a), (b), (c), 0, 0, 0)

constexpr int NTOKP = 16384;
constexpr int NTOK = 16640;
constexpr int SEQ = 8192;
constexpr size_t O_YP = 0;
constexpr size_t O_AKP = 17039360, O_AVP = 17563648, O_BKP = 18087936, O_BVP = 26476544;
constexpr size_t O_AKS = 34865152, O_AVS = 36962304, O_BKS = 39059456, O_BVS = 39190528;
constexpr size_t WS_WINT = 0;
constexpr size_t WS_WOUTT = WS_WINT + 8388608;
constexpr size_t WS_HN = WS_WOUTT + 2097152;
constexpr size_t WS_QA = WS_HN + 34078720;
constexpr size_t WS_KA = WS_QA + 17039360;
constexpr size_t WS_KAS = WS_KA + 16777216;
constexpr size_t WS_VAT = WS_KAS + 4456448;
constexpr size_t WS_VATS = WS_VAT + 16777216;
constexpr size_t WS_GA = WS_VATS + 4456448;
constexpr size_t WS_QB = WS_GA + 17039360;
constexpr size_t WS_KB = WS_QB + 17039360;
constexpr size_t WS_KBS = WS_KB + 16777216;
constexpr size_t WS_VBT = WS_KBS + 8650752;
constexpr size_t WS_VBTS = WS_VBT + 16777216;
constexpr size_t WS_GB = WS_VBTS + 8650752;
constexpr size_t WS_ROPE = WS_GB + 17039360;
constexpr size_t WS_END = WS_ROPE + 524288;

struct Params {
  const float* x_prompt; const float* x_sample;
  const float* cache_a_k; const float* cache_a_v; const float* cache_b_k; const float* cache_b_v;
  const float* norm_gain; const float* w_in; const float* w_out; const float* rel_bias;
  const float* lq1; const float* lk1; const float* lq2; const float* lk2;
  const float* subln; const float* final_gain;
  float* out; char* ws;
};

DI u32 pk2(float a, float b) { f2_t v = {a, b}; bf2_t r = __builtin_convertvector(v, bf2_t); return __builtin_bit_cast(u32, r); }
DI float bflo(u32 v) { return __uint_as_float(v << 16); }
DI float bfhi(u32 v) { return __uint_as_float(v & 0xffff0000u); }
DI int rho(int r) { return (r & ~12) | ((r & 4) << 1) | ((r & 8) >> 1); }
DI float wave_sum(float v) {
#pragma unroll
  for (int o = 32; o > 0; o >>= 1) v += __shfl_xor(v, o);
  return v;
}

DI void phase0(const Params& p, char* lds) {
  const int tid = threadIdx.x, bid = blockIdx.x, nb = gridDim.x;
  const int lane = tid & 63, w = tid >> 6;
  float* tile = (float*)lds;
  for (int t = bid; t < 1280; t += nb) {
    const float* W; u16* WT; int N, kt, nt;
    if (t < 1024) { W = p.w_in; WT = (u16*)(p.ws + WS_WINT); N = 4096; kt = t >> 6; nt = t & 63; }
    else { int t2 = t - 1024; W = p.w_out; WT = (u16*)(p.ws + WS_WOUTT); N = 1024; kt = t2 >> 4; nt = t2 & 15; }
#pragma unroll
    for (int it = 0; it < 8; ++it) {
      int idx = it * 512 + tid, kk = idx >> 6, nn = idx & 63;
      tile[kk * 65 + nn] = W[(size_t)(kt * 64 + kk) * N + nt * 64 + nn];
    }
    __syncthreads();
    {
      int n = tid >> 3, kg = tid & 7;
      float v[8];
#pragma unroll
      for (int j = 0; j < 8; ++j) v[j] = tile[(kg * 8 + j) * 65 + n];
      uint4 o; o.x = pk2(v[0], v[1]); o.y = pk2(v[2], v[3]); o.z = pk2(v[4], v[5]); o.w = pk2(v[6], v[7]);
      *(uint4*)(WT + (size_t)(nt * 64 + n) * 1024 + kt * 64 + kg * 8) = o;
    }
    __syncthreads();
  }
  {
    u16* HN = (u16*)(p.ws + WS_HN);
    for (int row = bid * 8 + w; row < NTOK; row += nb * 8) {
      const float* src = row < NTOKP ? p.x_prompt + (size_t)row * 1024 : p.x_sample + (size_t)(row - NTOKP) * 1024;
      float4 v[4]; float ss = 0.f;
#pragma unroll
      for (int it = 0; it < 4; ++it) { v[it] = *(const float4*)(src + it * 256 + lane * 4); ss += v[it].x * v[it].x + v[it].y * v[it].y + v[it].z * v[it].z + v[it].w * v[it].w; }
      ss = wave_sum(ss);
      float inv = rsqrtf(ss * (1.f / 1024.f) + 1e-6f);
#pragma unroll
      for (int it = 0; it < 4; ++it) {
        float4 g = *(const float4*)(p.norm_gain + it * 256 + lane * 4);
        uint2 o; o.x = pk2(v[it].x * inv * g.x, v[it].y * inv * g.y); o.y = pk2(v[it].z * inv * g.z, v[it].w * inv * g.w);
        *(uint2*)(HN + (size_t)row * 1024 + it * 256 + lane * 4) = o;
      }
    }
  }
  const int gt = bid * 512 + tid, gn = nb * 512;
  {
    u16* KAS = (u16*)(p.ws + WS_KAS);
    for (int i = gt; i < 524288; i += gn) {
      int e = i * 4, b = e >> 18, key = (e >> 9) & 511, f = e & 511;
      float4 v = *(const float4*)(p.cache_a_k + e);
      uint2 o; o.x = pk2(v.x, v.y); o.y = pk2(v.z, v.w);
      *(uint2*)(KAS + (size_t)(b * 544 + key) * 512 + f) = o;
      if (key >= 32) *(float4*)(p.out + O_AKS + (size_t)(b * 512 + key - 32) * 512 + f) = v;
    }
    u16* KBS = (u16*)(p.ws + WS_KBS);
    for (int i = gt; i < 1048576; i += gn) {
      int e = i * 4, b = e >> 19, key = (e >> 9) & 1023, f = e & 511;
      float4 v = *(const float4*)(p.cache_b_k + e);
      uint2 o; o.x = pk2(v.x, v.y); o.y = pk2(v.z, v.w);
      *(uint2*)(KBS + (size_t)(b * 1056 + key) * 512 + f) = o;
    }
    u16* VATS = (u16*)(p.ws + WS_VATS);
    for (int i = gt; i < 262144; i += gn) {
      int f = i & 511, kg = (i >> 9) & 63, b = i >> 15;
      float v[8];
#pragma unroll
      for (int j = 0; j < 8; ++j) v[j] = p.cache_a_v[(size_t)(b * 512 + kg * 8 + j) * 512 + f];
      uint4 o; o.x = pk2(v[0], v[1]); o.y = pk2(v[2], v[3]); o.z = pk2(v[4], v[5]); o.w = pk2(v[6], v[7]);
      *(uint4*)(VATS + (size_t)(b * 512 + f) * 544 + kg * 8) = o;
      if (kg >= 4) {
#pragma unroll
        for (int j = 0; j < 8; ++j) p.out[O_AVS + (size_t)(b * 512 + kg * 8 + j - 32) * 512 + f] = v[j];
      }
    }
    u16* VBTS = (u16*)(p.ws + WS_VBTS);
    for (int i = gt; i < 524288; i += gn) {
      int f = i & 511, kg = (i >> 9) & 127, b = i >> 16;
      float v[8];
#pragma unroll
      for (int j = 0; j < 8; ++j) v[j] = p.cache_b_v[(size_t)(b * 1024 + kg * 8 + j) * 512 + f];
      uint4 o; o.x = pk2(v[0], v[1]); o.y = pk2(v[2], v[3]); o.z = pk2(v[4], v[5]); o.w = pk2(v[6], v[7]);
      *(uint4*)(VBTS + (size_t)(b * 512 + f) * 1056 + kg * 8) = o;
    }
  }
  {
    float2* RT = (float2*)(p.ws + WS_ROPE);
    for (int i = gt; i < 65536; i += gn) {
      int pos = i >> 3, m = i & 7;
      float inv = powf(500000.f, -(float)m * 0.125f);
      float ang = (float)pos * inv;
      RT[i] = make_float2(cosf(ang), sinf(ang));
    }
  }
}

template <bool SWAP>
DI void gemm_mainloop(const u16* __restrict__ A, const u16* __restrict__ Bt, int tm, int tn, char* lds, f32x16 (&acc)[2][2]) {
  const int tid = threadIdx.x, lane = tid & 63, w = tid >> 6, wm = w >> 1, wn = w & 1;
  const int r = lane & 31, h = lane >> 5;
  const u16* pa = A + (size_t)(tm * 256 + (tid >> 3)) * 1024 + (tid & 7) * 8;
  const u16* pb = Bt + (size_t)(tn * 128 + (tid >> 3)) * 1024 + (tid & 7) * 8;
  const int wofs = (tid >> 3) * 128 + ((((tid & 7) ^ ((tid >> 4) & 7))) << 4);
  const int swr = (r >> 1) & 7;
  uint4 ra[4], rb[2];
#pragma unroll
  for (int i = 0; i < 2; ++i)
#pragma unroll
    for (int j = 0; j < 2; ++j)
#pragma unroll
      for (int e = 0; e < 16; ++e) acc[i][j][e] = 0.f;
#pragma unroll
  for (int it = 0; it < 4; ++it) ra[it] = *(const uint4*)(pa + (size_t)it * 65536);
#pragma unroll
  for (int it = 0; it < 2; ++it) rb[it] = *(const uint4*)(pb + (size_t)it * 65536);
#pragma unroll
  for (int it = 0; it < 4; ++it) *(uint4*)(lds + it * 8192 + wofs) = ra[it];
#pragma unroll
  for (int it = 0; it < 2; ++it) *(uint4*)(lds + 32768 + it * 8192 + wofs) = rb[it];
  __syncthreads();
  for (int kt = 0; kt < 16; ++kt) {
    if (kt + 1 < 16) {
#pragma unroll
      for (int it = 0; it < 4; ++it) ra[it] = *(const uint4*)(pa + (size_t)it * 65536 + (kt + 1) * 64);
#pragma unroll
      for (int it = 0; it < 2; ++it) rb[it] = *(const uint4*)(pb + (size_t)it * 65536 + (kt + 1) * 64);
    }
    const char* ba = lds + (kt & 1) * 49152;
    const char* bb = ba + 32768;
#pragma unroll
    for (int s = 0; s < 4; ++s) {
      const int co = (((2 * s + h) ^ swr) << 4);
      bf16x8 hf[2], wf[2];
#pragma unroll
      for (int i = 0; i < 2; ++i) hf[i] = *(const bf16x8*)(ba + (wm * 64 + i * 32 + r) * 128 + co);
#pragma unroll
      for (int j = 0; j < 2; ++j) wf[j] = *(const bf16x8*)(bb + (wn * 64 + j * 32 + r) * 128 + co);
#pragma unroll
      for (int i = 0; i < 2; ++i)
#pragma unroll
        for (int j = 0; j < 2; ++j) {
          if (SWAP) acc[j][i] = MFMA(wf[j], hf[i], acc[j][i]);
          else acc[i][j] = MFMA(hf[i], wf[j], acc[i][j]);
        }
    }
    if (kt + 1 < 16) {
      char* bw = lds + ((kt + 1) & 1) * 49152;
#pragma unroll
      for (int it = 0; it < 4; ++it) *(uint4*)(bw + it * 8192 + wofs) = ra[it];
#pragma unroll
      for (int it = 0; it < 2; ++it) *(uint4*)(bw + 32768 + it * 8192 + wofs) = rb[it];
    }
    __syncthreads();
  }
}

DI float silu(float x) { return x / (1.f + __expf(-x)); }

DI void phase1(const Params& p, char* lds) {
  const int tid = threadIdx.x, lane = tid & 63, w = tid >> 6, wm = w >> 1, wn = w & 1;
  const int r = lane & 31, h = lane >> 5;
  const u16* HN = (const u16*)(p.ws + WS_HN);
  const u16* WT = (const u16*)(p.ws + WS_WINT);
  const float2* RT = (const float2*)(p.ws + WS_ROPE);
  for (int tile = blockIdx.x; tile < 65 * 32; tile += gridDim.x) {
    const int tm = tile >> 5, tn = tile & 31;
    const int sec = tn >> 2;
    const bool sample = (tm == 64);
    f32x16 acc[2][2];
    if (sec == 2 || sec == 6) {
      gemm_mainloop<false>(HN, WT, tm, tn, lds, acc);
      u16* VT; size_t ldv; size_t o32;
      if (sec == 2) { VT = (u16*)(p.ws + (sample ? WS_VATS : WS_VAT)); ldv = sample ? 544 : 8192; }
      else { VT = (u16*)(p.ws + (sample ? WS_VBTS : WS_VBT)); ldv = sample ? 1056 : 8192; }
#pragma unroll
      for (int i = 0; i < 2; ++i)
#pragma unroll
        for (int j = 0; j < 2; ++j) {
          const int fs = (tn & 3) * 128 + wn * 64 + j * 32 + r;
#pragma unroll
          for (int g = 0; g < 4; ++g) {
            const int t = tm * 256 + wm * 64 + i * 32 + 8 * g + 4 * h;
            float v0 = acc[i][j][4 * g], v1 = acc[i][j][4 * g + 1], v2 = acc[i][j][4 * g + 2], v3 = acc[i][j][4 * g + 3];
            uint2 o; o.x = pk2(v0, v1); o.y = pk2(v2, v3);
            if (!sample) {
              const int b = t >> 13, s = t & 8191;
              *(uint2*)(VT + ((size_t)(b * 512 + fs)) * ldv + s) = o;
              if (sec == 2) {
                if (s >= 7680) {
                  float* d = p.out + O_AVP + ((size_t)(b * 512 + s - 7680)) * 512 + fs;
                  d[0] = v0; d[512] = v1; d[1024] = v2; d[1536] = v3;
                }
              } else {
                float* d = p.out + O_BVP + (size_t)t * 512 + fs;
                d[0] = v0; d[512] = v1; d[1024] = v2; d[1536] = v3;
              }
            } else {
              const int ts = t - NTOKP, b = ts >> 5, tt = ts & 31;
              if (sec == 2) {
                *(uint2*)(VT + ((size_t)(b * 512 + fs)) * ldv + 512 + tt) = o;
                float* d = p.out + O_AVS + ((size_t)(b * 512 + 480 + tt)) * 512 + fs;
                d[0] = v0; d[512] = v1; d[1024] = v2; d[1536] = v3;
              } else {
                *(uint2*)(VT + ((size_t)(b * 512 + fs)) * ldv + 1024 + tt) = o;
                float* d = p.out + O_BVS + (size_t)ts * 512 + fs;
                d[0] = v0; d[512] = v1; d[1024] = v2; d[1536] = v3;
              }
            }
          }
        }
    } else {
      gemm_mainloop<true>(HN, WT, tm, tn, lds, acc);
#pragma unroll
      for (int i = 0; i < 2; ++i) {
        const int t = tm * 256 + wm * 64 + i * 32 + r;
        const int ts = t - NTOKP, sb = ts >> 5, stt = ts & 31;
        const int pos = sample ? (1024 + stt) : (t & 8191);
        if (sec == 4 || sec == 5) {
#pragma unroll
          for (int e = 0; e < 4; ++e) {
            float2 cs = RT[pos * 8 + 4 * h + e];
            float x1 = acc[0][i][e], x2 = acc[0][i][4 + e];
            acc[0][i][e] = x1 * cs.x - x2 * cs.y;
            acc[0][i][4 + e] = x2 * cs.x + x1 * cs.y;
          }
        }
#pragma unroll
        for (int j = 0; j < 2; ++j)
#pragma unroll
          for (int g = 0; g < 4; ++g) {
            const int fs = (tn & 3) * 128 + wn * 64 + j * 32 + 8 * g + 4 * h;
            float v0 = acc[j][i][4 * g], v1 = acc[j][i][4 * g + 1], v2 = acc[j][i][4 * g + 2], v3 = acc[j][i][4 * g + 3];
            if (sec == 3 || sec == 7) { v0 = silu(v0); v1 = silu(v1); v2 = silu(v2); v3 = silu(v3); }
            uint2 o; o.x = pk2(v0, v1); o.y = pk2(v2, v3);
            const float4 vf = make_float4(v0, v1, v2, v3);
            if (sec == 0) *(uint2*)((u16*)(p.ws + WS_QA) + (size_t)t * 512 + fs) = o;
            else if (sec == 3) *(uint2*)((u16*)(p.ws + WS_GA) + (size_t)t * 512 + fs) = o;
            else if (sec == 4) *(uint2*)((u16*)(p.ws + WS_QB) + (size_t)t * 512 + fs) = o;
            else if (sec == 7) *(uint2*)((u16*)(p.ws + WS_GB) + (size_t)t * 512 + fs) = o;
            else if (sec == 1) {
              if (!sample) {
                *(uint2*)((u16*)(p.ws + WS_KA) + (size_t)t * 512 + fs) = o;
                const int b = t >> 13, s = t & 8191;
                if (s >= 7680) *(float4*)(p.out + O_AKP + ((size_t)(b * 512 + s - 7680)) * 512 + fs) = vf;
              } else {
                *(uint2*)((u16*)(p.ws + WS_KAS) + ((size_t)(sb * 544 + 512 + stt)) * 512 + fs) = o;
                *(float4*)(p.out + O_AKS + ((size_t)(sb * 512 + 480 + stt)) * 512 + fs) = vf;
              }
            } else {
              if (!sample) {
                *(uint2*)((u16*)(p.ws + WS_KB) + (size_t)t * 512 + fs) = o;
                *(float4*)(p.out + O_BKP + (size_t)t * 512 + fs) = vf;
              } else {
                *(uint2*)((u16*)(p.ws + WS_KBS) + ((size_t)(sb * 1056 + 1024 + stt)) * 512 + fs) = o;
                *(float4*)(p.out + O_BKS + (size_t)ts * 512 + fs) = vf;
              }
            }
          }
      }
    }
  }
}

constexpr float SM_C = 0.125f * 1.4426950408889634f;
template <int NQT, int DVT, bool BIAS>
DI void attn_wave(const u16* __restrict__ Q, int ldq, const u16* __restrict__ K, int ldk,
                  const u16* __restrict__ Vt, int ldv, int nkt, const float* bias_l2, int rel0,
                  f32x16 (&O)[NQT][DVT], float (&Mx)[NQT], float (&L)[NQT]) {
  const int lane = threadIdx.x & 63, r = lane & 31, h = lane >> 5;
  bf16x8 qf[NQT][4];
#pragma unroll
  for (int u = 0; u < NQT; ++u)
#pragma unroll
    for (int s = 0; s < 4; ++s) qf[u][s] = *(const bf16x8*)(Q + (size_t)(32 * u + r) * ldq + 16 * s + 8 * h);
#pragma unroll
  for (int u = 0; u < NQT; ++u) {
    Mx[u] = -INFINITY; L[u] = 0.f;
#pragma unroll
    for (int dt = 0; dt < DVT; ++dt)
#pragma unroll
      for (int e = 0; e < 16; ++e) O[u][dt][e] = 0.f;
  }
  const u16* kp = K + (size_t)rho(r) * ldk + 8 * h;
  const u16* vp = Vt + (size_t)r * ldv + 8 * h;
  bf16x8 kf[4];
#pragma unroll
  for (int s = 0; s < 4; ++s) kf[s] = *(const bf16x8*)(kp + 16 * s);
  for (int kt = 0; kt < nkt; ++kt) {
    bf16x8 vf[DVT][2];
#pragma unroll
    for (int dt = 0; dt < DVT; ++dt)
#pragma unroll
      for (int s2 = 0; s2 < 2; ++s2) vf[dt][s2] = *(const bf16x8*)(vp + (size_t)(32 * dt) * ldv + 32 * kt + 16 * s2);
    bf16x8 kn[4];
    {
      const int ktn = (kt + 1 < nkt) ? kt + 1 : kt;
#pragma unroll
      for (int s = 0; s < 4; ++s) kn[s] = *(const bf16x8*)(kp + (size_t)(32 * ktn) * ldk + 16 * s);
    }
    bf16x8 pf[NQT][2];
#pragma unroll
    for (int u = 0; u < NQT; ++u) {
      f32x16 S;
#pragma unroll
      for (int e = 0; e < 16; ++e) S[e] = 0.f;
#pragma unroll
      for (int s = 0; s < 4; ++s) S = MFMA(kf[s], qf[u][s], S);
      float t[16];
      if (BIAS) {
        const int relb = rel0 + 32 * u + r - 32 * kt - 8 * h;
        if (rel0 - 32 * kt - 31 >= 128) {
          const float bv = bias_l2[256];
#pragma unroll
          for (int e = 0; e < 16; ++e) t[e] = S[e] * SM_C + bv;
        } else {
#pragma unroll
          for (int e = 0; e < 16; ++e) {
            int rel = relb - ((e & 7) + 16 * (e >> 3));
            rel = rel < -128 ? -128 : (rel > 128 ? 128 : rel);
            t[e] = S[e] * SM_C + bias_l2[rel + 128];
          }
        }
      } else {
#pragma unroll
        for (int e = 0; e < 16; ++e) t[e] = S[e] * SM_C;
      }
      float mx = t[0];
#pragma unroll
      for (int e = 1; e < 16; ++e) mx = fmaxf(mx, t[e]);
      mx = fmaxf(mx, __shfl_xor(mx, 32));
      if (__any(mx > Mx[u] + 8.f)) {
        const float mn = fmaxf(Mx[u], mx);
        const float al = __builtin_amdgcn_exp2f(Mx[u] - mn);
        Mx[u] = mn; L[u] *= al;
#pragma unroll
        for (int dt = 0; dt < DVT; ++dt)
#pragma unroll
          for (int e = 0; e < 16; ++e) O[u][dt][e] *= al;
      }
      float ps = 0.f;
#pragma unroll
      for (int e = 0; e < 16; ++e) { t[e] = __builtin_amdgcn_exp2f(t[e] - Mx[u]); ps += t[e]; }
      L[u] += ps;
#pragma unroll
      for (int s2 = 0; s2 < 2; ++s2) {
        uint4 pk;
        pk.x = pk2(t[8 * s2], t[8 * s2 + 1]); pk.y = pk2(t[8 * s2 + 2], t[8 * s2 + 3]);
        pk.z = pk2(t[8 * s2 + 4], t[8 * s2 + 5]); pk.w = pk2(t[8 * s2 + 6], t[8 * s2 + 7]);
        pf[u][s2] = __builtin_bit_cast(bf16x8, pk);
      }
    }
#pragma unroll
    for (int u = 0; u < NQT; ++u)
#pragma unroll
      for (int dt = 0; dt < DVT; ++dt)
#pragma unroll
        for (int s2 = 0; s2 < 2; ++s2) O[u][dt] = MFMA(vf[dt][s2], pf[u][s2], O[u][dt]);
#pragma unroll
    for (int s = 0; s < 4; ++s) kf[s] = kn[s];
  }
#pragma unroll
  for (int u = 0; u < NQT; ++u) L[u] += __shfl_xor(L[u], 32);
}

template <int NQT>
DI void attnA_item(const Params& p, const u16* Q, const u16* K, const u16* Vt, int ldv, int nkt, int rel0,
                   const float* bias_l2, int tok0, int head) {
  f32x16 O[NQT][2]; float Mx[NQT], L[NQT];
  attn_wave<NQT, 2, true>(Q, 512, K, 512, Vt, ldv, nkt, bias_l2, rel0, O, Mx, L);
  const int lane = threadIdx.x & 63, r = lane & 31, h = lane >> 5;
  const u16* GA = (const u16*)(p.ws + WS_GA);
  u16* OB = (u16*)(p.ws + WS_HN);
#pragma unroll
  for (int u = 0; u < NQT; ++u) {
    const float inv = 1.f / L[u];
    const size_t tok = (size_t)(tok0 + 32 * u + r);
#pragma unroll
    for (int dt = 0; dt < 2; ++dt)
#pragma unroll
      for (int g = 0; g < 4; ++g) {
        const int dv = 32 * dt + 8 * g + 4 * h;
        const uint2 gg = *(const uint2*)(GA + tok * 512 + head * 64 + dv);
        uint2 o;
        o.x = pk2(O[u][dt][4 * g] * inv * bflo(gg.x), O[u][dt][4 * g + 1] * inv * bfhi(gg.x));
        o.y = pk2(O[u][dt][4 * g + 2] * inv * bflo(gg.y), O[u][dt][4 * g + 3] * inv * bfhi(gg.y));
        *(uint2*)(OB + tok * 1024 + head * 64 + dv) = o;
      }
  }
}

DI void attnB_item(const Params& p, const u16* Q, const u16* K, const u16* Vt, int ldv, int nkt, int tok0, int hb,
                   float lam, float* xch) {
  const int lane = threadIdx.x & 63, r = lane & 31, h = lane >> 5, w = threadIdx.x >> 6, m = w >> 2, wsub = w & 3;
  f32x16 O[1][4]; float Mx[1], L[1];
  attn_wave<1, 4, false>(Q, 512, K, 512, Vt, ldv, nkt, nullptr, 0, O, Mx, L);
  const float inv = 1.f / L[0];
  float* xw = xch + wsub * 4096 + lane;
  if (m == 1) {
    const float sc = inv * lam;
#pragma unroll
    for (int dt = 0; dt < 4; ++dt)
#pragma unroll
      for (int e = 0; e < 16; ++e) xw[(dt * 16 + e) * 64] = O[0][dt][e] * sc;
  }
  __syncthreads();
  if (m == 0) {
    float ss = 0.f;
#pragma unroll
    for (int dt = 0; dt < 4; ++dt)
#pragma unroll
      for (int e = 0; e < 16; ++e) { float o = O[0][dt][e] * inv - xw[(dt * 16 + e) * 64]; O[0][dt][e] = o; ss += o * o; }
    ss += __shfl_xor(ss, 32);
    const float rn = rsqrtf(ss * (1.f / 128.f) + 1e-6f) * 0.8f;
    const u16* GB = (const u16*)(p.ws + WS_GB);
    u16* OB = (u16*)(p.ws + WS_HN);
    const size_t tok = (size_t)(tok0 + r);
#pragma unroll
    for (int dt = 0; dt < 4; ++dt)
#pragma unroll
      for (int g = 0; g < 4; ++g) {
        const int dv = 32 * dt + 8 * g + 4 * h;
        const uint2 gg = *(const uint2*)(GB + tok * 512 + hb * 128 + dv);
        const float4 sg = *(const float4*)(p.subln + dv);
        uint2 o;
        o.x = pk2(O[0][dt][4 * g] * rn * sg.x * bflo(gg.x), O[0][dt][4 * g + 1] * rn * sg.y * bfhi(gg.x));
        o.y = pk2(O[0][dt][4 * g + 2] * rn * sg.z * bflo(gg.y), O[0][dt][4 * g + 3] * rn * sg.w * bfhi(gg.y));
        *(uint2*)(OB + tok * 1024 + 512 + hb * 128 + dv) = o;
      }
  }
  __syncthreads();
}

DI void phase2(const Params& p, char* lds) {
  const int tid = threadIdx.x, lane = tid & 63, w = tid >> 6;
  float* xch = (float*)lds;
  float* bias = (float*)(lds + 65536);
  for (int i = tid; i < 8 * 257; i += 512) { int hh = i / 257, k = i - hh * 257; bias[hh * 260 + k] = p.rel_bias[i] * 1.4426950408889634f; }
  float lam;
  {
    float a = p.lq1[lane] * p.lk1[lane], b = p.lq2[lane] * p.lk2[lane];
    a = wave_sum(a); b = wave_sum(b);
    lam = expf(a) - expf(b) + 0.2f;
  }
  __syncthreads();
  const u16* QA = (const u16*)(p.ws + WS_QA);
  const u16* QB = (const u16*)(p.ws + WS_QB);
  for (int item = blockIdx.x; item < 256; item += gridDim.x) {
    const int bh = item >> 5, i0 = item & 31, b = bh >> 2, hb = bh & 3;
    const int m = w >> 2, wsub = w & 3;
#pragma unroll 1
    for (int rep = 0; rep < 2; ++rep) {
      const int qt = rep ? 63 - i0 : i0;
      const int q0 = qt * 128 + wsub * 32;
      const int nkt = ((q0 >> 6) + 1) * 2;
      attnB_item(p, QB + (size_t)(b * SEQ + q0) * 512 + hb * 128 + m * 64,
                 (const u16*)(p.ws + WS_KB) + (size_t)(b * SEQ) * 512 + hb * 128 + m * 64,
                 (const u16*)(p.ws + WS_VBT) + (size_t)(b * 512 + hb * 128) * SEQ, SEQ, nkt, b * SEQ + q0, hb, lam, xch);
    }
  }
  for (int it = blockIdx.x; it < 256; it += gridDim.x) {
    const int b = it >> 7, c = it & 127, cs = c > 8 ? c - 8 : 0;
    attnA_item<2>(p, QA + (size_t)(b * SEQ + c * 64) * 512 + w * 64,
                  (const u16*)(p.ws + WS_KA) + (size_t)(b * SEQ + cs * 64) * 512 + w * 64,
                  (const u16*)(p.ws + WS_VAT) + (size_t)(b * 512 + w * 64) * SEQ + cs * 64, SEQ,
                  (c + 1 - cs) * 2, 64 * (c - cs), bias + w * 260, b * SEQ + c * 64, w);
  }
  for (int it = blockIdx.x; it < 8; it += gridDim.x) {
    const int m = w >> 2, wsub = w & 3, id = it * 4 + wsub, b = id >> 2, hb = id & 3;
    attnB_item(p, QB + (size_t)(NTOKP + b * 32) * 512 + hb * 128 + m * 64,
               (const u16*)(p.ws + WS_KBS) + (size_t)(b * 1056) * 512 + hb * 128 + m * 64,
               (const u16*)(p.ws + WS_VBTS) + (size_t)(b * 512 + hb * 128) * 1056, 1056, 33, NTOKP + b * 32, hb, lam, xch);
  }
  for (int it = (int)((blockIdx.x + gridDim.x - 8) % gridDim.x); it < 8; it += gridDim.x) {
    const int b = it;
    attnA_item<1>(p, QA + (size_t)(NTOKP + b * 32) * 512 + w * 64,
                  (const u16*)(p.ws + WS_KAS) + (size_t)(b * 544) * 512 + w * 64,
                  (const u16*)(p.ws + WS_VATS) + (size_t)(b * 512 + w * 64) * 544, 544, 17, 512, bias + w * 260,
                  NTOKP + b * 32, w);
  }
}

DI void phase3(const Params& p, char* lds) {
  const int tid = threadIdx.x, lane = tid & 63, w = tid >> 6, wm = w >> 1, wn = w & 1;
  const int r = lane & 31, h = lane >> 5;
  const u16* OB = (const u16*)(p.ws + WS_HN);
  const u16* WT = (const u16*)(p.ws + WS_WOUTT);
  for (int tile = blockIdx.x; tile < 65 * 8; tile += gridDim.x) {
    const int tm = tile >> 3, tn = tile & 7;
    f32x16 acc[2][2];
    gemm_mainloop<true>(OB, WT, tm, tn, lds, acc);
#pragma unroll
    for (int i = 0; i < 2; ++i) {
      const int t = tm * 256 + wm * 64 + i * 32 + r;
      const float* xr = t < NTOKP ? p.x_prompt + (size_t)t * 1024 : p.x_sample + (size_t)(t - NTOKP) * 1024;
      float* yr = p.out + O_YP + (size_t)t * 1024;
#pragma unroll
      for (int j = 0; j < 2; ++j)
#pragma unroll
        for (int g = 0; g < 4; ++g) {
          const int f = tn * 128 + wn * 64 + j * 32 + 8 * g + 4 * h;
          float4 xv = *(const float4*)(xr + f);
          xv.x += acc[j][i][4 * g]; xv.y += acc[j][i][4 * g + 1]; xv.z += acc[j][i][4 * g + 2]; xv.w += acc[j][i][4 * g + 3];
          *(float4*)(yr + f) = xv;
        }
    }
  }
}

DI void phase4(const Params& p) {
  const int lane = threadIdx.x & 63, w = threadIdx.x >> 6;
  for (int row = blockIdx.x * 8 + w; row < NTOK; row += gridDim.x * 8) {
    float* y = p.out + O_YP + (size_t)row * 1024;
    float4 v[4]; float ss = 0.f;
#pragma unroll
    for (int it = 0; it < 4; ++it) { v[it] = *(const float4*)(y + it * 256 + lane * 4); ss += v[it].x * v[it].x + v[it].y * v[it].y + v[it].z * v[it].z + v[it].w * v[it].w; }
    ss = wave_sum(ss);
    const float inv = rsqrtf(ss * (1.f / 1024.f) + 1e-6f);
#pragma unroll
    for (int it = 0; it < 4; ++it) {
      float4 g = *(const float4*)(p.final_gain + it * 256 + lane * 4);
      *(float4*)(y + it * 256 + lane * 4) = make_float4(v[it].x * inv * g.x, v[it].y * inv * g.y, v[it].z * inv * g.z, v[it].w * inv * g.w);
    }
  }
}

__global__ void __launch_bounds__(512) fwd_megakernel(Params p) {
  __shared__ __attribute__((aligned(16))) char lds[98304];
  cg::grid_group grid = cg::this_grid();
  phase0(p, lds);
  grid.sync();
  phase1(p, lds);
  grid.sync();
  phase2(p, lds);
  grid.sync();
  phase3(p, lds);
  grid.sync();
  phase4(p);
}

extern "C" void kernel_launch(void* const* d_in, const int* in_sizes, int n_in, void* d_out, int out_size, void* d_ws,
                              size_t ws_size, hipStream_t stream) {
  static int grid_blocks = 0;
  if (!grid_blocks) {
    int dev = 0, cus = 0, per_cu = 0;
    hipGetDevice(&dev);
    hipDeviceGetAttribute(&cus, hipDeviceAttributeMultiprocessorCount, dev);
    hipOccupancyMaxActiveBlocksPerMultiprocessor(&per_cu, fwd_megakernel, 512, 0);
    if (per_cu < 1) per_cu = 1;
    grid_blocks = cus;
  }
  Params p{};
  p.x_prompt = (const float*)d_in[0]; p.x_sample = (const float*)d_in[1];
  p.cache_a_k = (const float*)d_in[2]; p.cache_a_v = (const float*)d_in[3];
  p.cache_b_k = (const float*)d_in[4]; p.cache_b_v = (const float*)d_in[5];
  p.norm_gain = (const float*)d_in[6]; p.w_in = (const float*)d_in[7]; p.w_out = (const float*)d_in[8];
  p.rel_bias = (const float*)d_in[9];
  p.lq1 = (const float*)d_in[10]; p.lk1 = (const float*)d_in[11]; p.lq2 = (const float*)d_in[12]; p.lk2 = (const float*)d_in[13];
  p.subln = (const float*)d_in[14]; p.final_gain = (const float*)d_in[15];
  p.out = (float*)d_out; p.ws = (char*)d_ws;
  void* args[] = {&p};
  hipError_t e = hipLaunchCooperativeKernel((void*)fwd_megakernel, dim3(grid_blocks), dim3(512), args, 0, stream);
  if (e != hipSuccess) fprintf(stderr, "cooperative launch failed: %s (grid %d)\n", hipGetErrorString(e), grid_blocks);
}
```

```cpp
#include <hip/hip_runtime.h>
#include <hip/hip_cooperative_groups.h>
#include <cstdio>
namespace cg = cooperative_groups;

typedef short bf16x8 __attribute__((ext_vector_type(8)));
typedef float f32x16 __attribute__((ext_vector_type(16)));
typedef __bf16 bf2_t __attribute__((ext_vector_type(2)));
typedef float f2_t __attribute__((ext_vector_type(2)));
typedef unsigned u32;
typedef unsigned short u16;
#define DI __device__ __forceinline__
#define MFMA(a, b, c) __builtin_amdgcn_mfma_f32_32x32x16_bf16((a), (b), (c), 0, 0, 0)

constexpr int NTOKP = 16384;
constexpr int NTOK = 16640;
constexpr int SEQ = 8192;
constexpr size_t O_YP = 0;
constexpr size_t O_AKP = 17039360, O_AVP = 17563648, O_BKP = 18087936, O_BVP = 26476544;
constexpr size_t O_AKS = 34865152, O_AVS = 36962304, O_BKS = 39059456, O_BVS = 39190528;
constexpr size_t WS_WINT = 0;
constexpr size_t WS_WOUTT = WS_WINT + 8388608;
constexpr size_t WS_HN = WS_WOUTT + 2097152;
constexpr size_t WS_QA = WS_HN + 34078720;
constexpr size_t WS_KA = WS_QA + 17039360;
constexpr size_t WS_KAS = WS_KA + 16777216;
constexpr size_t WS_VAT = WS_KAS + 4456448;
constexpr size_t WS_VATS = WS_VAT + 16777216;
constexpr size_t WS_GA = WS_VATS + 4456448;
constexpr size_t WS_QB = WS_GA + 17039360;
constexpr size_t WS_KB = WS_QB + 17039360;
constexpr size_t WS_KBS = WS_KB + 16777216;
constexpr size_t WS_VBT = WS_KBS + 8650752;
constexpr size_t WS_VBTS = WS_VBT + 16777216;
constexpr size_t WS_GB = WS_VBTS + 8650752;
constexpr size_t WS_ROPE = WS_GB + 17039360;
constexpr size_t WS_END = WS_ROPE + 524288;

struct Params {
  const float* x_prompt; const float* x_sample;
  const float* cache_a_k; const float* cache_a_v; const float* cache_b_k; const float* cache_b_v;
  const float* norm_gain; const float* w_in; const float* w_out; const float* rel_bias;
  const float* lq1; const float* lk1; const float* lq2; const float* lk2;
  const float* subln; const float* final_gain;
  float* out; char* ws;
};

DI u32 pk2(float a, float b) { f2_t v = {a, b}; bf2_t r = __builtin_convertvector(v, bf2_t); return __builtin_bit_cast(u32, r); }
DI float bflo(u32 v) { return __uint_as_float(v << 16); }
DI float bfhi(u32 v) { return __uint_as_float(v & 0xffff0000u); }
DI int rho(int r) { return (r & ~12) | ((r & 4) << 1) | ((r & 8) >> 1); }
DI float wave_sum(float v) {
#pragma unroll
  for (int o = 32; o > 0; o >>= 1) v += __shfl_xor(v, o);
  return v;
}

DI void phase0(const Params& p, char* lds) {
  const int tid = threadIdx.x, bid = blockIdx.x, nb = gridDim.x;
  const int lane = tid & 63, w = tid >> 6;
  float* tile = (float*)lds;
  for (int t = bid; t < 1280; t += nb) {
    const float* W; u16* WT; int N, kt, nt;
    if (t < 1024) { W = p.w_in; WT = (u16*)(p.ws + WS_WINT); N = 4096; kt = t >> 6; nt = t & 63; }
    else { int t2 = t - 1024; W = p.w_out; WT = (u16*)(p.ws + WS_WOUTT); N = 1024; kt = t2 >> 4; nt = t2 & 15; }
#pragma unroll
    for (int it = 0; it < 8; ++it) {
      int idx = it * 512 + tid, kk = idx >> 6, nn = idx & 63;
      tile[kk * 65 + nn] = W[(size_t)(kt * 64 + kk) * N + nt * 64 + nn];
    }
    __syncthreads();
    {
      int n = tid >> 3, kg = tid & 7;
      float v[8];
#pragma unroll
      for (int j = 0; j < 8; ++j) v[j] = tile[(kg * 8 + j) * 65 + n];
      uint4 o; o.x = pk2(v[0], v[1]); o.y = pk2(v[2], v[3]); o.z = pk2(v[4], v[5]); o.w = pk2(v[6], v[7]);
      *(uint4*)(WT + (size_t)(nt * 64 + n) * 1024 + kt * 64 + kg * 8) = o;
    }
    __syncthreads();
  }
  {
    u16* HN = (u16*)(p.ws + WS_HN);
    for (int row = bid * 8 + w; row < NTOK; row += nb * 8) {
      const float* src = row < NTOKP ? p.x_prompt + (size_t)row * 1024 : p.x_sample + (size_t)(row - NTOKP) * 1024;
      float4 v[4]; float ss = 0.f;
#pragma unroll
      for (int it = 0; it < 4; ++it) { v[it] = *(const float4*)(src + it * 256 + lane * 4); ss += v[it].x * v[it].x + v[it].y * v[it].y + v[it].z * v[it].z + v[it].w * v[it].w; }
      ss = wave_sum(ss);
      float inv = rsqrtf(ss * (1.f / 1024.f) + 1e-6f);
#pragma unroll
      for (int it = 0; it < 4; ++it) {
        float4 g = *(const float4*)(p.norm_gain + it * 256 + lane * 4);
        uint2 o; o.x = pk2(v[it].x * inv * g.x, v[it].y * inv * g.y); o.y = pk2(v[it].z * inv * g.z, v[it].w * inv * g.w);
        *(uint2*)(HN + (size_t)row * 1024 + it * 256 + lane * 4) = o;
      }
    }
  }
  const int gt = bid * 512 + tid, gn = nb * 512;
  {
    u16* KAS = (u16*)(p.ws + WS_KAS);
    for (int i = gt; i < 524288; i += gn) {
      int e = i * 4, b = e >> 18, key = (e >> 9) & 511, f = e & 511;
      float4 v = *(const float4*)(p.cache_a_k + e);
      uint2 o; o.x = pk2(v.x, v.y); o.y = pk2(v.z, v.w);
      *(uint2*)(KAS + (size_t)(b * 544 + key) * 512 + f) = o;
      if (key >= 32) *(float4*)(p.out + O_AKS + (size_t)(b * 512 + key - 32) * 512 + f) = v;
    }
    u16* KBS = (u16*)(p.ws + WS_KBS);
    for (int i = gt; i < 1048576; i += gn) {
      int e = i * 4, b = e >> 19, key = (e >> 9) & 1023, f = e & 511;
      float4 v = *(const float4*)(p.cache_b_k + e);
      uint2 o; o.x = pk2(v.x, v.y); o.y = pk2(v.z, v.w);
      *(uint2*)(KBS + (size_t)(b * 1056 + key) * 512 + f) = o;
    }
    u16* VATS = (u16*)(p.ws + WS_VATS);
    for (int i = gt; i < 262144; i += gn) {
      int f = i & 511, kg = (i >> 9) & 63, b = i >> 15;
      float v[8];
#pragma unroll
      for (int j = 0; j < 8; ++j) v[j] = p.cache_a_v[(size_t)(b * 512 + kg * 8 + j) * 512 + f];
      uint4 o; o.x = pk2(v[0], v[1]); o.y = pk2(v[2], v[3]); o.z = pk2(v[4], v[5]); o.w = pk2(v[6], v[7]);
      *(uint4*)(VATS + (size_t)(b * 512 + f) * 544 + kg * 8) = o;
      if (kg >= 4) {
#pragma unroll
        for (int j = 0; j < 8; ++j) p.out[O_AVS + (size_t)(b * 512 + kg * 8 + j - 32) * 512 + f] = v[j];
      }
    }
    u16* VBTS = (u16*)(p.ws + WS_VBTS);
    for (int i = gt; i < 524288; i += gn) {
      int f = i & 511, kg = (i >> 9) & 127, b = i >> 16;
      float v[8];
#pragma unroll
      for (int j = 0; j < 8; ++j) v[j] = p.cache_b_v[(size_t)(b * 1024 + kg * 8 + j) * 512 + f];
      uint4 o; o.x = pk2(v[0], v[1]); o.y = pk2(v[2], v[3]); o.z = pk2(v[4], v[5]); o.w = pk2(v[6], v[7]);
      *(uint4*)(VBTS + (size_t)(b * 512 + f) * 1056 + kg * 8) = o;
    }
  }
  {
    float2* RT = (float2*)(p.ws + WS_ROPE);
    for (int i = gt; i < 65536; i += gn) {
      int pos = i >> 3, m = i & 7;
      float inv = powf(500000.f, -(float)m * 0.125f);
      float ang = (float)pos * inv;
      RT[i] = make_float2(cosf(ang), sinf(ang));
    }
  }
}

template <bool SWAP>
DI void gemm_mainloop(const u16* __restrict__ A, const u16* __restrict__ Bt, int tm, int tn, char* lds, f32x16 (&acc)[2][2]) {
  const int tid = threadIdx.x, lane = tid & 63, w = tid >> 6, wm = w >> 1, wn = w & 1;
  const int r = lane & 31, h = lane >> 5;
  const u16* pa = A + (size_t)(tm * 256 + (tid >> 3)) * 1024 + (tid & 7) * 8;
  const u16* pb = Bt + (size_t)(tn * 128 + (tid >> 3)) * 1024 + (tid & 7) * 8;
  const int wofs = (tid >> 3) * 128 + ((((tid & 7) ^ ((tid >> 4) & 7))) << 4);
  const int swr = (r >> 1) & 7;
  uint4 ra[4], rb[2];
#pragma unroll
  for (int i = 0; i < 2; ++i)
#pragma unroll
    for (int j = 0; j < 2; ++j)
#pragma unroll
      for (int e = 0; e < 16; ++e) acc[i][j][e] = 0.f;
#pragma unroll
  for (int it = 0; it < 4; ++it) ra[it] = *(const uint4*)(pa + (size_t)it * 65536);
#pragma unroll
  for (int it = 0; it < 2; ++it) rb[it] = *(const uint4*)(pb + (size_t)it * 65536);
#pragma unroll
  for (int it = 0; it < 4; ++it) *(uint4*)(lds + it * 8192 + wofs) = ra[it];
#pragma unroll
  for (int it = 0; it < 2; ++it) *(uint4*)(lds + 32768 + it * 8192 + wofs) = rb[it];
  __syncthreads();
  for (int kt = 0; kt < 16; ++kt) {
    if (kt + 1 < 16) {
#pragma unroll
      for (int it = 0; it < 4; ++it) ra[it] = *(const uint4*)(pa + (size_t)it * 65536 + (kt + 1) * 64);
#pragma unroll
      for (int it = 0; it < 2; ++it) rb[it] = *(const uint4*)(pb + (size_t)it * 65536 + (kt + 1) * 64);
    }
    const char* ba = lds + (kt & 1) * 49152;
    const char* bb = ba + 32768;
#pragma unroll
    for (int s = 0; s < 4; ++s) {
      const int co = (((2 * s + h) ^ swr) << 4);
      bf16x8 hf[2], wf[2];
#pragma unroll
      for (int i = 0; i < 2; ++i) hf[i] = *(const bf16x8*)(ba + (wm * 64 + i * 32 + r) * 128 + co);
#pragma unroll
      for (int j = 0; j < 2; ++j) wf[j] = *(const bf16x8*)(bb + (wn * 64 + j * 32 + r) * 128 + co);
#pragma unroll
      for (int i = 0; i < 2; ++i)
#pragma unroll
        for (int j = 0; j < 2; ++j) {
          if (SWAP) acc[j][i] = MFMA(wf[j], hf[i], acc[j][i]);
          else acc[i][j] = MFMA(hf[i], wf[j], acc[i][j]);
        }
    }
    if (kt + 1 < 16) {
      char* bw = lds + ((kt + 1) & 1) * 49152;
#pragma unroll
      for (int it = 0; it < 4; ++it) *(uint4*)(bw + it * 8192 + wofs) = ra[it];
#pragma unroll
      for (int it = 0; it < 2; ++it) *(uint4*)(bw + 32768 + it * 8192 + wofs) = rb[it];
    }
    __syncthreads();
  }
}

DI float silu(float x) { return x / (1.f + __expf(-x)); }

DI void phase1(const Params& p, char* lds) {
  const int tid = threadIdx.x, lane = tid & 63, w = tid >> 6, wm = w >> 1, wn = w & 1;
  const int r = lane & 31, h = lane >> 5;
  const u16* HN = (const u16*)(p.ws + WS_HN);
  const u16* WT = (const u16*)(p.ws + WS_WINT);
  const float2* RT = (const float2*)(p.ws + WS_ROPE);
  for (int tile = blockIdx.x; tile < 65 * 32; tile += gridDim.x) {
    const int tm = tile >> 5, tn = tile & 31;
    const int sec = tn >> 2;
    const bool sample = (tm == 64);
    f32x16 acc[2][2];
    if (sec == 2 || sec == 6) {
      gemm_mainloop<false>(HN, WT, tm, tn, lds, acc);
      u16* VT; size_t ldv; size_t o32;
      if (sec == 2) { VT = (u16*)(p.ws + (sample ? WS_VATS : WS_VAT)); ldv = sample ? 544 : 8192; }
      else { VT = (u16*)(p.ws + (sample ? WS_VBTS : WS_VBT)); ldv = sample ? 1056 : 8192; }
#pragma unroll
      for (int i = 0; i < 2; ++i)
#pragma unroll
        for (int j = 0; j < 2; ++j) {
          const int fs = (tn & 3) * 128 + wn * 64 + j * 32 + r;
#pragma unroll
          for (int g = 0; g < 4; ++g) {
            const int t = tm * 256 + wm * 64 + i * 32 + 8 * g + 4 * h;
            float v0 = acc[i][j][4 * g], v1 = acc[i][j][4 * g + 1], v2 = acc[i][j][4 * g + 2], v3 = acc[i][j][4 * g + 3];
            uint2 o; o.x = pk2(v0, v1); o.y = pk2(v2, v3);
            if (!sample) {
              const int b = t >> 13, s = t & 8191;
              *(uint2*)(VT + ((size_t)(b * 512 + fs)) * ldv + s) = o;
              if (sec == 2) {
                if (s >= 7680) {
                  float* d = p.out + O_AVP + ((size_t)(b * 512 + s - 7680)) * 512 + fs;
                  d[0] = v0; d[512] = v1; d[1024] = v2; d[1536] = v3;
                }
              } else {
                float* d = p.out + O_BVP + (size_t)t * 512 + fs;
                d[0] = v0; d[512] = v1; d[1024] = v2; d[1536] = v3;
              }
            } else {
              const int ts = t - NTOKP, b = ts >> 5, tt = ts & 31;
              if (sec == 2) {
                *(uint2*)(VT + ((size_t)(b * 512 + fs)) * ldv + 512 + tt) = o;
                float* d = p.out + O_AVS + ((size_t)(b * 512 + 480 + tt)) * 512 + fs;
                d[0] = v0; d[512] = v1; d[1024] = v2; d[1536] = v3;
              } else {
                *(uint2*)(VT + ((size_t)(b * 512 + fs)) * ldv + 1024 + tt) = o;
                float* d = p.out + O_BVS + (size_t)ts * 512 + fs;
                d[0] = v0; d[512] = v1; d[1024] = v2; d[1536] = v3;
              }
            }
          }
        }
    } else {
      gemm_mainloop<true>(HN, WT, tm, tn, lds, acc);
#pragma unroll
      for (int i = 0; i < 2; ++i) {
        const int t = tm * 256 + wm * 64 + i * 32 + r;
        const int ts = t - NTOKP, sb = ts >> 5, stt = ts & 31;
        const int pos = sample ? (1024 + stt) : (t & 8191);
        if (sec == 4 || sec == 5) {
#pragma unroll
          for (int e = 0; e < 4; ++e) {
            float2 cs = RT[pos * 8 + 4 * h + e];
            float x1 = acc[0][i][e], x2 = acc[0][i][4 + e];
            acc[0][i][e] = x1 * cs.x - x2 * cs.y;
            acc[0][i][4 + e] = x2 * cs.x + x1 * cs.y;
          }
        }
#pragma unroll
        for (int j = 0; j < 2; ++j)
#pragma unroll
          for (int g = 0; g < 4; ++g) {
            const int fs = (tn & 3) * 128 + wn * 64 + j * 32 + 8 * g + 4 * h;
            float v0 = acc[j][i][4 * g], v1 = acc[j][i][4 * g + 1], v2 = acc[j][i][4 * g + 2], v3 = acc[j][i][4 * g + 3];
            if (sec == 3 || sec == 7) { v0 = silu(v0); v1 = silu(v1); v2 = silu(v2); v3 = silu(v3); }
            uint2 o; o.x = pk2(v0, v1); o.y = pk2(v2, v3);
            const float4 vf = make_float4(v0, v1, v2, v3);
            if (sec == 0) *(uint2*)((u16*)(p.ws + WS_QA) + (size_t)t * 512 + fs) = o;
            else if (sec == 3) *(uint2*)((u16*)(p.ws + WS_GA) + (size_t)t * 512 + fs) = o;
            else if (sec == 4) *(uint2*)((u16*)(p.ws + WS_QB) + (size_t)t * 512 + fs) = o;
            else if (sec == 7) *(uint2*)((u16*)(p.ws + WS_GB) + (size_t)t * 512 + fs) = o;
            else if (sec == 1) {
              if (!sample) {
                *(uint2*)((u16*)(p.ws + WS_KA) + (size_t)t * 512 + fs) = o;
                const int b = t >> 13, s = t & 8191;
                if (s >= 7680) *(float4*)(p.out + O_AKP + ((size_t)(b * 512 + s - 7680)) * 512 + fs) = vf;
              } else {
                *(uint2*)((u16*)(p.ws + WS_KAS) + ((size_t)(sb * 544 + 512 + stt)) * 512 + fs) = o;
                *(float4*)(p.out + O_AKS + ((size_t)(sb * 512 + 480 + stt)) * 512 + fs) = vf;
              }
            } else {
              if (!sample) {
                *(uint2*)((u16*)(p.ws + WS_KB) + (size_t)t * 512 + fs) = o;
                *(float4*)(p.out + O_BKP + (size_t)t * 512 + fs) = vf;
              } else {
                *(uint2*)((u16*)(p.ws + WS_KBS) + ((size_t)(sb * 1056 + 1024 + stt)) * 512 + fs) = o;
                *(float4*)(p.out + O_BKS + (size_t)ts * 512 + fs) = vf;
              }
            }
          }
      }
    }
  }
}

constexpr float SM_C = 0.125f * 1.4426950408889634f;
template <int NQT, int DVT, bool BIAS>
DI void attn_wave(const u16* __restrict__ Q, int ldq, const u16* __restrict__ K, int ldk,
                  const u16* __restrict__ Vt, int ldv, int nkt, const float* bias_l2, int rel0,
                  f32x16 (&O)[NQT][DVT], float (&Mx)[NQT], float (&L)[NQT]) {
  const int lane = threadIdx.x & 63, r = lane & 31, h = lane >> 5;
  bf16x8 qf[NQT][4];
#pragma unroll
  for (int u = 0; u < NQT; ++u)
#pragma unroll
    for (int s = 0; s < 4; ++s) qf[u][s] = *(const bf16x8*)(Q + (size_t)(32 * u + r) * ldq + 16 * s + 8 * h);
#pragma unroll
  for (int u = 0; u < NQT; ++u) {
    Mx[u] = -INFINITY; L[u] = 0.f;
#pragma unroll
    for (int dt = 0; dt < DVT; ++dt)
#pragma unroll
      for (int e = 0; e < 16; ++e) O[u][dt][e] = 0.f;
  }
  const u16* kp = K + (size_t)rho(r) * ldk + 8 * h;
  const u16* vp = Vt + (size_t)r * ldv + 8 * h;
  bf16x8 kf[4];
#pragma unroll
  for (int s = 0; s < 4; ++s) kf[s] = *(const bf16x8*)(kp + 16 * s);
  for (int kt = 0; kt < nkt; ++kt) {
    bf16x8 vf[DVT][2];
#pragma unroll
    for (int dt = 0; dt < DVT; ++dt)
#pragma unroll
      for (int s2 = 0; s2 < 2; ++s2) vf[dt][s2] = *(const bf16x8*)(vp + (size_t)(32 * dt) * ldv + 32 * kt + 16 * s2);
    bf16x8 kn[4];
    {
      const int ktn = (kt + 1 < nkt) ? kt + 1 : kt;
#pragma unroll
      for (int s = 0; s < 4; ++s) kn[s] = *(const bf16x8*)(kp + (size_t)(32 * ktn) * ldk + 16 * s);
    }
    bf16x8 pf[NQT][2];
#pragma unroll
    for (int u = 0; u < NQT; ++u) {
      f32x16 S;
#pragma unroll
      for (int e = 0; e < 16; ++e) S[e] = 0.f;
#pragma unroll
      for (int s = 0; s < 4; ++s) S = MFMA(kf[s], qf[u][s], S);
      float t[16];
      if (BIAS) {
        const int relb = rel0 + 32 * u + r - 32 * kt - 8 * h;
        if (rel0 - 32 * kt - 31 >= 128) {
          const float bv = bias_l2[256];
#pragma unroll
          for (int e = 0; e < 16; ++e) t[e] = S[e] * SM_C + bv;
        } else {
#pragma unroll
          for (int e = 0; e < 16; ++e) {
            int rel = relb - ((e & 7) + 16 * (e >> 3));
            rel = rel < -128 ? -128 : (rel > 128 ? 128 : rel);
            t[e] = S[e] * SM_C + bias_l2[rel + 128];
          }
        }
      } else {
#pragma unroll
        for (int e = 0; e < 16; ++e) t[e] = S[e] * SM_C;
      }
      float mx = t[0];
#pragma unroll
      for (int e = 1; e < 16; ++e) mx = fmaxf(mx, t[e]);
      mx = fmaxf(mx, __shfl_xor(mx, 32));
      if (__any(mx > Mx[u] + 8.f)) {
        const float mn = fmaxf(Mx[u], mx);
        const float al = __builtin_amdgcn_exp2f(Mx[u] - mn);
        Mx[u] = mn; L[u] *= al;
#pragma unroll
        for (int dt = 0; dt < DVT; ++dt)
#pragma unroll
          for (int e = 0; e < 16; ++e) O[u][dt][e] *= al;
      }
      float ps = 0.f;
#pragma unroll
      for (int e = 0; e < 16; ++e) { t[e] = __builtin_amdgcn_exp2f(t[e] - Mx[u]); ps += t[e]; }
      L[u] += ps;
#pragma unroll
      for (int s2 = 0; s2 < 2; ++s2) {
        uint4 pk;
        pk.x = pk2(t[8 * s2], t[8 * s2 + 1]); pk.y = pk2(t[8 * s2 + 2], t[8 * s2 + 3]);
        pk.z = pk2(t[8 * s2 + 4], t[8 * s2 + 5]); pk.w = pk2(t[8 * s2 + 6], t[8 * s2 + 7]);
        pf[u][s2] = __builtin_bit_cast(bf16x8, pk);
      }
    }
#pragma unroll
    for (int u = 0; u < NQT; ++u)
#pragma unroll
      for (int dt = 0; dt < DVT; ++dt)
#pragma unroll
        for (int s2 = 0; s2 < 2; ++s2) O[u][dt] = MFMA(vf[dt][s2], pf[u][s2], O[u][dt]);
#pragma unroll
    for (int s = 0; s < 4; ++s) kf[s] = kn[s];
  }
#pragma unroll
  for (int u = 0; u < NQT; ++u) L[u] += __shfl_xor(L[u], 32);
}

template <int NQT>
DI void attnA_item(const Params& p, const u16* Q, const u16* K, const u16* Vt, int ldv, int nkt, int rel0,
                   const float* bias_l2, int tok0, int head) {
  f32x16 O[NQT][2]; float Mx[NQT], L[NQT];
  attn_wave<NQT, 2, true>(Q, 512, K, 512, Vt, ldv, nkt, bias_l2, rel0, O, Mx, L);
  const int lane = threadIdx.x & 63, r = lane & 31, h = lane >> 5;
  const u16* GA = (const u16*)(p.ws + WS_GA);
  u16* OB = (u16*)(p.ws + WS_HN);
#pragma unroll
  for (int u = 0; u < NQT; ++u) {
    const float inv = 1.f / L[u];
    const size_t tok = (size_t)(tok0 + 32 * u + r);
#pragma unroll
    for (int dt = 0; dt < 2; ++dt)
#pragma unroll
      for (int g = 0; g < 4; ++g) {
        const int dv = 32 * dt + 8 * g + 4 * h;
        const uint2 gg = *(const uint2*)(GA + tok * 512 + head * 64 + dv);
        uint2 o;
        o.x = pk2(O[u][dt][4 * g] * inv * bflo(gg.x), O[u][dt][4 * g + 1] * inv * bfhi(gg.x));
        o.y = pk2(O[u][dt][4 * g + 2] * inv * bflo(gg.y), O[u][dt][4 * g + 3] * inv * bfhi(gg.y));
        *(uint2*)(OB + tok * 1024 + head * 64 + dv) = o;
      }
  }
}

DI void attnB_epilogue(const Params& p, f32x16 (&O)[4], float Lsum, int tok0, int hb, float lam, float* xch) {
  const int lane = threadIdx.x & 63, r = lane & 31, h = lane >> 5, w = threadIdx.x >> 6, m = w >> 2, wsub = w & 3;
  const float inv = 1.f / Lsum;
  float* xw = xch + wsub * 4096 + lane;
  if (m == 1) {
    const float sc = inv * lam;
#pragma unroll
    for (int dt = 0; dt < 4; ++dt)
#pragma unroll
      for (int e = 0; e < 16; ++e) xw[(dt * 16 + e) * 64] = O[dt][e] * sc;
  }
  __syncthreads();
  if (m == 0) {
    float ss = 0.f;
#pragma unroll
    for (int dt = 0; dt < 4; ++dt)
#pragma unroll
      for (int e = 0; e < 16; ++e) { float o = O[dt][e] * inv - xw[(dt * 16 + e) * 64]; O[dt][e] = o; ss += o * o; }
    ss += __shfl_xor(ss, 32);
    const float rn = rsqrtf(ss * (1.f / 128.f) + 1e-6f) * 0.8f;
    const u16* GB = (const u16*)(p.ws + WS_GB);
    u16* OB = (u16*)(p.ws + WS_HN);
    const size_t tok = (size_t)(tok0 + r);
#pragma unroll
    for (int dt = 0; dt < 4; ++dt)
#pragma unroll
      for (int g = 0; g < 4; ++g) {
        const int dv = 32 * dt + 8 * g + 4 * h;
        const uint2 gg = *(const uint2*)(GB + tok * 512 + hb * 128 + dv);
        const float4 sg = *(const float4*)(p.subln + dv);
        uint2 o;
        o.x = pk2(O[dt][4 * g] * rn * sg.x * bflo(gg.x), O[dt][4 * g + 1] * rn * sg.y * bfhi(gg.x));
        o.y = pk2(O[dt][4 * g + 2] * rn * sg.z * bflo(gg.y), O[dt][4 * g + 3] * rn * sg.w * bfhi(gg.y));
        *(uint2*)(OB + tok * 1024 + 512 + hb * 128 + dv) = o;
      }
  }
  __syncthreads();
}

DI void attnB_item(const Params& p, const u16* Q, const u16* K, const u16* Vt, int ldv, int nkt, int tok0, int hb,
                   float lam, float* xch) {
  f32x16 O[1][4]; float Mx[1], L[1];
  attn_wave<1, 4, false>(Q, 512, K, 512, Vt, ldv, nkt, nullptr, 0, O, Mx, L);
  attnB_epilogue(p, O[0], L[0], tok0, hb, lam, xch);
}

DI void attnB_block(const Params& p, int b, int hb, int qt, float lam, char* lds, float* xch) {
  const int tid = threadIdx.x, lane = tid & 63, r = lane & 31, h = lane >> 5, w = tid >> 6, m = w >> 2, wsub = w & 3;
  const int q0 = qt * 128 + wsub * 32;
  const int nt = 2 * qt + 2;
  const int my_nt = (q0 >> 6) + 1;
  bf16x8 qf[4];
  {
    const u16* Q = (const u16*)(p.ws + WS_QB) + (size_t)(b * SEQ + q0 + r) * 512 + hb * 128 + m * 64 + 8 * h;
#pragma unroll
    for (int s = 0; s < 4; ++s) qf[s] = *(const bf16x8*)(Q + 16 * s);
  }
  f32x16 O[4];
#pragma unroll
  for (int dt = 0; dt < 4; ++dt)
#pragma unroll
    for (int e = 0; e < 16; ++e) O[dt][e] = 0.f;
  float Mx = -INFINITY, L = 0.f;
  const u16* gk = (const u16*)(p.ws + WS_KB) + (size_t)(b * SEQ + (tid >> 4)) * 512 + hb * 128 + (tid & 15) * 8;
  const u16* gv = (const u16*)(p.ws + WS_VBT) + (size_t)(b * 512 + hb * 128 + (tid >> 3)) * SEQ + (tid & 7) * 8;
  const int lk = ((tid >> 3) & 1) * 8192 + (tid >> 4) * 128 + ((((tid & 7) ^ ((tid >> 5) & 7))) << 4);
  const int lv = 16384 + (tid >> 3) * 128 + ((((tid & 7) ^ ((tid >> 4) & 7))) << 4);
  const int rr = rho(r);
  const int swk = (rr >> 1) & 7, swv = (r >> 1) & 7;
  uint4 sk0, sk1, sv0, sv1;
  sk0 = *(const uint4*)(gk); sk1 = *(const uint4*)(gk + (size_t)32 * 512);
  sv0 = *(const uint4*)(gv); sv1 = *(const uint4*)(gv + (size_t)64 * SEQ);
  *(uint4*)(lds + lk) = sk0; *(uint4*)(lds + lk + 4096) = sk1;
  *(uint4*)(lds + lv) = sv0; *(uint4*)(lds + lv + 8192) = sv1;
  __syncthreads();
  for (int t = 0; t < nt; ++t) {
    if (t + 1 < nt) {
      sk0 = *(const uint4*)(gk + (size_t)(64 * (t + 1)) * 512);
      sk1 = *(const uint4*)(gk + (size_t)(64 * (t + 1) + 32) * 512);
      sv0 = *(const uint4*)(gv + 64 * (t + 1));
      sv1 = *(const uint4*)(gv + (size_t)64 * SEQ + 64 * (t + 1));
    }
    if (t < my_nt) {
      const char* kb = lds + (t & 1) * 32768 + m * 8192;
      const char* vb = lds + (t & 1) * 32768 + 16384;
      f32x16 S0, S1;
#pragma unroll
      for (int e = 0; e < 16; ++e) { S0[e] = 0.f; S1[e] = 0.f; }
#pragma unroll
      for (int s = 0; s < 4; ++s) {
        const int co = (((2 * s + h) ^ swk) << 4);
        bf16x8 a0 = *(const bf16x8*)(kb + rr * 128 + co);
        bf16x8 a1 = *(const bf16x8*)(kb + (32 + rr) * 128 + co);
        S0 = MFMA(a0, qf[s], S0);
        S1 = MFMA(a1, qf[s], S1);
      }
      float mx = fmaxf(S0[0], S1[0]);
#pragma unroll
      for (int e = 1; e < 16; ++e) mx = fmaxf(mx, fmaxf(S0[e], S1[e]));
      mx *= SM_C;
      mx = fmaxf(mx, __shfl_xor(mx, 32));
      if (__any(mx > Mx + 8.f)) {
        const float mn = fmaxf(Mx, mx);
        const float al = __builtin_amdgcn_exp2f(Mx - mn);
        Mx = mn; L *= al;
#pragma unroll
        for (int dt = 0; dt < 4; ++dt)
#pragma unroll
          for (int e = 0; e < 16; ++e) O[dt][e] *= al;
      }
      float ps = 0.f;
#pragma unroll
      for (int e = 0; e < 16; ++e) {
        S0[e] = __builtin_amdgcn_exp2f(fmaf(S0[e], SM_C, -Mx));
        S1[e] = __builtin_amdgcn_exp2f(fmaf(S1[e], SM_C, -Mx));
        ps += S0[e] + S1[e];
      }
      L += ps;
      bf16x8 pf[4];
#pragma unroll
      for (int s2 = 0; s2 < 2; ++s2) {
        uint4 pa, pb;
        pa.x = pk2(S0[8 * s2], S0[8 * s2 + 1]); pa.y = pk2(S0[8 * s2 + 2], S0[8 * s2 + 3]);
        pa.z = pk2(S0[8 * s2 + 4], S0[8 * s2 + 5]); pa.w = pk2(S0[8 * s2 + 6], S0[8 * s2 + 7]);
        pb.x = pk2(S1[8 * s2], S1[8 * s2 + 1]); pb.y = pk2(S1[8 * s2 + 2], S1[8 * s2 + 3]);
        pb.z = pk2(S1[8 * s2 + 4], S1[8 * s2 + 5]); pb.w = pk2(S1[8 * s2 + 6], S1[8 * s2 + 7]);
        pf[s2] = __builtin_bit_cast(bf16x8, pa);
        pf[2 + s2] = __builtin_bit_cast(bf16x8, pb);
      }
#pragma unroll
      for (int ks = 0; ks < 4; ++ks) {
        const int co = (((2 * ks + h) ^ swv) << 4);
#pragma unroll
        for (int dt = 0; dt < 4; ++dt) {
          bf16x8 v = *(const bf16x8*)(vb + (32 * dt + r) * 128 + co);
          O[dt] = MFMA(v, pf[ks], O[dt]);
        }
      }
    }
    if (t + 1 < nt) {
      char* bw = lds + ((t + 1) & 1) * 32768;
      *(uint4*)(bw + lk) = sk0; *(uint4*)(bw + lk + 4096) = sk1;
      *(uint4*)(bw + lv) = sv0; *(uint4*)(bw + lv + 8192) = sv1;
    }
    __syncthreads();
  }
  L += __shfl_xor(L, 32);
  attnB_epilogue(p, O, L, b * SEQ + q0, hb, lam, xch);
}

DI void phase2(const Params& p, char* lds) {
  const int tid = threadIdx.x, lane = tid & 63, w = tid >> 6;
  float* xch = (float*)(lds + 65536);
  float* bias = (float*)(lds + 131072);
  for (int i = tid; i < 8 * 257; i += 512) { int hh = i / 257, k = i - hh * 257; bias[hh * 260 + k] = p.rel_bias[i] * 1.4426950408889634f; }
  float lam;
  {
    float a = p.lq1[lane] * p.lk1[lane], b = p.lq2[lane] * p.lk2[lane];
    a = wave_sum(a); b = wave_sum(b);
    lam = expf(a) - expf(b) + 0.2f;
  }
  __syncthreads();
  const u16* QA = (const u16*)(p.ws + WS_QA);
  const u16* QB = (const u16*)(p.ws + WS_QB);
  for (int item = blockIdx.x; item < 256; item += gridDim.x) {
    const int bh = item & 7, i0 = item >> 3, b = bh >> 2, hb = bh & 3;
#pragma unroll 1
    for (int rep = 0; rep < 2; ++rep) attnB_block(p, b, hb, rep ? 63 - i0 : i0, lam, lds, xch);
  }
  for (int it = blockIdx.x; it < 256; it += gridDim.x) {
    const int b = it >> 7, c = it & 127, cs = c > 8 ? c - 8 : 0;
    attnA_item<2>(p, QA + (size_t)(b * SEQ + c * 64) * 512 + w * 64,
                  (const u16*)(p.ws + WS_KA) + (size_t)(b * SEQ + cs * 64) * 512 + w * 64,
                  (const u16*)(p.ws + WS_VAT) + (size_t)(b * 512 + w * 64) * SEQ + cs * 64, SEQ,
                  (c + 1 - cs) * 2, 64 * (c - cs), bias + w * 260, b * SEQ + c * 64, w);
  }
  for (int it = blockIdx.x; it < 8; it += gridDim.x) {
    const int m = w >> 2, wsub = w & 3, id = it * 4 + wsub, b = id >> 2, hb = id & 3;
    attnB_item(p, QB + (size_t)(NTOKP + b * 32) * 512 + hb * 128 + m * 64,
               (const u16*)(p.ws + WS_KBS) + (size_t)(b * 1056) * 512 + hb * 128 + m * 64,
               (const u16*)(p.ws + WS_VBTS) + (size_t)(b * 512 + hb * 128) * 1056, 1056, 33, NTOKP + b * 32, hb, lam, xch);
  }
  for (int it = (int)((blockIdx.x + gridDim.x - 8) % gridDim.x); it < 8; it += gridDim.x) {
    const int b = it;
    attnA_item<1>(p, QA + (size_t)(NTOKP + b * 32) * 512 + w * 64,
                  (const u16*)(p.ws + WS_KAS) + (size_t)(b * 544) * 512 + w * 64,
                  (const u16*)(p.ws + WS_VATS) + (size_t)(b * 512 + w * 64) * 544, 544, 17, 512, bias + w * 260,
                  NTOKP + b * 32, w);
  }
}

DI void phase3(const Params& p, char* lds) {
  const int tid = threadIdx.x, lane = tid & 63, w = tid >> 6, wm = w >> 1, wn = w & 1;
  const int r = lane & 31, h = lane >> 5;
  const u16* OB = (const u16*)(p.ws + WS_HN);
  const u16* WT = (const u16*)(p.ws + WS_WOUTT);
  for (int tile = blockIdx.x; tile < 65 * 8; tile += gridDim.x) {
    const int tm = tile >> 3, tn = tile & 7;
    f32x16 acc[2][2];
    gemm_mainloop<true>(OB, WT, tm, tn, lds, acc);
#pragma unroll
    for (int i = 0; i < 2; ++i) {
      const int t = tm * 256 + wm * 64 + i * 32 + r;
      const float* xr = t < NTOKP ? p.x_prompt + (size_t)t * 1024 : p.x_sample + (size_t)(t - NTOKP) * 1024;
      float* yr = p.out + O_YP + (size_t)t * 1024;
#pragma unroll
      for (int j = 0; j < 2; ++j)
#pragma unroll
        for (int g = 0; g < 4; ++g) {
          const int f = tn * 128 + wn * 64 + j * 32 + 8 * g + 4 * h;
          float4 xv = *(const float4*)(xr + f);
          xv.x += acc[j][i][4 * g]; xv.y += acc[j][i][4 * g + 1]; xv.z += acc[j][i][4 * g + 2]; xv.w += acc[j][i][4 * g + 3];
          *(float4*)(yr + f) = xv;
        }
    }
  }
}

DI void phase4(const Params& p) {
  const int lane = threadIdx.x & 63, w = threadIdx.x >> 6;
  for (int row = blockIdx.x * 8 + w; row < NTOK; row += gridDim.x * 8) {
    float* y = p.out + O_YP + (size_t)row * 1024;
    float4 v[4]; float ss = 0.f;
#pragma unroll
    for (int it = 0; it < 4; ++it) { v[it] = *(const float4*)(y + it * 256 + lane * 4); ss += v[it].x * v[it].x + v[it].y * v[it].y + v[it].z * v[it].z + v[it].w * v[it].w; }
    ss = wave_sum(ss);
    const float inv = rsqrtf(ss * (1.f / 1024.f) + 1e-6f);
#pragma unroll
    for (int it = 0; it < 4; ++it) {
      float4 g = *(const float4*)(p.final_gain + it * 256 + lane * 4);
      *(float4*)(y + it * 256 + lane * 4) = make_float4(v[it].x * inv * g.x, v[it].y * inv * g.y, v[it].z * inv * g.z, v[it].w * inv * g.w);
    }
  }
}

__global__ void __launch_bounds__(512) fwd_megakernel(Params p) {
  __shared__ __attribute__((aligned(16))) char lds[143360];
  cg::grid_group grid = cg::this_grid();
  phase0(p, lds);
  grid.sync();
  phase1(p, lds);
  grid.sync();
  phase2(p, lds);
  grid.sync();
  phase3(p, lds);
  grid.sync();
  phase4(p);
}

extern "C" void kernel_launch(void* const* d_in, const int* in_sizes, int n_in, void* d_out, int out_size, void* d_ws,
                              size_t ws_size, hipStream_t stream) {
  static int grid_blocks = 0;
  if (!grid_blocks) {
    int dev = 0, cus = 0, per_cu = 0;
    hipGetDevice(&dev);
    hipDeviceGetAttribute(&cus, hipDeviceAttributeMultiprocessorCount, dev);
    hipOccupancyMaxActiveBlocksPerMultiprocessor(&per_cu, fwd_megakernel, 512, 0);
    if (per_cu < 1) per_cu = 1;
    grid_blocks = cus;
  }
  Params p{};
  p.x_prompt = (const float*)d_in[0]; p.x_sample = (const float*)d_in[1];
  p.cache_a_k = (const float*)d_in[2]; p.cache_a_v = (const float*)d_in[3];
  p.cache_b_k = (const float*)d_in[4]; p.cache_b_v = (const float*)d_in[5];
  p.norm_gain = (const float*)d_in[6]; p.w_in = (const float*)d_in[7]; p.w_out = (const float*)d_in[8];
  p.rel_bias = (const float*)d_in[9];
  p.lq1 = (const float*)d_in[10]; p.lk1 = (const float*)d_in[11]; p.lq2 = (const float*)d_in[12]; p.lk2 = (const float*)d_in[13];
  p.subln = (const float*)d_in[14]; p.final_gain = (const float*)d_in[15];
  p.out = (float*)d_out; p.ws = (char*)d_ws;
  void* args[] = {&p};
  hipError_t e = hipLaunchCooperativeKernel((void*)fwd_megakernel, dim3(grid_blocks), dim3(512), args, 0, stream);
  if (e != hipSuccess) fprintf(stderr, "cooperative launch failed: %s (grid %d)\n", hipGetErrorString(e), grid_blocks);
}
```

```cpp
#include <hip/hip_runtime.h>
#include <hip/hip_cooperative_groups.h>
#include <cstdio>
namespace cg = cooperative_groups;

typedef short bf16x8 __attribute__((ext_vector_type(8)));
typedef float f32x16 __attribute__((ext_vector_type(16)));
typedef __bf16 bf2_t __attribute__((ext_vector_type(2)));
typedef float f2_t __attribute__((ext_vector_type(2)));
typedef unsigned u32;
typedef unsigned short u16;
#define DI __device__ __forceinline__
#define MFMA(a, b, c) __builtin_amdgcn_mfma_f32_32x32x16_bf16((a), (b), (c), 0, 0, 0)

constexpr int NTOKP = 16384;
constexpr int NTOK = 16640;
constexpr int SEQ = 8192;
constexpr size_t O_YP = 0;
constexpr size_t O_AKP = 17039360, O_AVP = 17563648, O_BKP = 18087936, O_BVP = 26476544;
constexpr size_t O_AKS = 34865152, O_AVS = 36962304, O_BKS = 39059456, O_BVS = 39190528;
constexpr size_t WS_WINT = 0;
constexpr size_t WS_WOUTT = WS_WINT + 8388608;
constexpr size_t WS_HN = WS_WOUTT + 2097152;
constexpr size_t WS_QA = WS_HN + 34078720;
constexpr size_t WS_KA = WS_QA + 17039360;
constexpr size_t WS_KAS = WS_KA + 16777216;
constexpr size_t WS_VAT = WS_KAS + 4456448;
constexpr size_t WS_VATS = WS_VAT + 16777216;
constexpr size_t WS_GA = WS_VATS + 4456448;
constexpr size_t WS_QB = WS_GA + 17039360;
constexpr size_t WS_KB = WS_QB + 17039360;
constexpr size_t WS_KBS = WS_KB + 16777216;
constexpr size_t WS_VBT = WS_KBS + 8650752;
constexpr size_t WS_VBTS = WS_VBT + 16777216;
constexpr size_t WS_GB = WS_VBTS + 8650752;
constexpr size_t WS_ROPE = WS_GB + 17039360;
constexpr size_t WS_BAR = WS_ROPE + 524288;
constexpr size_t WS_END = WS_BAR + 4096;

struct Params {
  const float* x_prompt; const float* x_sample;
  const float* cache_a_k; const float* cache_a_v; const float* cache_b_k; const float* cache_b_v;
  const float* norm_gain; const float* w_in; const float* w_out; const float* rel_bias;
  const float* lq1; const float* lk1; const float* lq2; const float* lk2;
  const float* subln; const float* final_gain;
  float* out; char* ws;
};

DI u32 pk2(float a, float b) { f2_t v = {a, b}; bf2_t r = __builtin_convertvector(v, bf2_t); return __builtin_bit_cast(u32, r); }
DI float bflo(u32 v) { return __uint_as_float(v << 16); }
DI float bfhi(u32 v) { return __uint_as_float(v & 0xffff0000u); }
DI int rho(int r) { return (r & ~12) | ((r & 4) << 1) | ((r & 8) >> 1); }
DI void gld16(uint4& dst, const void* p) { asm volatile("global_load_dwordx4 %0, %1, off" : "=v"(dst) : "v"(p) : "memory"); }
DI void wait_vm0() { asm volatile("s_waitcnt vmcnt(0)" ::: "memory"); }
DI float wave_sum(float v) {
#pragma unroll
  for (int o = 32; o > 0; o >>= 1) v += __shfl_xor(v, o);
  return v;
}


DI void ctr_barrier(unsigned* ctr, unsigned target) {
  __syncthreads();
  if (threadIdx.x == 0) {
    __builtin_amdgcn_fence(__ATOMIC_RELEASE, "agent");
    __hip_atomic_fetch_add(ctr, 1u, __ATOMIC_RELAXED, __HIP_MEMORY_SCOPE_AGENT);
    while (__hip_atomic_load(ctr, __ATOMIC_RELAXED, __HIP_MEMORY_SCOPE_AGENT) < target) __builtin_amdgcn_s_sleep(1);
    __builtin_amdgcn_fence(__ATOMIC_ACQUIRE, "agent");
  }
  __syncthreads();
}

DI void phase0(const Params& p, char* lds) {
  const int tid = threadIdx.x, bid = blockIdx.x, nb = gridDim.x;
  const int lane = tid & 63, w = tid >> 6;
  float* tile = (float*)lds;
  for (int t = bid; t < 1280; t += nb) {
    const float* W; u16* WT; int N, kt, nt;
    if (t < 1024) { W = p.w_in; WT = (u16*)(p.ws + WS_WINT); N = 4096; kt = t >> 6; nt = t & 63; }
    else { int t2 = t - 1024; W = p.w_out; WT = (u16*)(p.ws + WS_WOUTT); N = 1024; kt = t2 >> 4; nt = t2 & 15; }
#pragma unroll
    for (int it = 0; it < 8; ++it) {
      int idx = it * 512 + tid, kk = idx >> 6, nn = idx & 63;
      tile[kk * 65 + nn] = W[(size_t)(kt * 64 + kk) * N + nt * 64 + nn];
    }
    __syncthreads();
    {
      int n = tid >> 3, kg = tid & 7;
      float v[8];
#pragma unroll
      for (int j = 0; j < 8; ++j) v[j] = tile[(kg * 8 + j) * 65 + n];
      uint4 o; o.x = pk2(v[0], v[1]); o.y = pk2(v[2], v[3]); o.z = pk2(v[4], v[5]); o.w = pk2(v[6], v[7]);
      *(uint4*)(WT + (size_t)(nt * 64 + n) * 1024 + kt * 64 + kg * 8) = o;
    }
    __syncthreads();
  }
  {
    u16* HN = (u16*)(p.ws + WS_HN);
    for (int row = bid * 8 + w; row < NTOK; row += nb * 8) {
      const float* src = row < NTOKP ? p.x_prompt + (size_t)row * 1024 : p.x_sample + (size_t)(row - NTOKP) * 1024;
      float4 v[4]; float ss = 0.f;
#pragma unroll
      for (int it = 0; it < 4; ++it) { v[it] = *(const float4*)(src + it * 256 + lane * 4); ss += v[it].x * v[it].x + v[it].y * v[it].y + v[it].z * v[it].z + v[it].w * v[it].w; }
      ss = wave_sum(ss);
      float inv = rsqrtf(ss * (1.f / 1024.f) + 1e-6f);
#pragma unroll
      for (int it = 0; it < 4; ++it) {
        float4 g = *(const float4*)(p.norm_gain + it * 256 + lane * 4);
        uint2 o; o.x = pk2(v[it].x * inv * g.x, v[it].y * inv * g.y); o.y = pk2(v[it].z * inv * g.z, v[it].w * inv * g.w);
        *(uint2*)(HN + (size_t)row * 1024 + it * 256 + lane * 4) = o;
      }
    }
  }
  const int gt = bid * 512 + tid, gn = nb * 512;
  {
    u16* KAS = (u16*)(p.ws + WS_KAS);
    for (int i = gt; i < 524288; i += gn) {
      int e = i * 4, b = e >> 18, key = (e >> 9) & 511, f = e & 511;
      float4 v = *(const float4*)(p.cache_a_k + e);
      uint2 o; o.x = pk2(v.x, v.y); o.y = pk2(v.z, v.w);
      *(uint2*)(KAS + (size_t)(b * 544 + key) * 512 + f) = o;
      if (key >= 32) *(float4*)(p.out + O_AKS + (size_t)(b * 512 + key - 32) * 512 + f) = v;
    }
    u16* KBS = (u16*)(p.ws + WS_KBS);
    for (int i = gt; i < 1048576; i += gn) {
      int e = i * 4, b = e >> 19, key = (e >> 9) & 1023, f = e & 511;
      float4 v = *(const float4*)(p.cache_b_k + e);
      uint2 o; o.x = pk2(v.x, v.y); o.y = pk2(v.z, v.w);
      *(uint2*)(KBS + (size_t)(b * 1056 + key) * 512 + f) = o;
    }
    u16* VATS = (u16*)(p.ws + WS_VATS);
    for (int i = gt; i < 262144; i += gn) {
      int f = i & 511, kg = (i >> 9) & 63, b = i >> 15;
      float v[8];
#pragma unroll
      for (int j = 0; j < 8; ++j) v[j] = p.cache_a_v[(size_t)(b * 512 + kg * 8 + j) * 512 + f];
      uint4 o; o.x = pk2(v[0], v[1]); o.y = pk2(v[2], v[3]); o.z = pk2(v[4], v[5]); o.w = pk2(v[6], v[7]);
      *(uint4*)(VATS + (size_t)(b * 512 + f) * 544 + kg * 8) = o;
      if (kg >= 4) {
#pragma unroll
        for (int j = 0; j < 8; ++j) p.out[O_AVS + (size_t)(b * 512 + kg * 8 + j - 32) * 512 + f] = v[j];
      }
    }
    u16* VBTS = (u16*)(p.ws + WS_VBTS);
    for (int i = gt; i < 524288; i += gn) {
      int f = i & 511, kg = (i >> 9) & 127, b = i >> 16;
      float v[8];
#pragma unroll
      for (int j = 0; j < 8; ++j) v[j] = p.cache_b_v[(size_t)(b * 1024 + kg * 8 + j) * 512 + f];
      uint4 o; o.x = pk2(v[0], v[1]); o.y = pk2(v[2], v[3]); o.z = pk2(v[4], v[5]); o.w = pk2(v[6], v[7]);
      *(uint4*)(VBTS + (size_t)(b * 512 + f) * 1056 + kg * 8) = o;
    }
  }
  {
    float2* RT = (float2*)(p.ws + WS_ROPE);
    for (int i = gt; i < 65536; i += gn) {
      int pos = i >> 3, m = i & 7;
      float inv = powf(500000.f, -(float)m * 0.125f);
      float ang = (float)pos * inv;
      RT[i] = make_float2(cosf(ang), sinf(ang));
    }
  }
}

template <bool SWAP>
DI void gemm_mainloop(const u16* __restrict__ A, const u16* __restrict__ Bt, int tm, int tn, char* lds, f32x16 (&acc)[2][2]) {
  const int tid = threadIdx.x, lane = tid & 63, w = tid >> 6, wm = w >> 1, wn = w & 1;
  const int r = lane & 31, h = lane >> 5;
  const u16* pa = A + (size_t)(tm * 256 + (tid >> 3)) * 1024 + (tid & 7) * 8;
  const u16* pb = Bt + (size_t)(tn * 128 + (tid >> 3)) * 1024 + (tid & 7) * 8;
  const int wofs = (tid >> 3) * 128 + ((((tid & 7) ^ ((tid >> 4) & 7))) << 4);
  const int swr = (r >> 1) & 7;
  uint4 ra[4], rb[2];
#pragma unroll
  for (int i = 0; i < 2; ++i)
#pragma unroll
    for (int j = 0; j < 2; ++j)
#pragma unroll
      for (int e = 0; e < 16; ++e) acc[i][j][e] = 0.f;
#pragma unroll
  for (int it = 0; it < 4; ++it) ra[it] = *(const uint4*)(pa + (size_t)it * 65536);
#pragma unroll
  for (int it = 0; it < 2; ++it) rb[it] = *(const uint4*)(pb + (size_t)it * 65536);
#pragma unroll
  for (int it = 0; it < 4; ++it) *(uint4*)(lds + it * 8192 + wofs) = ra[it];
#pragma unroll
  for (int it = 0; it < 2; ++it) *(uint4*)(lds + 32768 + it * 8192 + wofs) = rb[it];
  __syncthreads();
  for (int kt = 0; kt < 16; ++kt) {
    if (kt + 1 < 16) {
#pragma unroll
      for (int it = 0; it < 4; ++it) gld16(ra[it], pa + (size_t)it * 65536 + (kt + 1) * 64);
#pragma unroll
      for (int it = 0; it < 2; ++it) gld16(rb[it], pb + (size_t)it * 65536 + (kt + 1) * 64);
    }
    __builtin_amdgcn_sched_barrier(0);
    const char* ba = lds + (kt & 1) * 49152;
    const char* bb = ba + 32768;
    bf16x8 hf[2][2], wf[2][2];
    {
      const int co = ((h ^ swr) << 4);
#pragma unroll
      for (int i = 0; i < 2; ++i) hf[0][i] = *(const bf16x8*)(ba + (wm * 64 + i * 32 + r) * 128 + co);
#pragma unroll
      for (int j = 0; j < 2; ++j) wf[0][j] = *(const bf16x8*)(bb + (wn * 64 + j * 32 + r) * 128 + co);
    }
#pragma unroll
    for (int s = 0; s < 4; ++s) {
      if (s < 3) {
        const int co = (((2 * (s + 1) + h) ^ swr) << 4);
#pragma unroll
        for (int i = 0; i < 2; ++i) hf[(s + 1) & 1][i] = *(const bf16x8*)(ba + (wm * 64 + i * 32 + r) * 128 + co);
#pragma unroll
        for (int j = 0; j < 2; ++j) wf[(s + 1) & 1][j] = *(const bf16x8*)(bb + (wn * 64 + j * 32 + r) * 128 + co);
      }
#pragma unroll
      for (int i = 0; i < 2; ++i)
#pragma unroll
        for (int j = 0; j < 2; ++j) {
          if (SWAP) acc[j][i] = MFMA(wf[s & 1][j], hf[s & 1][i], acc[j][i]);
          else acc[i][j] = MFMA(hf[s & 1][i], wf[s & 1][j], acc[i][j]);
        }
      __builtin_amdgcn_sched_barrier(0);
    }
    if (kt + 1 < 16) {
      char* bw = lds + ((kt + 1) & 1) * 49152;
      wait_vm0();
#pragma unroll
      for (int it = 0; it < 4; ++it) *(uint4*)(bw + it * 8192 + wofs) = ra[it];
#pragma unroll
      for (int it = 0; it < 2; ++it) *(uint4*)(bw + 32768 + it * 8192 + wofs) = rb[it];
    }
    __syncthreads();
  }
}

DI float silu(float x) { return x / (1.f + __expf(-x)); }

DI float dpp_x1(float v) { return __int_as_float(__builtin_amdgcn_update_dpp(0, __float_as_int(v), 0xB1, 0xF, 0xF, true)); }
DI float dpp_x8(float v) { return __int_as_float(__builtin_amdgcn_update_dpp(0, __float_as_int(v), 0x128, 0xF, 0xF, true)); }
DI void store_bf16_tile(const f32x16& a, u16* base  , size_t ld, int h, int odd) {
#pragma unroll
  for (int g = 0; g < 4; ++g)
#pragma unroll
    for (int e = 0; e < 4; e += 2) {
      const float v0 = a[4 * g + e], v1 = a[4 * g + e + 1];
      const float n0 = dpp_x1(v0), n1 = dpp_x1(v1);
      const u32 o = odd ? pk2(n1, v1) : pk2(v0, n0);
      *(u32*)(base + (size_t)(8 * g + 4 * h + e + odd) * ld) = o;
      if (e == 2) __builtin_amdgcn_sched_barrier(0);
    }
}
DI void phase1(const Params& p, char* lds) {
  const u16* HN = (const u16*)(p.ws + WS_HN);
  const u16* WT = (const u16*)(p.ws + WS_WINT);
  const float2* RT = (const float2*)(p.ws + WS_ROPE);
  for (int tile = blockIdx.x; tile < 65 * 32; tile += gridDim.x) {
    const int tm = tile >> 5, tn = tile & 31;
    const int sec = tn >> 2;
    const bool sample = (tm == 64);
    f32x16 acc[2][2];
    gemm_mainloop<false>(HN, WT, tm, tn, lds, acc);
    int tid = threadIdx.x;
    asm volatile("" : "+v"(tid));
    const int lane = tid & 63, w = tid >> 6, wm = w >> 1, wn = w & 1;
    const int r = lane & 31, h = lane >> 5, odd = r & 1;
    const int tb = tm * 256 + wm * 64;
    const int fb = (tn & 3) * 128 + wn * 64;
    if (sec == 2 || sec == 6) {
#pragma unroll
      for (int i = 0; i < 2; ++i)
#pragma unroll
        for (int j = 0; j < 2; ++j) {
          const int fs = fb + j * 32 + r;
          char* trow = lds + (wn * 64 + j * 32 + r) * 528 + (wm * 64 + i * 32 + 4 * h) * 2;
#pragma unroll
          for (int g = 0; g < 4; ++g) {
            const int t = tb + i * 32 + 8 * g + 4 * h;
            const float v0 = acc[i][j][4 * g], v1 = acc[i][j][4 * g + 1], v2 = acc[i][j][4 * g + 2], v3 = acc[i][j][4 * g + 3];
            uint2 o; o.x = pk2(v0, v1); o.y = pk2(v2, v3);
            *(uint2*)(trow + g * 16) = o;
            float* d = nullptr;
            if (!sample) {
              const int b = t >> 13, s = t & 8191;
              if (sec == 6) d = p.out + O_BVP + (size_t)t * 512 + fs;
              else if (s >= 7680) d = p.out + O_AVP + ((size_t)(b * 512 + s - 7680)) * 512 + fs;
            } else {
              const int ts = t - NTOKP, b = ts >> 5, tt = ts & 31;
              if (sec == 6) d = p.out + O_BVS + (size_t)ts * 512 + fs;
              else d = p.out + O_AVS + ((size_t)(b * 512 + 480 + tt)) * 512 + fs;
            }
            if (d) { d[0] = v0; d[512] = v1; d[1024] = v2; d[1536] = v3; }
            __builtin_amdgcn_sched_barrier(0);
          }
        }
      __syncthreads();
      {
        u16* VT; size_t ldv;
        if (sec == 2) { VT = (u16*)(p.ws + (sample ? WS_VATS : WS_VAT)); ldv = sample ? 544 : 8192; }
        else { VT = (u16*)(p.ws + (sample ? WS_VBTS : WS_VBT)); ldv = sample ? 1056 : 8192; }
        const int sofs = sample ? (sec == 2 ? 512 : 1024) : 0;
#pragma unroll
        for (int it = 0; it < 8; ++it) {
          const int id = it * 512 + tid, row = id >> 5, c = id & 31;
          const uint4 v = *(const uint4*)(lds + row * 528 + c * 16);
          const int fs = (tn & 3) * 128 + row;
          if (!sample) {
            const int t0 = tm * 256 + c * 8, b = t0 >> 13, s = t0 & 8191;
            *(uint4*)(VT + ((size_t)(b * 512 + fs)) * ldv + s) = v;
          } else {
            const int b = c >> 2, tt = (c & 3) * 8;
            *(uint4*)(VT + ((size_t)(b * 512 + fs)) * ldv + sofs + tt) = v;
          }
        }
      }
      __syncthreads();
    } else {
      if (sec == 4 || sec == 5) {
        const float sgn = (r & 8) ? 1.f : -1.f;
        const int pos0 = sample ? (1024 + 4 * h) : ((tb & 8191) + 4 * h);
        const float2* rt = RT + pos0 * 8 + (r & 7);
#pragma unroll
        for (int i = 0; i < 2; ++i)
#pragma unroll
          for (int g = 0; g < 4; ++g) {
            const int po = (sample ? 0 : i * 32) + 8 * g;
            float2 cs[4];
#pragma unroll
            for (int e = 0; e < 4; ++e) cs[e] = rt[(po + e) * 8];
            __builtin_amdgcn_sched_barrier(0);
#pragma unroll
            for (int e = 0; e < 4; ++e) {
              const float x = acc[i][0][4 * g + e];
              const float xp = dpp_x8(x);
              if (r < 16) acc[i][0][4 * g + e] = x * cs[e].x + sgn * xp * cs[e].y;
            }
            __builtin_amdgcn_sched_barrier(0);
          }
      }
      if (sec == 3 || sec == 7) {
#pragma unroll
        for (int i = 0; i < 2; ++i)
#pragma unroll
          for (int j = 0; j < 2; ++j)
#pragma unroll
            for (int e = 0; e < 16; ++e) acc[i][j][e] = silu(acc[i][j][e]);
      }
      u16* dst; size_t trow0;
      if (sec == 0) { dst = (u16*)(p.ws + WS_QA); trow0 = tb; }
      else if (sec == 3) { dst = (u16*)(p.ws + WS_GA); trow0 = tb; }
      else if (sec == 4) { dst = (u16*)(p.ws + WS_QB); trow0 = tb; }
      else if (sec == 7) { dst = (u16*)(p.ws + WS_GB); trow0 = tb; }
      else if (sec == 1) {
        if (!sample) { dst = (u16*)(p.ws + WS_KA); trow0 = tb; }
        else { dst = (u16*)(p.ws + WS_KAS); trow0 = (size_t)(wm * 2) * 544 + 512; }
      } else {
        if (!sample) { dst = (u16*)(p.ws + WS_KB); trow0 = tb; }
        else { dst = (u16*)(p.ws + WS_KBS); trow0 = (size_t)(wm * 2) * 1056 + 1024; }
      }
      const size_t istep = sample ? (sec == 1 ? 544 : (sec == 5 ? 1056 : 32)) : 32;
#pragma unroll
      for (int i = 0; i < 2; ++i)
#pragma unroll
        for (int j = 0; j < 2; ++j)
          store_bf16_tile(acc[i][j], dst + (trow0 + i * istep) * 512 + fb + j * 32 + (r & ~1), 512, h, odd);
      if (sec == 1 || sec == 5) {
#pragma unroll
        for (int i = 0; i < 2; ++i) {
          float* d = nullptr;
          const int t0 = tb + i * 32;
          if (!sample) {
            const int b = t0 >> 13, s = t0 & 8191;
            if (sec == 5) d = p.out + O_BKP + (size_t)t0 * 512;
            else if (s >= 7680) d = p.out + O_AKP + ((size_t)(b * 512 + s - 7680)) * 512;
          } else {
            const int ts = t0 - NTOKP, b = ts >> 5;
            if (sec == 5) d = p.out + O_BKS + (size_t)ts * 512;
            else d = p.out + O_AKS + ((size_t)(b * 512 + 480)) * 512;
          }
          if (d) {
#pragma unroll
            for (int j = 0; j < 2; ++j)
#pragma unroll
              for (int e = 0; e < 16; ++e) {
                d[(size_t)(8 * (e >> 2) + 4 * h + (e & 3)) * 512 + fb + j * 32 + r] = acc[i][j][e];
                if ((e & 3) == 3) __builtin_amdgcn_sched_barrier(0);
              }
          }
        }
      }
    }
  }
}

constexpr float SM_C = 0.125f * 1.4426950408889634f;
template <int NQT, int DVT, bool BIAS>
DI void attn_wave(const u16* __restrict__ Q, int ldq, const u16* __restrict__ K, int ldk,
                  const u16* __restrict__ Vt, int ldv, int nkt, const float* bias_l2, int rel0,
                  f32x16 (&O)[NQT][DVT], float (&Mx)[NQT], float (&L)[NQT]) {
  const int lane = threadIdx.x & 63, r = lane & 31, h = lane >> 5;
  bf16x8 qf[NQT][4];
#pragma unroll
  for (int u = 0; u < NQT; ++u)
#pragma unroll
    for (int s = 0; s < 4; ++s) qf[u][s] = *(const bf16x8*)(Q + (size_t)(32 * u + r) * ldq + 16 * s + 8 * h);
#pragma unroll
  for (int u = 0; u < NQT; ++u) {
    Mx[u] = -INFINITY; L[u] = 0.f;
#pragma unroll
    for (int dt = 0; dt < DVT; ++dt)
#pragma unroll
      for (int e = 0; e < 16; ++e) O[u][dt][e] = 0.f;
  }
  const u16* kp = K + (size_t)rho(r) * ldk + 8 * h;
  const u16* vp = Vt + (size_t)r * ldv + 8 * h;
  bf16x8 kf[4];
#pragma unroll
  for (int s = 0; s < 4; ++s) kf[s] = *(const bf16x8*)(kp + 16 * s);
  for (int kt = 0; kt < nkt; ++kt) {
    bf16x8 vf[DVT][2];
#pragma unroll
    for (int dt = 0; dt < DVT; ++dt)
#pragma unroll
      for (int s2 = 0; s2 < 2; ++s2) vf[dt][s2] = *(const bf16x8*)(vp + (size_t)(32 * dt) * ldv + 32 * kt + 16 * s2);
    bf16x8 kn[4];
    {
      const int ktn = (kt + 1 < nkt) ? kt + 1 : kt;
#pragma unroll
      for (int s = 0; s < 4; ++s) kn[s] = *(const bf16x8*)(kp + (size_t)(32 * ktn) * ldk + 16 * s);
    }
    bf16x8 pf[NQT][2];
#pragma unroll
    for (int u = 0; u < NQT; ++u) {
      f32x16 S;
#pragma unroll
      for (int e = 0; e < 16; ++e) S[e] = 0.f;
#pragma unroll
      for (int s = 0; s < 4; ++s) S = MFMA(kf[s], qf[u][s], S);
      float t[16];
      if (BIAS) {
        const int relb = rel0 + 32 * u + r - 32 * kt - 8 * h;
        if (rel0 - 32 * kt - 31 >= 128) {
          const float bv = bias_l2[256];
#pragma unroll
          for (int e = 0; e < 16; ++e) t[e] = S[e] * SM_C + bv;
        } else {
#pragma unroll
          for (int e = 0; e < 16; ++e) {
            int rel = relb - ((e & 7) + 16 * (e >> 3));
            rel = rel < -128 ? -128 : (rel > 128 ? 128 : rel);
            t[e] = S[e] * SM_C + bias_l2[rel + 128];
          }
        }
      } else {
#pragma unroll
        for (int e = 0; e < 16; ++e) t[e] = S[e] * SM_C;
      }
      float mx = t[0];
#pragma unroll
      for (int e = 1; e < 16; ++e) mx = fmaxf(mx, t[e]);
      mx = fmaxf(mx, __shfl_xor(mx, 32));
      if (__any(mx > Mx[u] + 8.f)) {
        const float mn = fmaxf(Mx[u], mx);
        const float al = __builtin_amdgcn_exp2f(Mx[u] - mn);
        Mx[u] = mn; L[u] *= al;
#pragma unroll
        for (int dt = 0; dt < DVT; ++dt)
#pragma unroll
          for (int e = 0; e < 16; ++e) O[u][dt][e] *= al;
      }
      float ps = 0.f;
#pragma unroll
      for (int e = 0; e < 16; ++e) { t[e] = __builtin_amdgcn_exp2f(t[e] - Mx[u]); ps += t[e]; }
      L[u] += ps;
#pragma unroll
      for (int s2 = 0; s2 < 2; ++s2) {
        uint4 pk;
        pk.x = pk2(t[8 * s2], t[8 * s2 + 1]); pk.y = pk2(t[8 * s2 + 2], t[8 * s2 + 3]);
        pk.z = pk2(t[8 * s2 + 4], t[8 * s2 + 5]); pk.w = pk2(t[8 * s2 + 6], t[8 * s2 + 7]);
        pf[u][s2] = __builtin_bit_cast(bf16x8, pk);
      }
    }
#pragma unroll
    for (int u = 0; u < NQT; ++u)
#pragma unroll
      for (int dt = 0; dt < DVT; ++dt)
#pragma unroll
        for (int s2 = 0; s2 < 2; ++s2) O[u][dt] = MFMA(vf[dt][s2], pf[u][s2], O[u][dt]);
#pragma unroll
    for (int s = 0; s < 4; ++s) kf[s] = kn[s];
  }
#pragma unroll
  for (int u = 0; u < NQT; ++u) L[u] += __shfl_xor(L[u], 32);
}

template <int NQT>
DI void attnA_item(const Params& p, const u16* Q, const u16* K, const u16* Vt, int ldv, int nkt, int rel0,
                   const float* bias_l2, int tok0, int head) {
  f32x16 O[NQT][2]; float Mx[NQT], L[NQT];
  attn_wave<NQT, 2, true>(Q, 512, K, 512, Vt, ldv, nkt, bias_l2, rel0, O, Mx, L);
  const int lane = threadIdx.x & 63, r = lane & 31, h = lane >> 5;
  const u16* GA = (const u16*)(p.ws + WS_GA);
  u16* OB = (u16*)(p.ws + WS_HN);
#pragma unroll
  for (int u = 0; u < NQT; ++u) {
    const float inv = 1.f / L[u];
    const size_t tok = (size_t)(tok0 + 32 * u + r);
#pragma unroll
    for (int dt = 0; dt < 2; ++dt)
#pragma unroll
      for (int g = 0; g < 4; ++g) {
        const int dv = 32 * dt + 8 * g + 4 * h;
        const uint2 gg = *(const uint2*)(GA + tok * 512 + head * 64 + dv);
        uint2 o;
        o.x = pk2(O[u][dt][4 * g] * inv * bflo(gg.x), O[u][dt][4 * g + 1] * inv * bfhi(gg.x));
        o.y = pk2(O[u][dt][4 * g + 2] * inv * bflo(gg.y), O[u][dt][4 * g + 3] * inv * bfhi(gg.y));
        *(uint2*)(OB + tok * 1024 + head * 64 + dv) = o;
      }
  }
}

DI void attnB_epilogue(const Params& p, f32x16 (&O)[4], float Lsum, int tok0, int hb, float lam, float* xch) {
  const int lane = threadIdx.x & 63, r = lane & 31, h = lane >> 5, w = threadIdx.x >> 6, m = w >> 2, wsub = w & 3;
  const float inv = 1.f / Lsum;
  float* xw = xch + wsub * 4096 + lane;
  if (m == 1) {
    const float sc = inv * lam;
#pragma unroll
    for (int dt = 0; dt < 4; ++dt)
#pragma unroll
      for (int e = 0; e < 16; ++e) xw[(dt * 16 + e) * 64] = O[dt][e] * sc;
  }
  __syncthreads();
  if (m == 0) {
    float ss = 0.f;
#pragma unroll
    for (int dt = 0; dt < 4; ++dt)
#pragma unroll
      for (int e = 0; e < 16; ++e) { float o = O[dt][e] * inv - xw[(dt * 16 + e) * 64]; O[dt][e] = o; ss += o * o; }
    ss += __shfl_xor(ss, 32);
    const float rn = rsqrtf(ss * (1.f / 128.f) + 1e-6f) * 0.8f;
    const u16* GB = (const u16*)(p.ws + WS_GB);
    u16* OB = (u16*)(p.ws + WS_HN);
    const size_t tok = (size_t)(tok0 + r);
#pragma unroll
    for (int dt = 0; dt < 4; ++dt)
#pragma unroll
      for (int g = 0; g < 4; ++g) {
        const int dv = 32 * dt + 8 * g + 4 * h;
        const uint2 gg = *(const uint2*)(GB + tok * 512 + hb * 128 + dv);
        const float4 sg = *(const float4*)(p.subln + dv);
        uint2 o;
        o.x = pk2(O[dt][4 * g] * rn * sg.x * bflo(gg.x), O[dt][4 * g + 1] * rn * sg.y * bfhi(gg.x));
        o.y = pk2(O[dt][4 * g + 2] * rn * sg.z * bflo(gg.y), O[dt][4 * g + 3] * rn * sg.w * bfhi(gg.y));
        *(uint2*)(OB + tok * 1024 + 512 + hb * 128 + dv) = o;
      }
  }
  __syncthreads();
}

DI void attnB_item(const Params& p, const u16* Q, const u16* K, const u16* Vt, int ldv, int nkt, int tok0, int hb,
                   float lam, float* xch) {
  f32x16 O[1][4]; float Mx[1], L[1];
  attn_wave<1, 4, false>(Q, 512, K, 512, Vt, ldv, nkt, nullptr, 0, O, Mx, L);
  attnB_epilogue(p, O[0], L[0], tok0, hb, lam, xch);
}

DI void attnB_block(const Params& p, int b, int hb, int qt, float lam, char* lds, float* xch) {
  const int tid = threadIdx.x, lane = tid & 63, r = lane & 31, h = lane >> 5, w = tid >> 6, m = w >> 2, wsub = w & 3;
  const int q0 = qt * 128 + wsub * 32;
  const int nt = 2 * qt + 2;
  const int my_nt = (q0 >> 6) + 1;
  uint4 qraw[4];
  {
    const u16* Q = (const u16*)(p.ws + WS_QB) + (size_t)(b * SEQ + q0 + r) * 512 + hb * 128 + m * 64 + 8 * h;
#pragma unroll
    for (int s = 0; s < 4; ++s) gld16(qraw[s], Q + 16 * s);
  }
  f32x16 O[4];
#pragma unroll
  for (int dt = 0; dt < 4; ++dt)
#pragma unroll
    for (int e = 0; e < 16; ++e) O[dt][e] = 0.f;
  float Mx = -INFINITY, L = 0.f;
  const u16* gk = (const u16*)(p.ws + WS_KB) + (size_t)(b * SEQ + (tid >> 4)) * 512 + hb * 128 + (tid & 15) * 8;
  const u16* gv = (const u16*)(p.ws + WS_VBT) + (size_t)(b * 512 + hb * 128 + (tid >> 3)) * SEQ + (tid & 7) * 8;
  const int lk = ((tid >> 3) & 1) * 8192 + (tid >> 4) * 128 + ((((tid & 7) ^ ((tid >> 5) & 7))) << 4);
  const int lv = 16384 + (tid >> 3) * 128 + ((((tid & 7) ^ ((tid >> 4) & 7))) << 4);
  const int rr = rho(r);
  const int swk = (rr >> 1) & 7, swv = (r >> 1) & 7;
  uint4 sk0, sk1, sv0, sv1;
  sk0 = *(const uint4*)(gk); sk1 = *(const uint4*)(gk + (size_t)32 * 512);
  sv0 = *(const uint4*)(gv); sv1 = *(const uint4*)(gv + (size_t)64 * SEQ);
  *(uint4*)(lds + lk) = sk0; *(uint4*)(lds + lk + 4096) = sk1;
  *(uint4*)(lds + lv) = sv0; *(uint4*)(lds + lv + 8192) = sv1;
  wait_vm0();
  bf16x8 qf[4];
#pragma unroll
  for (int s = 0; s < 4; ++s) qf[s] = __builtin_bit_cast(bf16x8, qraw[s]);
  __syncthreads();
  for (int t = 0; t < nt; ++t) {
    if (t + 1 < nt) {
      gld16(sk0, gk + (size_t)(64 * (t + 1)) * 512);
      gld16(sk1, gk + (size_t)(64 * (t + 1) + 32) * 512);
      gld16(sv0, gv + 64 * (t + 1));
      gld16(sv1, gv + (size_t)64 * SEQ + 64 * (t + 1));
    }
    __builtin_amdgcn_sched_barrier(0);
    if (t < my_nt) {
      const char* kb = lds + (t & 1) * 32768 + m * 8192;
      const char* vb = lds + (t & 1) * 32768 + 16384;
      f32x16 S0, S1;
#pragma unroll
      for (int e = 0; e < 16; ++e) { S0[e] = 0.f; S1[e] = 0.f; }
      bf16x8 ka[4], kc[4];
#pragma unroll
      for (int s = 0; s < 4; ++s) {
        const int co = (((2 * s + h) ^ swk) << 4);
        ka[s] = *(const bf16x8*)(kb + rr * 128 + co);
        kc[s] = *(const bf16x8*)(kb + (32 + rr) * 128 + co);
      }
      __builtin_amdgcn_sched_barrier(0);
#pragma unroll
      for (int s = 0; s < 4; ++s) {
        S0 = MFMA(ka[s], qf[s], S0);
        S1 = MFMA(kc[s], qf[s], S1);
      }
      float mx = fmaxf(S0[0], S1[0]);
#pragma unroll
      for (int e = 1; e < 16; ++e) mx = fmaxf(mx, fmaxf(S0[e], S1[e]));
      mx *= SM_C;
      mx = fmaxf(mx, __shfl_xor(mx, 32));
      if (__any(mx > Mx + 8.f)) {
        const float mn = fmaxf(Mx, mx);
        const float al = __builtin_amdgcn_exp2f(Mx - mn);
        Mx = mn; L *= al;
#pragma unroll
        for (int dt = 0; dt < 4; ++dt)
#pragma unroll
          for (int e = 0; e < 16; ++e) O[dt][e] *= al;
      }
      float ps = 0.f;
#pragma unroll
      for (int e = 0; e < 16; ++e) {
        S0[e] = __builtin_amdgcn_exp2f(fmaf(S0[e], SM_C, -Mx));
        S1[e] = __builtin_amdgcn_exp2f(fmaf(S1[e], SM_C, -Mx));
        ps += S0[e] + S1[e];
      }
      L += ps;
      bf16x8 pf[4];
#pragma unroll
      for (int s2 = 0; s2 < 2; ++s2) {
        uint4 pa, pb;
        pa.x = pk2(S0[8 * s2], S0[8 * s2 + 1]); pa.y = pk2(S0[8 * s2 + 2], S0[8 * s2 + 3]);
        pa.z = pk2(S0[8 * s2 + 4], S0[8 * s2 + 5]); pa.w = pk2(S0[8 * s2 + 6], S0[8 * s2 + 7]);
        pb.x = pk2(S1[8 * s2], S1[8 * s2 + 1]); pb.y = pk2(S1[8 * s2 + 2], S1[8 * s2 + 3]);
        pb.z = pk2(S1[8 * s2 + 4], S1[8 * s2 + 5]); pb.w = pk2(S1[8 * s2 + 6], S1[8 * s2 + 7]);
        pf[s2] = __builtin_bit_cast(bf16x8, pa);
        pf[2 + s2] = __builtin_bit_cast(bf16x8, pb);
      }
#pragma unroll
      for (int ks = 0; ks < 4; ++ks) {
        const int co = (((2 * ks + h) ^ swv) << 4);
#pragma unroll
        for (int dt = 0; dt < 4; ++dt) {
          bf16x8 v = *(const bf16x8*)(vb + (32 * dt + r) * 128 + co);
          O[dt] = MFMA(v, pf[ks], O[dt]);
        }
      }
    }
    if (t + 1 < nt) {
      char* bw = lds + ((t + 1) & 1) * 32768;
      wait_vm0();
      *(uint4*)(bw + lk) = sk0; *(uint4*)(bw + lk + 4096) = sk1;
      *(uint4*)(bw + lv) = sv0; *(uint4*)(bw + lv + 8192) = sv1;
    }
    __syncthreads();
  }
  L += __shfl_xor(L, 32);
  attnB_epilogue(p, O, L, b * SEQ + q0, hb, lam, xch);
}

DI float phase2_setup(const Params& p, char* lds) {
  const int tid = threadIdx.x, lane = tid & 63;
  float* bias = (float*)(lds + 131072);
  for (int i = tid; i < 8 * 257; i += 512) { int hh = i / 257, k = i - hh * 257; bias[hh * 260 + k] = p.rel_bias[i] * 1.4426950408889634f; }
  float a = p.lq1[lane] * p.lk1[lane], b = p.lq2[lane] * p.lk2[lane];
  a = wave_sum(a); b = wave_sum(b);
  __syncthreads();
  return expf(a) - expf(b) + 0.2f;
}
DI void p2_bprompt(const Params& p, char* lds, float lam) {
  float* xch = (float*)(lds + 65536);
  for (int item = blockIdx.x; item < 256; item += gridDim.x) {
    const int bh = item & 7, i0 = item >> 3, b = bh >> 2, hb = bh & 3;
#pragma unroll 1
    for (int rep = 0; rep < 2; ++rep) attnB_block(p, b, hb, rep ? 63 - i0 : i0, lam, lds, xch);
  }
}
DI void p2_aprompt(const Params& p, char* lds) {
  const int w = threadIdx.x >> 6;
  const float* bias = (const float*)(lds + 131072);
  const u16* QA = (const u16*)(p.ws + WS_QA);
  for (int it = blockIdx.x; it < 256; it += gridDim.x) {
    const int b = it >> 7, c = it & 127, cs = c > 8 ? c - 8 : 0;
    attnA_item<2>(p, QA + (size_t)(b * SEQ + c * 64) * 512 + w * 64,
                  (const u16*)(p.ws + WS_KA) + (size_t)(b * SEQ + cs * 64) * 512 + w * 64,
                  (const u16*)(p.ws + WS_VAT) + (size_t)(b * 512 + w * 64) * SEQ + cs * 64, SEQ,
                  (c + 1 - cs) * 2, 64 * (c - cs), bias + w * 260, b * SEQ + c * 64, w);
  }
}
DI void p2_sample(const Params& p, char* lds, float lam) {
  const int w = threadIdx.x >> 6;
  float* xch = (float*)(lds + 65536);
  const float* bias = (const float*)(lds + 131072);
  const u16* QA = (const u16*)(p.ws + WS_QA);
  const u16* QB = (const u16*)(p.ws + WS_QB);
  for (int it = blockIdx.x; it < 8; it += gridDim.x) {
    const int m = w >> 2, wsub = w & 3, id = it * 4 + wsub, b = id >> 2, hb = id & 3;
    attnB_item(p, QB + (size_t)(NTOKP + b * 32) * 512 + hb * 128 + m * 64,
               (const u16*)(p.ws + WS_KBS) + (size_t)(b * 1056) * 512 + hb * 128 + m * 64,
               (const u16*)(p.ws + WS_VBTS) + (size_t)(b * 512 + hb * 128) * 1056, 1056, 33, NTOKP + b * 32, hb, lam, xch);
  }
  for (int it = (int)((blockIdx.x + gridDim.x - 8) % gridDim.x); it < 8; it += gridDim.x) {
    const int b = it;
    attnA_item<1>(p, QA + (size_t)(NTOKP + b * 32) * 512 + w * 64,
                  (const u16*)(p.ws + WS_KAS) + (size_t)(b * 544) * 512 + w * 64,
                  (const u16*)(p.ws + WS_VATS) + (size_t)(b * 512 + w * 64) * 544, 544, 17, 512, bias + w * 260,
                  NTOKP + b * 32, w);
  }
}

DI void phase3(const Params& p, char* lds) {
  const u16* OB = (const u16*)(p.ws + WS_HN);
  const u16* WT = (const u16*)(p.ws + WS_WOUTT);
  for (int tile = blockIdx.x; tile < 65 * 8; tile += gridDim.x) {
    const int tm = tile >> 3, tn = tile & 7;
    f32x16 acc[2][2];
    gemm_mainloop<false>(OB, WT, tm, tn, lds, acc);
    int tid = threadIdx.x;
    asm volatile("" : "+v"(tid));
    const int lane = tid & 63, w = tid >> 6, wm = w >> 1, wn = w & 1;
    const int r = lane & 31, h = lane >> 5;
#pragma unroll
    for (int i = 0; i < 2; ++i) {
      const int t0 = tm * 256 + wm * 64 + i * 32;
      const float* xr = t0 < NTOKP ? p.x_prompt + (size_t)t0 * 1024 : p.x_sample + (size_t)(t0 - NTOKP) * 1024;
      float* yr = p.out + O_YP + (size_t)t0 * 1024;
#pragma unroll
      for (int j = 0; j < 2; ++j) {
        const int f = tn * 128 + wn * 64 + j * 32 + r;
#pragma unroll
        for (int e = 0; e < 16; ++e) {
          const size_t o = (size_t)(8 * (e >> 2) + 4 * h + (e & 3)) * 1024 + f;
          yr[o] = xr[o] + acc[i][j][e];
          if ((e & 3) == 3) __builtin_amdgcn_sched_barrier(0);
        }
      }
    }
  }
}

DI void phase4(const Params& p) {
  const int lane = threadIdx.x & 63, w = threadIdx.x >> 6;
  for (int row = blockIdx.x * 8 + w; row < NTOK; row += gridDim.x * 8) {
    float* y = p.out + O_YP + (size_t)row * 1024;
    float4 v[4]; float ss = 0.f;
#pragma unroll
    for (int it = 0; it < 4; ++it) { v[it] = *(const float4*)(y + it * 256 + lane * 4); ss += v[it].x * v[it].x + v[it].y * v[it].y + v[it].z * v[it].z + v[it].w * v[it].w; }
    ss = wave_sum(ss);
    const float inv = rsqrtf(ss * (1.f / 1024.f) + 1e-6f);
#pragma unroll
    for (int it = 0; it < 4; ++it) {
      float4 g = *(const float4*)(p.final_gain + it * 256 + lane * 4);
      *(float4*)(y + it * 256 + lane * 4) = make_float4(v[it].x * inv * g.x, v[it].y * inv * g.y, v[it].z * inv * g.z, v[it].w * inv * g.w);
    }
  }
}

__global__ void __launch_bounds__(512) fwd_megakernel(Params p) {
  __shared__ __attribute__((aligned(16))) char lds[143360];
  cg::grid_group grid = cg::this_grid();
  unsigned* ctr = (unsigned*)(p.ws + WS_BAR);
  const unsigned G = gridDim.x;
  if (blockIdx.x == 0 && threadIdx.x == 0) *ctr = 0u;
  phase0(p, lds);
  grid.sync();
  phase1(p, lds);
  ctr_barrier(ctr, G);
  {
    const float lam = phase2_setup(p, lds);
    p2_bprompt(p, lds, lam);
    p2_aprompt(p, lds);
    p2_sample(p, lds, lam);
  }
  ctr_barrier(ctr, 2 * G);
  phase3(p, lds);
  ctr_barrier(ctr, 3 * G);
  phase4(p);
}

extern "C" void kernel_launch(void* const* d_in, const int* in_sizes, int n_in, void* d_out, int out_size, void* d_ws,
                              size_t ws_size, hipStream_t stream) {
  static int grid_blocks = 0;
  if (!grid_blocks) {
    int dev = 0, cus = 0, per_cu = 0;
    hipGetDevice(&dev);
    hipDeviceGetAttribute(&cus, hipDeviceAttributeMultiprocessorCount, dev);
    hipOccupancyMaxActiveBlocksPerMultiprocessor(&per_cu, fwd_megakernel, 512, 0);
    if (per_cu < 1) per_cu = 1;
    grid_blocks = cus;
  }
  Params p{};
  p.x_prompt = (const float*)d_in[0]; p.x_sample = (const float*)d_in[1];
  p.cache_a_k = (const float*)d_in[2]; p.cache_a_v = (const float*)d_in[3];
  p.cache_b_k = (const float*)d_in[4]; p.cache_b_v = (const float*)d_in[5];
  p.norm_gain = (const float*)d_in[6]; p.w_in = (const float*)d_in[7]; p.w_out = (const float*)d_in[8];
  p.rel_bias = (const float*)d_in[9];
  p.lq1 = (const float*)d_in[10]; p.lk1 = (const float*)d_in[11]; p.lq2 = (const float*)d_in[12]; p.lk2 = (const float*)d_in[13];
  p.subln = (const float*)d_in[14]; p.final_gain = (const float*)d_in[15];
  p.out = (float*)d_out; p.ws = (char*)d_ws;
  void* args[] = {&p};
  hipError_t e = hipLaunchCooperativeKernel((void*)fwd_megakernel, dim3(grid_blocks), dim3(512), args, 0, stream);
  if (e != hipSuccess) fprintf(stderr, "cooperative launch failed: %s (grid %d)\n", hipGetErrorString(e), grid_blocks);
}
```

```cpp
#include <hip/hip_runtime.h>
#include <hip/hip_cooperative_groups.h>
#include <cstdio>
namespace cg = cooperative_groups;

typedef short bf16x8 __attribute__((ext_vector_type(8)));
typedef float f32x16 __attribute__((ext_vector_type(16)));
typedef __bf16 bf2_t __attribute__((ext_vector_type(2)));
typedef float f2_t __attribute__((ext_vector_type(2)));
typedef unsigned u32;
typedef unsigned short u16;
#define DI __device__ __forceinline__
#define MFMA(a, b, c) __builtin_amdgcn_mfma_f32_32x32x16_bf16((a), (b), (c), 0, 0, 0)

constexpr int NTOKP = 16384;
constexpr int NTOK = 16640;
constexpr int SEQ = 8192;
constexpr size_t O_YP = 0;
constexpr size_t O_AKP = 17039360, O_AVP = 17563648, O_BKP = 18087936, O_BVP = 26476544;
constexpr size_t O_AKS = 34865152, O_AVS = 36962304, O_BKS = 39059456, O_BVS = 39190528;
constexpr size_t WS_WINT = 0;
constexpr size_t WS_WOUTT = WS_WINT + 8388608;
constexpr size_t WS_HN = WS_WOUTT + 2097152;
constexpr size_t WS_QA = WS_HN + 34078720;
constexpr size_t WS_KA = WS_QA + 17039360;
constexpr size_t WS_KAS = WS_KA + 16777216;
constexpr size_t WS_VAT = WS_KAS + 4456448;
constexpr size_t WS_VATS = WS_VAT + 16777216;
constexpr size_t WS_GA = WS_VATS + 4456448;
constexpr size_t WS_QB = WS_GA + 17039360;
constexpr size_t WS_KB = WS_QB + 17039360;
constexpr size_t WS_KBS = WS_KB + 16777216;
constexpr size_t WS_VBT = WS_KBS + 8650752;
constexpr size_t WS_VBTS = WS_VBT + 16777216;
constexpr size_t WS_GB = WS_VBTS + 8650752;
constexpr size_t WS_ROPE = WS_GB + 17039360;
constexpr size_t WS_BAR = WS_ROPE + 524288;
constexpr size_t WS_QUEUE = WS_BAR + 4096;
constexpr size_t WS_END = WS_QUEUE + 4096;

struct Params {
  const float* x_prompt; const float* x_sample;
  const float* cache_a_k; const float* cache_a_v; const float* cache_b_k; const float* cache_b_v;
  const float* norm_gain; const float* w_in; const float* w_out; const float* rel_bias;
  const float* lq1; const float* lk1; const float* lq2; const float* lk2;
  const float* subln; const float* final_gain;
  float* out; char* ws;
};

DI u32 pk2(float a, float b) { f2_t v = {a, b}; bf2_t r = __builtin_convertvector(v, bf2_t); return __builtin_bit_cast(u32, r); }
DI float bflo(u32 v) { return __uint_as_float(v << 16); }
DI float bfhi(u32 v) { return __uint_as_float(v & 0xffff0000u); }
DI int rho(int r) { return (r & ~12) | ((r & 4) << 1) | ((r & 8) >> 1); }
DI void gld16(uint4& dst, const void* p) { asm volatile("global_load_dwordx4 %0, %1, off" : "=v"(dst) : "v"(p) : "memory"); }
DI void wait_vm0() { asm volatile("s_waitcnt vmcnt(0)" ::: "memory"); }
DI float wave_sum(float v) {
#pragma unroll
  for (int o = 32; o > 0; o >>= 1) v += __shfl_xor(v, o);
  return v;
}


DI void ctr_barrier(unsigned* ctr, unsigned target) {
  __syncthreads();
  if (threadIdx.x == 0) {
    __builtin_amdgcn_fence(__ATOMIC_RELEASE, "agent");
    __hip_atomic_fetch_add(ctr, 1u, __ATOMIC_RELAXED, __HIP_MEMORY_SCOPE_AGENT);
    while (__hip_atomic_load(ctr, __ATOMIC_RELAXED, __HIP_MEMORY_SCOPE_AGENT) < target) __builtin_amdgcn_s_sleep(1);
    __builtin_amdgcn_fence(__ATOMIC_ACQUIRE, "agent");
  }
  __syncthreads();
}

DI void phase0(const Params& p, char* lds) {
  const int tid = threadIdx.x, bid = blockIdx.x, nb = gridDim.x;
  const int lane = tid & 63, w = tid >> 6;
  float* tile = (float*)lds;
  for (int t = bid; t < 1280; t += nb) {
    const float* W; u16* WT; int N, kt, nt;
    if (t < 1024) { W = p.w_in; WT = (u16*)(p.ws + WS_WINT); N = 4096; kt = t >> 6; nt = t & 63; }
    else { int t2 = t - 1024; W = p.w_out; WT = (u16*)(p.ws + WS_WOUTT); N = 1024; kt = t2 >> 4; nt = t2 & 15; }
#pragma unroll
    for (int it = 0; it < 8; ++it) {
      int idx = it * 512 + tid, kk = idx >> 6, nn = idx & 63;
      tile[kk * 65 + nn] = W[(size_t)(kt * 64 + kk) * N + nt * 64 + nn];
    }
    __syncthreads();
    {
      int n = tid >> 3, kg = tid & 7;
      float v[8];
#pragma unroll
      for (int j = 0; j < 8; ++j) v[j] = tile[(kg * 8 + j) * 65 + n];
      uint4 o; o.x = pk2(v[0], v[1]); o.y = pk2(v[2], v[3]); o.z = pk2(v[4], v[5]); o.w = pk2(v[6], v[7]);
      *(uint4*)(WT + (size_t)(nt * 64 + n) * 1024 + kt * 64 + kg * 8) = o;
    }
    __syncthreads();
  }
  {
    u16* HN = (u16*)(p.ws + WS_HN);
    for (int row = bid * 8 + w; row < NTOK; row += nb * 8) {
      const float* src = row < NTOKP ? p.x_prompt + (size_t)row * 1024 : p.x_sample + (size_t)(row - NTOKP) * 1024;
      float4 v[4]; float ss = 0.f;
#pragma unroll
      for (int it = 0; it < 4; ++it) { v[it] = *(const float4*)(src + it * 256 + lane * 4); ss += v[it].x * v[it].x + v[it].y * v[it].y + v[it].z * v[it].z + v[it].w * v[it].w; }
      ss = wave_sum(ss);
      float inv = rsqrtf(ss * (1.f / 1024.f) + 1e-6f);
#pragma unroll
      for (int it = 0; it < 4; ++it) {
        float4 g = *(const float4*)(p.norm_gain + it * 256 + lane * 4);
        uint2 o; o.x = pk2(v[it].x * inv * g.x, v[it].y * inv * g.y); o.y = pk2(v[it].z * inv * g.z, v[it].w * inv * g.w);
        *(uint2*)(HN + (size_t)row * 1024 + it * 256 + lane * 4) = o;
      }
    }
  }
  const int gt = bid * 512 + tid, gn = nb * 512;
  {
    u16* KAS = (u16*)(p.ws + WS_KAS);
    for (int i = gt; i < 524288; i += gn) {
      int e = i * 4, b = e >> 18, key = (e >> 9) & 511, f = e & 511;
      float4 v = *(const float4*)(p.cache_a_k + e);
      uint2 o; o.x = pk2(v.x, v.y); o.y = pk2(v.z, v.w);
      *(uint2*)(KAS + (size_t)(b * 544 + key) * 512 + f) = o;
      if (key >= 32) *(float4*)(p.out + O_AKS + (size_t)(b * 512 + key - 32) * 512 + f) = v;
    }
    u16* KBS = (u16*)(p.ws + WS_KBS);
    for (int i = gt; i < 1048576; i += gn) {
      int e = i * 4, b = e >> 19, key = (e >> 9) & 1023, f = e & 511;
      float4 v = *(const float4*)(p.cache_b_k + e);
      uint2 o; o.x = pk2(v.x, v.y); o.y = pk2(v.z, v.w);
      *(uint2*)(KBS + (size_t)(b * 1056 + key) * 512 + f) = o;
    }
    u16* VATS = (u16*)(p.ws + WS_VATS);
    for (int i = gt; i < 262144; i += gn) {
      int f = i & 511, kg = (i >> 9) & 63, b = i >> 15;
      float v[8];
#pragma unroll
      for (int j = 0; j < 8; ++j) v[j] = p.cache_a_v[(size_t)(b * 512 + kg * 8 + j) * 512 + f];
      uint4 o; o.x = pk2(v[0], v[1]); o.y = pk2(v[2], v[3]); o.z = pk2(v[4], v[5]); o.w = pk2(v[6], v[7]);
      *(uint4*)(VATS + (size_t)(b * 512 + f) * 544 + kg * 8) = o;
      if (kg >= 4) {
#pragma unroll
        for (int j = 0; j < 8; ++j) p.out[O_AVS + (size_t)(b * 512 + kg * 8 + j - 32) * 512 + f] = v[j];
      }
    }
    u16* VBTS = (u16*)(p.ws + WS_VBTS);
    for (int i = gt; i < 524288; i += gn) {
      int f = i & 511, kg = (i >> 9) & 127, b = i >> 16;
      float v[8];
#pragma unroll
      for (int j = 0; j < 8; ++j) v[j] = p.cache_b_v[(size_t)(b * 1024 + kg * 8 + j) * 512 + f];
      uint4 o; o.x = pk2(v[0], v[1]); o.y = pk2(v[2], v[3]); o.z = pk2(v[4], v[5]); o.w = pk2(v[6], v[7]);
      *(uint4*)(VBTS + (size_t)(b * 512 + f) * 1056 + kg * 8) = o;
    }
  }
  {
    float2* RT = (float2*)(p.ws + WS_ROPE);
    for (int i = gt; i < 65536; i += gn) {
      int pos = i >> 3, m = i & 7;
      float inv = powf(500000.f, -(float)m * 0.125f);
      float ang = (float)pos * inv;
      RT[i] = make_float2(cosf(ang), sinf(ang));
    }
  }
}

template <bool SWAP>
DI void gemm_mainloop(const u16* __restrict__ A, const u16* __restrict__ Bt, int tm, int tn, char* lds, f32x16 (&acc)[2][2]) {
  const int tid = threadIdx.x, lane = tid & 63, w = tid >> 6, wm = w >> 1, wn = w & 1;
  const int r = lane & 31, h = lane >> 5;
  const u16* pa = A + (size_t)(tm * 256 + (tid >> 3)) * 1024 + (tid & 7) * 8;
  const u16* pb = Bt + (size_t)(tn * 128 + (tid >> 3)) * 1024 + (tid & 7) * 8;
  const int wofs = (tid >> 3) * 128 + ((((tid & 7) ^ ((tid >> 4) & 7))) << 4);
  const int swr = (r >> 1) & 7;
  uint4 ra[4], rb[2];
#pragma unroll
  for (int i = 0; i < 2; ++i)
#pragma unroll
    for (int j = 0; j < 2; ++j)
#pragma unroll
      for (int e = 0; e < 16; ++e) acc[i][j][e] = 0.f;
#pragma unroll
  for (int it = 0; it < 4; ++it) ra[it] = *(const uint4*)(pa + (size_t)it * 65536);
#pragma unroll
  for (int it = 0; it < 2; ++it) rb[it] = *(const uint4*)(pb + (size_t)it * 65536);
#pragma unroll
  for (int it = 0; it < 4; ++it) *(uint4*)(lds + it * 8192 + wofs) = ra[it];
#pragma unroll
  for (int it = 0; it < 2; ++it) *(uint4*)(lds + 32768 + it * 8192 + wofs) = rb[it];
  __syncthreads();
  for (int kt = 0; kt < 16; ++kt) {
    if (kt + 1 < 16) {
#pragma unroll
      for (int it = 0; it < 4; ++it) gld16(ra[it], pa + (size_t)it * 65536 + (kt + 1) * 64);
#pragma unroll
      for (int it = 0; it < 2; ++it) gld16(rb[it], pb + (size_t)it * 65536 + (kt + 1) * 64);
    }
    __builtin_amdgcn_sched_barrier(0);
    const char* ba = lds + (kt & 1) * 49152;
    const char* bb = ba + 32768;
    bf16x8 hf[2][2], wf[2][2];
    {
      const int co = ((h ^ swr) << 4);
#pragma unroll
      for (int i = 0; i < 2; ++i) hf[0][i] = *(const bf16x8*)(ba + (wm * 64 + i * 32 + r) * 128 + co);
#pragma unroll
      for (int j = 0; j < 2; ++j) wf[0][j] = *(const bf16x8*)(bb + (wn * 64 + j * 32 + r) * 128 + co);
    }
#pragma unroll
    for (int s = 0; s < 4; ++s) {
      if (s < 3) {
        const int co = (((2 * (s + 1) + h) ^ swr) << 4);
#pragma unroll
        for (int i = 0; i < 2; ++i) hf[(s + 1) & 1][i] = *(const bf16x8*)(ba + (wm * 64 + i * 32 + r) * 128 + co);
#pragma unroll
        for (int j = 0; j < 2; ++j) wf[(s + 1) & 1][j] = *(const bf16x8*)(bb + (wn * 64 + j * 32 + r) * 128 + co);
      }
#pragma unroll
      for (int i = 0; i < 2; ++i)
#pragma unroll
        for (int j = 0; j < 2; ++j) {
          if (SWAP) acc[j][i] = MFMA(wf[s & 1][j], hf[s & 1][i], acc[j][i]);
          else acc[i][j] = MFMA(hf[s & 1][i], wf[s & 1][j], acc[i][j]);
        }
      __builtin_amdgcn_sched_barrier(0);
    }
    if (kt + 1 < 16) {
      char* bw = lds + ((kt + 1) & 1) * 49152;
      wait_vm0();
#pragma unroll
      for (int it = 0; it < 4; ++it) *(uint4*)(bw + it * 8192 + wofs) = ra[it];
#pragma unroll
      for (int it = 0; it < 2; ++it) *(uint4*)(bw + 32768 + it * 8192 + wofs) = rb[it];
    }
    __syncthreads();
  }
}

DI float silu(float x) { return x / (1.f + __expf(-x)); }

DI float dpp_x1(float v) { return __int_as_float(__builtin_amdgcn_update_dpp(0, __float_as_int(v), 0xB1, 0xF, 0xF, true)); }
DI float dpp_x8(float v) { return __int_as_float(__builtin_amdgcn_update_dpp(0, __float_as_int(v), 0x128, 0xF, 0xF, true)); }
DI void store_bf16_tile(const f32x16& a, u16* base  , size_t ld, int h, int odd) {
#pragma unroll
  for (int g = 0; g < 4; ++g)
#pragma unroll
    for (int e = 0; e < 4; e += 2) {
      const float v0 = a[4 * g + e], v1 = a[4 * g + e + 1];
      const float n0 = dpp_x1(v0), n1 = dpp_x1(v1);
      const u32 o = odd ? pk2(n1, v1) : pk2(v0, n0);
      *(u32*)(base + (size_t)(8 * g + 4 * h + e + odd) * ld) = o;
      if (e == 2) __builtin_amdgcn_sched_barrier(0);
    }
}
DI void phase1(const Params& p, char* lds) {
  const u16* HN = (const u16*)(p.ws + WS_HN);
  const u16* WT = (const u16*)(p.ws + WS_WINT);
  const float2* RT = (const float2*)(p.ws + WS_ROPE);
  for (int tile = blockIdx.x; tile < 65 * 32; tile += gridDim.x) {
    const int tm = tile >> 5, tn = tile & 31;
    const int sec = tn >> 2;
    const bool sample = (tm == 64);
    f32x16 acc[2][2];
    gemm_mainloop<false>(HN, WT, tm, tn, lds, acc);
    int tid = threadIdx.x;
    asm volatile("" : "+v"(tid));
    const int lane = tid & 63, w = tid >> 6, wm = w >> 1, wn = w & 1;
    const int r = lane & 31, h = lane >> 5, odd = r & 1;
    const int tb = tm * 256 + wm * 64;
    const int fb = (tn & 3) * 128 + wn * 64;
    if (sec == 2 || sec == 6) {
#pragma unroll
      for (int i = 0; i < 2; ++i)
#pragma unroll
        for (int j = 0; j < 2; ++j) {
          const int fs = fb + j * 32 + r;
          char* trow = lds + (wn * 64 + j * 32 + r) * 528 + (wm * 64 + i * 32 + 4 * h) * 2;
#pragma unroll
          for (int g = 0; g < 4; ++g) {
            const int t = tb + i * 32 + 8 * g + 4 * h;
            const float v0 = acc[i][j][4 * g], v1 = acc[i][j][4 * g + 1], v2 = acc[i][j][4 * g + 2], v3 = acc[i][j][4 * g + 3];
            uint2 o; o.x = pk2(v0, v1); o.y = pk2(v2, v3);
            *(uint2*)(trow + g * 16) = o;
            float* d = nullptr;
            if (!sample) {
              const int b = t >> 13, s = t & 8191;
              if (sec == 6) d = p.out + O_BVP + (size_t)t * 512 + fs;
              else if (s >= 7680) d = p.out + O_AVP + ((size_t)(b * 512 + s - 7680)) * 512 + fs;
            } else {
              const int ts = t - NTOKP, b = ts >> 5, tt = ts & 31;
              if (sec == 6) d = p.out + O_BVS + (size_t)ts * 512 + fs;
              else d = p.out + O_AVS + ((size_t)(b * 512 + 480 + tt)) * 512 + fs;
            }
            if (d) { d[0] = v0; d[512] = v1; d[1024] = v2; d[1536] = v3; }
            __builtin_amdgcn_sched_barrier(0);
          }
        }
      __syncthreads();
      {
        u16* VT; size_t ldv;
        if (sec == 2) { VT = (u16*)(p.ws + (sample ? WS_VATS : WS_VAT)); ldv = sample ? 544 : 8192; }
        else { VT = (u16*)(p.ws + (sample ? WS_VBTS : WS_VBT)); ldv = sample ? 1056 : 8192; }
        const int sofs = sample ? (sec == 2 ? 512 : 1024) : 0;
#pragma unroll
        for (int it = 0; it < 8; ++it) {
          const int id = it * 512 + tid, row = id >> 5, c = id & 31;
          const uint4 v = *(const uint4*)(lds + row * 528 + c * 16);
          const int fs = (tn & 3) * 128 + row;
          if (!sample) {
            const int t0 = tm * 256 + c * 8, b = t0 >> 13, s = t0 & 8191;
            *(uint4*)(VT + ((size_t)(b * 512 + fs)) * ldv + s) = v;
          } else {
            const int b = c >> 2, tt = (c & 3) * 8;
            *(uint4*)(VT + ((size_t)(b * 512 + fs)) * ldv + sofs + tt) = v;
          }
        }
      }
      __syncthreads();
    } else {
      if (sec == 4 || sec == 5) {
        const float sgn = (r & 8) ? 1.f : -1.f;
        const int pos0 = sample ? (1024 + 4 * h) : ((tb & 8191) + 4 * h);
        const float2* rt = RT + pos0 * 8 + (r & 7);
#pragma unroll
        for (int i = 0; i < 2; ++i)
#pragma unroll
          for (int g = 0; g < 4; ++g) {
            const int po = (sample ? 0 : i * 32) + 8 * g;
            float2 cs[4];
#pragma unroll
            for (int e = 0; e < 4; ++e) cs[e] = rt[(po + e) * 8];
            __builtin_amdgcn_sched_barrier(0);
#pragma unroll
            for (int e = 0; e < 4; ++e) {
              const float x = acc[i][0][4 * g + e];
              const float xp = dpp_x8(x);
              if (r < 16) acc[i][0][4 * g + e] = x * cs[e].x + sgn * xp * cs[e].y;
            }
            __builtin_amdgcn_sched_barrier(0);
          }
      }
      if (sec == 3 || sec == 7) {
#pragma unroll
        for (int i = 0; i < 2; ++i)
#pragma unroll
          for (int j = 0; j < 2; ++j)
#pragma unroll
            for (int e = 0; e < 16; ++e) acc[i][j][e] = silu(acc[i][j][e]);
      }
      u16* dst; size_t trow0;
      if (sec == 0) { dst = (u16*)(p.ws + WS_QA); trow0 = tb; }
      else if (sec == 3) { dst = (u16*)(p.ws + WS_GA); trow0 = tb; }
      else if (sec == 4) { dst = (u16*)(p.ws + WS_QB); trow0 = tb; }
      else if (sec == 7) { dst = (u16*)(p.ws + WS_GB); trow0 = tb; }
      else if (sec == 1) {
        if (!sample) { dst = (u16*)(p.ws + WS_KA); trow0 = tb; }
        else { dst = (u16*)(p.ws + WS_KAS); trow0 = (size_t)(wm * 2) * 544 + 512; }
      } else {
        if (!sample) { dst = (u16*)(p.ws + WS_KB); trow0 = tb; }
        else { dst = (u16*)(p.ws + WS_KBS); trow0 = (size_t)(wm * 2) * 1056 + 1024; }
      }
      const size_t istep = sample ? (sec == 1 ? 544 : (sec == 5 ? 1056 : 32)) : 32;
#pragma unroll
      for (int i = 0; i < 2; ++i)
#pragma unroll
        for (int j = 0; j < 2; ++j)
          store_bf16_tile(acc[i][j], dst + (trow0 + i * istep) * 512 + fb + j * 32 + (r & ~1), 512, h, odd);
      if (sec == 1 || sec == 5) {
#pragma unroll
        for (int i = 0; i < 2; ++i) {
          float* d = nullptr;
          const int t0 = tb + i * 32;
          if (!sample) {
            const int b = t0 >> 13, s = t0 & 8191;
            if (sec == 5) d = p.out + O_BKP + (size_t)t0 * 512;
            else if (s >= 7680) d = p.out + O_AKP + ((size_t)(b * 512 + s - 7680)) * 512;
          } else {
            const int ts = t0 - NTOKP, b = ts >> 5;
            if (sec == 5) d = p.out + O_BKS + (size_t)ts * 512;
            else d = p.out + O_AKS + ((size_t)(b * 512 + 480)) * 512;
          }
          if (d) {
#pragma unroll
            for (int j = 0; j < 2; ++j)
#pragma unroll
              for (int e = 0; e < 16; ++e) {
                d[(size_t)(8 * (e >> 2) + 4 * h + (e & 3)) * 512 + fb + j * 32 + r] = acc[i][j][e];
                if ((e & 3) == 3) __builtin_amdgcn_sched_barrier(0);
              }
          }
        }
      }
    }
  }
}

constexpr float SM_C = 0.125f * 1.4426950408889634f;
template <int NQT, int DVT, bool BIAS>
DI void attn_wave(const u16* __restrict__ Q, int ldq, const u16* __restrict__ K, int ldk,
                  const u16* __restrict__ Vt, int ldv, int nkt, const float* bias_l2, int rel0,
                  f32x16 (&O)[NQT][DVT], float (&Mx)[NQT], float (&L)[NQT]) {
  const int lane = threadIdx.x & 63, r = lane & 31, h = lane >> 5;
  bf16x8 qf[NQT][4];
#pragma unroll
  for (int u = 0; u < NQT; ++u)
#pragma unroll
    for (int s = 0; s < 4; ++s) qf[u][s] = *(const bf16x8*)(Q + (size_t)(32 * u + r) * ldq + 16 * s + 8 * h);
#pragma unroll
  for (int u = 0; u < NQT; ++u) {
    Mx[u] = -INFINITY; L[u] = 0.f;
#pragma unroll
    for (int dt = 0; dt < DVT; ++dt)
#pragma unroll
      for (int e = 0; e < 16; ++e) O[u][dt][e] = 0.f;
  }
  const u16* kp = K + (size_t)rho(r) * ldk + 8 * h;
  const u16* vp = Vt + (size_t)r * ldv + 8 * h;
  bf16x8 kf[4];
#pragma unroll
  for (int s = 0; s < 4; ++s) kf[s] = *(const bf16x8*)(kp + 16 * s);
  for (int kt = 0; kt < nkt; ++kt) {
    bf16x8 vf[DVT][2];
#pragma unroll
    for (int dt = 0; dt < DVT; ++dt)
#pragma unroll
      for (int s2 = 0; s2 < 2; ++s2) vf[dt][s2] = *(const bf16x8*)(vp + (size_t)(32 * dt) * ldv + 32 * kt + 16 * s2);
    bf16x8 kn[4];
    {
      const int ktn = (kt + 1 < nkt) ? kt + 1 : kt;
#pragma unroll
      for (int s = 0; s < 4; ++s) kn[s] = *(const bf16x8*)(kp + (size_t)(32 * ktn) * ldk + 16 * s);
    }
    bf16x8 pf[NQT][2];
#pragma unroll
    for (int u = 0; u < NQT; ++u) {
      f32x16 S;
#pragma unroll
      for (int e = 0; e < 16; ++e) S[e] = 0.f;
#pragma unroll
      for (int s = 0; s < 4; ++s) S = MFMA(kf[s], qf[u][s], S);
      float t[16];
      if (BIAS) {
        const int relb = rel0 + 32 * u + r - 32 * kt - 8 * h;
        if (rel0 - 32 * kt - 31 >= 128) {
          const float bv = bias_l2[256];
#pragma unroll
          for (int e = 0; e < 16; ++e) t[e] = S[e] * SM_C + bv;
        } else {
#pragma unroll
          for (int e = 0; e < 16; ++e) {
            int rel = relb - ((e & 7) + 16 * (e >> 3));
            rel = rel < -128 ? -128 : (rel > 128 ? 128 : rel);
            t[e] = S[e] * SM_C + bias_l2[rel + 128];
          }
        }
      } else {
#pragma unroll
        for (int e = 0; e < 16; ++e) t[e] = S[e] * SM_C;
      }
      float mx = t[0];
#pragma unroll
      for (int e = 1; e < 16; ++e) mx = fmaxf(mx, t[e]);
      mx = fmaxf(mx, __shfl_xor(mx, 32));
      if (__any(mx > Mx[u] + 8.f)) {
        const float mn = fmaxf(Mx[u], mx);
        const float al = __builtin_amdgcn_exp2f(Mx[u] - mn);
        Mx[u] = mn; L[u] *= al;
#pragma unroll
        for (int dt = 0; dt < DVT; ++dt)
#pragma unroll
          for (int e = 0; e < 16; ++e) O[u][dt][e] *= al;
      }
      float ps = 0.f;
#pragma unroll
      for (int e = 0; e < 16; ++e) { t[e] = __builtin_amdgcn_exp2f(t[e] - Mx[u]); ps += t[e]; }
      L[u] += ps;
#pragma unroll
      for (int s2 = 0; s2 < 2; ++s2) {
        uint4 pk;
        pk.x = pk2(t[8 * s2], t[8 * s2 + 1]); pk.y = pk2(t[8 * s2 + 2], t[8 * s2 + 3]);
        pk.z = pk2(t[8 * s2 + 4], t[8 * s2 + 5]); pk.w = pk2(t[8 * s2 + 6], t[8 * s2 + 7]);
        pf[u][s2] = __builtin_bit_cast(bf16x8, pk);
      }
    }
#pragma unroll
    for (int u = 0; u < NQT; ++u)
#pragma unroll
      for (int dt = 0; dt < DVT; ++dt)
#pragma unroll
        for (int s2 = 0; s2 < 2; ++s2) O[u][dt] = MFMA(vf[dt][s2], pf[u][s2], O[u][dt]);
#pragma unroll
    for (int s = 0; s < 4; ++s) kf[s] = kn[s];
  }
#pragma unroll
  for (int u = 0; u < NQT; ++u) L[u] += __shfl_xor(L[u], 32);
}

template <int NQT>
DI void attnA_item(const Params& p, const u16* Q, const u16* K, const u16* Vt, int ldv, int nkt, int rel0,
                   const float* bias_l2, int tok0, int head) {
  f32x16 O[NQT][2]; float Mx[NQT], L[NQT];
  attn_wave<NQT, 2, true>(Q, 512, K, 512, Vt, ldv, nkt, bias_l2, rel0, O, Mx, L);
  const int lane = threadIdx.x & 63, r = lane & 31, h = lane >> 5;
  const u16* GA = (const u16*)(p.ws + WS_GA);
  u16* OB = (u16*)(p.ws + WS_HN);
#pragma unroll
  for (int u = 0; u < NQT; ++u) {
    const float inv = 1.f / L[u];
    const size_t tok = (size_t)(tok0 + 32 * u + r);
#pragma unroll
    for (int dt = 0; dt < 2; ++dt)
#pragma unroll
      for (int g = 0; g < 4; ++g) {
        const int dv = 32 * dt + 8 * g + 4 * h;
        const uint2 gg = *(const uint2*)(GA + tok * 512 + head * 64 + dv);
        uint2 o;
        o.x = pk2(O[u][dt][4 * g] * inv * bflo(gg.x), O[u][dt][4 * g + 1] * inv * bfhi(gg.x));
        o.y = pk2(O[u][dt][4 * g + 2] * inv * bflo(gg.y), O[u][dt][4 * g + 3] * inv * bfhi(gg.y));
        *(uint2*)(OB + tok * 1024 + head * 64 + dv) = o;
      }
  }
}

DI void attnB_epilogue(const Params& p, f32x16 (&O)[4], float Lsum, int tok0, int hb, float lam, float* xch) {
  const int lane = threadIdx.x & 63, r = lane & 31, h = lane >> 5, w = threadIdx.x >> 6, m = w >> 2, wsub = w & 3;
  const float inv = 1.f / Lsum;
  float* xw = xch + wsub * 4096 + lane;
  if (m == 1) {
    const float sc = inv * lam;
#pragma unroll
    for (int dt = 0; dt < 4; ++dt)
#pragma unroll
      for (int e = 0; e < 16; ++e) xw[(dt * 16 + e) * 64] = O[dt][e] * sc;
  }
  __syncthreads();
  if (m == 0) {
    float ss = 0.f;
#pragma unroll
    for (int dt = 0; dt < 4; ++dt)
#pragma unroll
      for (int e = 0; e < 16; ++e) { float o = O[dt][e] * inv - xw[(dt * 16 + e) * 64]; O[dt][e] = o; ss += o * o; }
    ss += __shfl_xor(ss, 32);
    const float rn = rsqrtf(ss * (1.f / 128.f) + 1e-6f) * 0.8f;
    const u16* GB = (const u16*)(p.ws + WS_GB);
    u16* OB = (u16*)(p.ws + WS_HN);
    const size_t tok = (size_t)(tok0 + r);
#pragma unroll
    for (int dt = 0; dt < 4; ++dt)
#pragma unroll
      for (int g = 0; g < 4; ++g) {
        const int dv = 32 * dt + 8 * g + 4 * h;
        const uint2 gg = *(const uint2*)(GB + tok * 512 + hb * 128 + dv);
        const float4 sg = *(const float4*)(p.subln + dv);
        uint2 o;
        o.x = pk2(O[dt][4 * g] * rn * sg.x * bflo(gg.x), O[dt][4 * g + 1] * rn * sg.y * bfhi(gg.x));
        o.y = pk2(O[dt][4 * g + 2] * rn * sg.z * bflo(gg.y), O[dt][4 * g + 3] * rn * sg.w * bfhi(gg.y));
        *(uint2*)(OB + tok * 1024 + 512 + hb * 128 + dv) = o;
      }
  }
  __syncthreads();
}

DI void attnB_item(const Params& p, const u16* Q, const u16* K, const u16* Vt, int ldv, int nkt, int tok0, int hb,
                   float lam, float* xch) {
  f32x16 O[1][4]; float Mx[1], L[1];
  attn_wave<1, 4, false>(Q, 512, K, 512, Vt, ldv, nkt, nullptr, 0, O, Mx, L);
  attnB_epilogue(p, O[0], L[0], tok0, hb, lam, xch);
}

typedef float f2 __attribute__((ext_vector_type(2)));
constexpr int BLK_V = 0, BLK_K = 49152, BLK_XCH = 81920, LDS_BIAS = 147456;
DI float half_max(float v) {
  auto rr = __builtin_amdgcn_permlane32_swap(__float_as_uint(v), __float_as_uint(v), false, false);
  return fmaxf(__uint_as_float(rr[0]), __uint_as_float(rr[1]));
}
DI void attnB_block(const Params& p, int b, int hb, int qt, float lam, char* lds) {
  const int tid = threadIdx.x, lane = tid & 63, r = lane & 31, h = lane >> 5, w = tid >> 6, m = w >> 2, wsub = w & 3;
  const bool late = (m == 1);
  const int q0 = qt * 128 + wsub * 32;
  const int nt = 2 * qt + 2;
  const int my_nt = (q0 >> 6) + 1;
  uint4 qraw[4];
  {
    const u16* Q = (const u16*)(p.ws + WS_QB) + (size_t)(b * SEQ + q0 + r) * 512 + hb * 128 + m * 64 + 8 * h;
#pragma unroll
    for (int s = 0; s < 4; ++s) gld16(qraw[s], Q + 16 * s);
  }
  f32x16 O[4];
#pragma unroll
  for (int dt = 0; dt < 4; ++dt)
#pragma unroll
    for (int e = 0; e < 16; ++e) O[dt][e] = 0.f;
  float Mx = -INFINITY;
  f2 L2 = {0.f, 0.f};
  const u16* gk = (const u16*)(p.ws + WS_KB) + (size_t)(b * SEQ + (tid >> 4)) * 512 + hb * 128 + (tid & 15) * 8;
  const u16* gv = (const u16*)(p.ws + WS_VBT) + (size_t)(b * 512 + hb * 128 + (tid >> 3)) * SEQ + (tid & 7) * 8;
  const int lk = BLK_K + ((tid >> 3) & 1) * 8192 + (tid >> 4) * 128 + ((((tid & 7) ^ ((tid >> 5) & 7))) << 4);
  const int lv = BLK_V + (tid >> 3) * 128 + ((((tid & 7) ^ ((tid >> 4) & 7))) << 4);
  const int rr = rho(r);
  const int swk = (rr >> 1) & 7, swv = (r >> 1) & 7;
  uint4 sk0, sk1, sv0, sv1;
  gld16(sk0, gk); gld16(sk1, gk + (size_t)32 * 512);
  gld16(sv0, gv); gld16(sv1, gv + (size_t)64 * SEQ);
  wait_vm0();
  *(uint4*)(lds + lk) = sk0; *(uint4*)(lds + lk + 4096) = sk1;
  *(uint4*)(lds + lv) = sv0; *(uint4*)(lds + lv + 8192) = sv1;
  bf16x8 qf[4];
#pragma unroll
  for (int s = 0; s < 4; ++s) qf[s] = __builtin_bit_cast(bf16x8, qraw[s]);
  bf16x8 pf[4];
#pragma unroll
  for (int s = 0; s < 4; ++s) pf[s] = qf[s];
  __syncthreads();
  int vs = 0;
  for (int t = 0; t <= nt; ++t) {
    if (t + 1 < nt) {
      gld16(sk0, gk + (size_t)(64 * (t + 1)) * 512);
      gld16(sk1, gk + (size_t)(64 * (t + 1) + 32) * 512);
      gld16(sv0, gv + 64 * (t + 1));
      gld16(sv1, gv + (size_t)64 * SEQ + 64 * (t + 1));
    }
    __builtin_amdgcn_sched_barrier(0);
    if (late && t >= 1 && t - 1 < my_nt) {
      const char* vb = lds + BLK_V + (vs == 0 ? 2 : vs - 1) * 16384;
#pragma unroll
      for (int ks = 0; ks < 4; ++ks) {
        const int co = (((2 * ks + h) ^ swv) << 4);
#pragma unroll
        for (int dt = 0; dt < 4; ++dt) {
          bf16x8 v = *(const bf16x8*)(vb + (32 * dt + r) * 128 + co);
          O[dt] = MFMA(v, pf[ks], O[dt]);
        }
      }
    }
    if (t < my_nt && t < nt) {
      const char* kb = lds + BLK_K + (t & 1) * 16384 + m * 8192;
      f32x16 S0, S1;
#pragma unroll
      for (int e = 0; e < 16; ++e) { S0[e] = 0.f; S1[e] = 0.f; }
      bf16x8 ka[4], kc[4];
#pragma unroll
      for (int s = 0; s < 4; ++s) {
        const int co = (((2 * s + h) ^ swk) << 4);
        ka[s] = *(const bf16x8*)(kb + rr * 128 + co);
        kc[s] = *(const bf16x8*)(kb + (32 + rr) * 128 + co);
      }
#pragma unroll
      for (int s = 0; s < 4; ++s) {
        S0 = MFMA(ka[s], qf[s], S0);
        S1 = MFMA(kc[s], qf[s], S1);
      }
      f2 tv[16];
      const f2 cc = {SM_C, SM_C};
#pragma unroll
      for (int e = 0; e < 8; ++e) {
        f2 a = {S0[2 * e], S0[2 * e + 1]}; tv[e] = a * cc;
        f2 c = {S1[2 * e], S1[2 * e + 1]}; tv[8 + e] = c * cc;
      }
      float mx = fmaxf(tv[0].x, tv[0].y);
#pragma unroll
      for (int e = 1; e < 16; ++e) mx = fmaxf(mx, fmaxf(tv[e].x, tv[e].y));
      mx = half_max(mx);
      if (__any(mx > Mx + 8.f)) {
        const float mn = fmaxf(Mx, mx);
        const float al = __builtin_amdgcn_exp2f(Mx - mn);
        Mx = mn; L2 *= al;
#pragma unroll
        for (int dt = 0; dt < 4; ++dt)
#pragma unroll
          for (int e = 0; e < 16; ++e) O[dt][e] *= al;
      }
      const f2 nm = {-Mx, -Mx};
#pragma unroll
      for (int e = 0; e < 16; ++e) {
        f2 d = tv[e] + nm;
        d.x = __builtin_amdgcn_exp2f(d.x); d.y = __builtin_amdgcn_exp2f(d.y);
        L2 += d;
        tv[e] = d;
      }
#pragma unroll
      for (int s2 = 0; s2 < 4; ++s2) {
        uint4 pa;
        pa.x = pk2(tv[4 * s2].x, tv[4 * s2].y); pa.y = pk2(tv[4 * s2 + 1].x, tv[4 * s2 + 1].y);
        pa.z = pk2(tv[4 * s2 + 2].x, tv[4 * s2 + 2].y); pa.w = pk2(tv[4 * s2 + 3].x, tv[4 * s2 + 3].y);
        pf[s2] = __builtin_bit_cast(bf16x8, pa);
      }
      if (!late) {
        const char* vb = lds + BLK_V + vs * 16384;
#pragma unroll
        for (int ks = 0; ks < 4; ++ks) {
          const int co = (((2 * ks + h) ^ swv) << 4);
#pragma unroll
          for (int dt = 0; dt < 4; ++dt) {
            bf16x8 v = *(const bf16x8*)(vb + (32 * dt + r) * 128 + co);
            O[dt] = MFMA(v, pf[ks], O[dt]);
          }
        }
      }
    }
    if (t + 1 < nt) {
      const int vn = (vs == 2 ? 0 : vs + 1);
      wait_vm0();
      *(uint4*)(lds + lk + ((t + 1) & 1) * 16384) = sk0; *(uint4*)(lds + lk + ((t + 1) & 1) * 16384 + 4096) = sk1;
      *(uint4*)(lds + lv + vn * 16384) = sv0; *(uint4*)(lds + lv + vn * 16384 + 8192) = sv1;
    }
    vs = (vs == 2 ? 0 : vs + 1);
    __syncthreads();
  }
  float L = L2.x + L2.y;
  L += __shfl_xor(L, 32);
  attnB_epilogue(p, O, L, b * SEQ + q0, hb, lam, (float*)(lds + BLK_XCH));
}

DI float phase2_setup(const Params& p, char* lds) {
  const int tid = threadIdx.x, lane = tid & 63;
  float* bias = (float*)(lds + LDS_BIAS);
  for (int i = tid; i < 8 * 257; i += 512) { int hh = i / 257, k = i - hh * 257; bias[hh * 260 + k] = p.rel_bias[i] * 1.4426950408889634f; }
  float a = p.lq1[lane] * p.lk1[lane], b = p.lq2[lane] * p.lk2[lane];
  a = wave_sum(a); b = wave_sum(b);
  __syncthreads();
  return expf(a) - expf(b) + 0.2f;
}
constexpr int NQUEUE = 10;
DI int q_pop(unsigned* ctr, int* slot) {
  __syncthreads();
  if (threadIdx.x == 0) *slot = (int)__hip_atomic_fetch_add(ctr, 1u, __ATOMIC_RELAXED, __HIP_MEMORY_SCOPE_AGENT);
  __syncthreads();
  return *slot;
}
DI void p2_all(const Params& p, char* lds, float lam) {
  const int w = threadIdx.x >> 6;
  unsigned* Q = (unsigned*)(p.ws + WS_QUEUE);
  int* slot = (int*)(lds + LDS_BIAS + 8320);
  float* xch = (float*)(lds + 65536);
  const float* bias = (const float*)(lds + LDS_BIAS);
  const u16* QA = (const u16*)(p.ws + WS_QA);
  const u16* QB = (const u16*)(p.ws + WS_QB);
  {
    const int it = q_pop(Q, slot);
    if (it < 8) {
      const int m = w >> 2, wsub = w & 3, id = it * 4 + wsub, b = id >> 2, hb = id & 3;
      attnB_item(p, QB + (size_t)(NTOKP + b * 32) * 512 + hb * 128 + m * 64,
                 (const u16*)(p.ws + WS_KBS) + (size_t)(b * 1056) * 512 + hb * 128 + m * 64,
                 (const u16*)(p.ws + WS_VBTS) + (size_t)(b * 512 + hb * 128) * 1056, 1056, 33, NTOKP + b * 32, hb, lam, xch);
    } else if (it < 16) {
      const int b = it - 8;
      attnA_item<1>(p, QA + (size_t)(NTOKP + b * 32) * 512 + w * 64,
                    (const u16*)(p.ws + WS_KAS) + (size_t)(b * 544) * 512 + w * 64,
                    (const u16*)(p.ws + WS_VATS) + (size_t)(b * 512 + w * 64) * 544, 544, 17, 512, bias + w * 260,
                    NTOKP + b * 32, w);
    }
  }
#pragma unroll 1
  for (int k = 0; k < 8; ++k) {
    const int x = (blockIdx.x + k) & 7;
#pragma unroll 1
    for (;;) {
      const int i = q_pop(Q + 64 * (1 + x), slot);
      if (i >= 64) break;
      attnB_block(p, x >> 2, x & 3, 63 - i, lam, lds);
    }
  }
#pragma unroll 1
  for (;;) {
    const int it = q_pop(Q + 64 * 9, slot);
    if (it >= 256) break;
    const int b = it >> 7, c = it & 127, cs = c > 8 ? c - 8 : 0;
    attnA_item<2>(p, QA + (size_t)(b * SEQ + c * 64) * 512 + w * 64,
                  (const u16*)(p.ws + WS_KA) + (size_t)(b * SEQ + cs * 64) * 512 + w * 64,
                  (const u16*)(p.ws + WS_VAT) + (size_t)(b * 512 + w * 64) * SEQ + cs * 64, SEQ,
                  (c + 1 - cs) * 2, 64 * (c - cs), bias + w * 260, b * SEQ + c * 64, w);
  }
}

DI void phase3(const Params& p, char* lds) {
  const u16* OB = (const u16*)(p.ws + WS_HN);
  const u16* WT = (const u16*)(p.ws + WS_WOUTT);
  for (int tile = blockIdx.x; tile < 65 * 8; tile += gridDim.x) {
    const int tm = tile >> 3, tn = tile & 7;
    f32x16 acc[2][2];
    gemm_mainloop<false>(OB, WT, tm, tn, lds, acc);
    int tid = threadIdx.x;
    asm volatile("" : "+v"(tid));
    const int lane = tid & 63, w = tid >> 6, wm = w >> 1, wn = w & 1;
    const int r = lane & 31, h = lane >> 5;
#pragma unroll
    for (int i = 0; i < 2; ++i) {
      const int t0 = tm * 256 + wm * 64 + i * 32;
      const float* xr = t0 < NTOKP ? p.x_prompt + (size_t)t0 * 1024 : p.x_sample + (size_t)(t0 - NTOKP) * 1024;
      float* yr = p.out + O_YP + (size_t)t0 * 1024;
#pragma unroll
      for (int j = 0; j < 2; ++j) {
        const int f = tn * 128 + wn * 64 + j * 32 + r;
#pragma unroll
        for (int e = 0; e < 16; ++e) {
          const size_t o = (size_t)(8 * (e >> 2) + 4 * h + (e & 3)) * 1024 + f;
          yr[o] = xr[o] + acc[i][j][e];
          if ((e & 3) == 3) __builtin_amdgcn_sched_barrier(0);
        }
      }
    }
  }
}

DI void phase4(const Params& p) {
  const int lane = threadIdx.x & 63, w = threadIdx.x >> 6;
  for (int row = blockIdx.x * 8 + w; row < NTOK; row += gridDim.x * 8) {
    float* y = p.out + O_YP + (size_t)row * 1024;
    float4 v[4]; float ss = 0.f;
#pragma unroll
    for (int it = 0; it < 4; ++it) { v[it] = *(const float4*)(y + it * 256 + lane * 4); ss += v[it].x * v[it].x + v[it].y * v[it].y + v[it].z * v[it].z + v[it].w * v[it].w; }
    ss = wave_sum(ss);
    const float inv = rsqrtf(ss * (1.f / 1024.f) + 1e-6f);
#pragma unroll
    for (int it = 0; it < 4; ++it) {
      float4 g = *(const float4*)(p.final_gain + it * 256 + lane * 4);
      *(float4*)(y + it * 256 + lane * 4) = make_float4(v[it].x * inv * g.x, v[it].y * inv * g.y, v[it].z * inv * g.z, v[it].w * inv * g.w);
    }
  }
}

__global__ void __launch_bounds__(512) fwd_megakernel(Params p) {
  __shared__ __attribute__((aligned(16))) char lds[155904];
  cg::grid_group grid = cg::this_grid();
  unsigned* ctr = (unsigned*)(p.ws + WS_BAR);
  const unsigned G = gridDim.x;
  if (blockIdx.x == 0 && threadIdx.x == 0) *ctr = 0u;
  if (blockIdx.x == 0 && threadIdx.x < NQUEUE) ((unsigned*)(p.ws + WS_QUEUE))[64 * threadIdx.x] = 0u;
  phase0(p, lds);
  grid.sync();
  phase1(p, lds);
  ctr_barrier(ctr, G);
  {
    const float lam = phase2_setup(p, lds);
    p2_all(p, lds, lam);
  }
  ctr_barrier(ctr, 2 * G);
  phase3(p, lds);
  ctr_barrier(ctr, 3 * G);
  phase4(p);
}

extern "C" void kernel_launch(void* const* d_in, const int* in_sizes, int n_in, void* d_out, int out_size, void* d_ws,
                              size_t ws_size, hipStream_t stream) {
  static int grid_blocks = 0;
  if (!grid_blocks) {
    int dev = 0, cus = 0, per_cu = 0;
    hipGetDevice(&dev);
    hipDeviceGetAttribute(&cus, hipDeviceAttributeMultiprocessorCount, dev);
    hipOccupancyMaxActiveBlocksPerMultiprocessor(&per_cu, fwd_megakernel, 512, 0);
    if (per_cu < 1) per_cu = 1;
    grid_blocks = cus;
  }
  Params p{};
  p.x_prompt = (const float*)d_in[0]; p.x_sample = (const float*)d_in[1];
  p.cache_a_k = (const float*)d_in[2]; p.cache_a_v = (const float*)d_in[3];
  p.cache_b_k = (const float*)d_in[4]; p.cache_b_v = (const float*)d_in[5];
  p.norm_gain = (const float*)d_in[6]; p.w_in = (const float*)d_in[7]; p.w_out = (const float*)d_in[8];
  p.rel_bias = (const float*)d_in[9];
  p.lq1 = (const float*)d_in[10]; p.lk1 = (const float*)d_in[11]; p.lq2 = (const float*)d_in[12]; p.lk2 = (const float*)d_in[13];
  p.subln = (const float*)d_in[14]; p.final_gain = (const float*)d_in[15];
  p.out = (float*)d_out; p.ws = (char*)d_ws;
  void* args[] = {&p};
  hipError_t e = hipLaunchCooperativeKernel((void*)fwd_megakernel, dim3(grid_blocks), dim3(512), args, 0, stream);
  if (e != hipSuccess) fprintf(stderr, "cooperative launch failed: %s (grid %d)\n", hipGetErrorString(e), grid_blocks);
}
```

```cpp
#include <hip/hip_runtime.h>
#include <hip/hip_cooperative_groups.h>
#include <cstdio>
namespace cg = cooperative_groups;

typedef short bf16x8 __attribute__((ext_vector_type(8)));
typedef float f32x16 __attribute__((ext_vector_type(16)));
typedef __bf16 bf2_t __attribute__((ext_vector_type(2)));
typedef float f2_t __attribute__((ext_vector_type(2)));
typedef unsigned u32;
typedef unsigned short u16;
#define DI __device__ __forceinline__
#define MFMA(a, b, c) __builtin_amdgcn_mfma_f32_32x32x16_bf16((a), (b), (c), 0, 0, 0)

constexpr int NTOKP = 16384;
constexpr int NTOK = 16640;
constexpr int SEQ = 8192;
constexpr size_t O_YP = 0;
constexpr size_t O_AKP = 17039360, O_AVP = 17563648, O_BKP = 18087936, O_BVP = 26476544;
constexpr size_t O_AKS = 34865152, O_AVS = 36962304, O_BKS = 39059456, O_BVS = 39190528;
constexpr size_t WS_WINT = 0;
constexpr size_t WS_WOUTT = WS_WINT + 8388608;
constexpr size_t WS_HN = WS_WOUTT + 2097152;
constexpr size_t WS_QA = WS_HN + 34078720;
constexpr size_t WS_KA = WS_QA + 17039360;
constexpr size_t WS_KAS = WS_KA + 16777216;
constexpr size_t WS_VAT = WS_KAS + 4456448;
constexpr size_t WS_VATS = WS_VAT + 16777216;
constexpr size_t WS_GA = WS_VATS + 4456448;
constexpr size_t WS_QB = WS_GA + 17039360;
constexpr size_t WS_KB = WS_QB + 17039360;
constexpr size_t WS_KBS = WS_KB + 16777216;
constexpr size_t WS_VBT = WS_KBS + 8650752;
constexpr size_t WS_VBTS = WS_VBT + 16777216;
constexpr size_t WS_GB = WS_VBTS + 8650752;
constexpr size_t WS_ROPE = WS_GB + 17039360;
constexpr size_t WS_BAR = WS_ROPE + 524288;
constexpr size_t WS_QUEUE = WS_BAR + 4096;
constexpr size_t WS_END = WS_QUEUE + 4096;

struct Params {
  const float* x_prompt; const float* x_sample;
  const float* cache_a_k; const float* cache_a_v; const float* cache_b_k; const float* cache_b_v;
  const float* norm_gain; const float* w_in; const float* w_out; const float* rel_bias;
  const float* lq1; const float* lk1; const float* lq2; const float* lk2;
  const float* subln; const float* final_gain;
  float* out; char* ws;
};

DI u32 pk2(float a, float b) { f2_t v = {a, b}; bf2_t r = __builtin_convertvector(v, bf2_t); return __builtin_bit_cast(u32, r); }
DI float bflo(u32 v) { return __uint_as_float(v << 16); }
DI float bfhi(u32 v) { return __uint_as_float(v & 0xffff0000u); }
DI int rho(int r) { return (r & ~12) | ((r & 4) << 1) | ((r & 8) >> 1); }
DI void gld16(uint4& dst, const void* p) { asm volatile("global_load_dwordx4 %0, %1, off" : "=v"(dst) : "v"(p) : "memory"); }
DI void wait_vm0() { asm volatile("s_waitcnt vmcnt(0)" ::: "memory"); }
DI float wave_sum(float v) {
#pragma unroll
  for (int o = 32; o > 0; o >>= 1) v += __shfl_xor(v, o);
  return v;
}


DI void ctr_barrier(unsigned* ctr, unsigned target) {
  __syncthreads();
  if (threadIdx.x == 0) {
    __builtin_amdgcn_fence(__ATOMIC_RELEASE, "agent");
    __hip_atomic_fetch_add(ctr, 1u, __ATOMIC_RELAXED, __HIP_MEMORY_SCOPE_AGENT);
    while (__hip_atomic_load(ctr, __ATOMIC_RELAXED, __HIP_MEMORY_SCOPE_AGENT) < target) __builtin_amdgcn_s_sleep(1);
    __builtin_amdgcn_fence(__ATOMIC_ACQUIRE, "agent");
  }
  __syncthreads();
}

DI void phase0(const Params& p, char* lds) {
  const int tid = threadIdx.x, bid = blockIdx.x, nb = gridDim.x;
  const int lane = tid & 63, w = tid >> 6;
  float* tile = (float*)lds;
  for (int i = bid * 512 + tid; i < 131072; i += nb * 512) {
    const int ln = i & 63, s_ = (i >> 6) & 63, ct = i >> 12, r_ = ln & 31, h_ = ln >> 5;
    float v[8];
#pragma unroll
    for (int j = 0; j < 8; ++j) v[j] = p.w_out[(size_t)(16 * s_ + 8 * h_ + j) * 1024 + ct * 32 + r_];
    uint4 o; o.x = pk2(v[0], v[1]); o.y = pk2(v[2], v[3]); o.z = pk2(v[4], v[5]); o.w = pk2(v[6], v[7]);
    *(uint4*)(p.ws + WS_WOUTT + (size_t)i * 16) = o;
  }
  for (int t = bid; t < 1024; t += nb) {
    const float* W; u16* WT; int N, kt, nt;
    { W = p.w_in; WT = (u16*)(p.ws + WS_WINT); N = 4096; kt = t >> 6; nt = t & 63; }
#pragma unroll
    for (int it = 0; it < 8; ++it) {
      int idx = it * 512 + tid, kk = idx >> 6, nn = idx & 63;
      tile[kk * 65 + nn] = W[(size_t)(kt * 64 + kk) * N + nt * 64 + nn];
    }
    __syncthreads();
    {
      int n = tid >> 3, kg = tid & 7;
      float v[8];
#pragma unroll
      for (int j = 0; j < 8; ++j) v[j] = tile[(kg * 8 + j) * 65 + n];
      uint4 o; o.x = pk2(v[0], v[1]); o.y = pk2(v[2], v[3]); o.z = pk2(v[4], v[5]); o.w = pk2(v[6], v[7]);
      *(uint4*)(WT + (size_t)(nt * 64 + n) * 1024 + kt * 64 + kg * 8) = o;
    }
    __syncthreads();
  }
  {
    u16* HN = (u16*)(p.ws + WS_HN);
    for (int row = bid * 8 + w; row < NTOK; row += nb * 8) {
      const float* src = row < NTOKP ? p.x_prompt + (size_t)row * 1024 : p.x_sample + (size_t)(row - NTOKP) * 1024;
      float4 v[4]; float ss = 0.f;
#pragma unroll
      for (int it = 0; it < 4; ++it) { v[it] = *(const float4*)(src + it * 256 + lane * 4); ss += v[it].x * v[it].x + v[it].y * v[it].y + v[it].z * v[it].z + v[it].w * v[it].w; }
      ss = wave_sum(ss);
      float inv = rsqrtf(ss * (1.f / 1024.f) + 1e-6f);
#pragma unroll
      for (int it = 0; it < 4; ++it) {
        float4 g = *(const float4*)(p.norm_gain + it * 256 + lane * 4);
        uint2 o; o.x = pk2(v[it].x * inv * g.x, v[it].y * inv * g.y); o.y = pk2(v[it].z * inv * g.z, v[it].w * inv * g.w);
        *(uint2*)(HN + (size_t)row * 1024 + it * 256 + lane * 4) = o;
      }
    }
  }
  const int gt = bid * 512 + tid, gn = nb * 512;
  {
    u16* KAS = (u16*)(p.ws + WS_KAS);
    for (int i = gt; i < 524288; i += gn) {
      int e = i * 4, b = e >> 18, key = (e >> 9) & 511, f = e & 511;
      float4 v = *(const float4*)(p.cache_a_k + e);
      uint2 o; o.x = pk2(v.x, v.y); o.y = pk2(v.z, v.w);
      *(uint2*)(KAS + (size_t)(b * 544 + key) * 512 + f) = o;
      if (key >= 32) *(float4*)(p.out + O_AKS + (size_t)(b * 512 + key - 32) * 512 + f) = v;
    }
    u16* KBS = (u16*)(p.ws + WS_KBS);
    for (int i = gt; i < 1048576; i += gn) {
      int e = i * 4, b = e >> 19, key = (e >> 9) & 1023, f = e & 511;
      float4 v = *(const float4*)(p.cache_b_k + e);
      uint2 o; o.x = pk2(v.x, v.y); o.y = pk2(v.z, v.w);
      *(uint2*)(KBS + (size_t)(b * 1056 + key) * 512 + f) = o;
    }
    u16* VATS = (u16*)(p.ws + WS_VATS);
    for (int i = gt; i < 262144; i += gn) {
      int f = i & 511, kg = (i >> 9) & 63, b = i >> 15;
      float v[8];
#pragma unroll
      for (int j = 0; j < 8; ++j) v[j] = p.cache_a_v[(size_t)(b * 512 + kg * 8 + j) * 512 + f];
      uint4 o; o.x = pk2(v[0], v[1]); o.y = pk2(v[2], v[3]); o.z = pk2(v[4], v[5]); o.w = pk2(v[6], v[7]);
      *(uint4*)(VATS + (size_t)(b * 512 + f) * 544 + kg * 8) = o;
      if (kg >= 4) {
#pragma unroll
        for (int j = 0; j < 8; ++j) p.out[O_AVS + (size_t)(b * 512 + kg * 8 + j - 32) * 512 + f] = v[j];
      }
    }
    u16* VBTS = (u16*)(p.ws + WS_VBTS);
    for (int i = gt; i < 524288; i += gn) {
      int f = i & 511, kg = (i >> 9) & 127, b = i >> 16;
      float v[8];
#pragma unroll
      for (int j = 0; j < 8; ++j) v[j] = p.cache_b_v[(size_t)(b * 1024 + kg * 8 + j) * 512 + f];
      uint4 o; o.x = pk2(v[0], v[1]); o.y = pk2(v[2], v[3]); o.z = pk2(v[4], v[5]); o.w = pk2(v[6], v[7]);
      *(uint4*)(VBTS + (size_t)(b * 512 + f) * 1056 + kg * 8) = o;
    }
  }
  {
    float2* RT = (float2*)(p.ws + WS_ROPE);
    for (int i = gt; i < 65536; i += gn) {
      int pos = i >> 3, m = i & 7;
      float inv = powf(500000.f, -(float)m * 0.125f);
      float ang = (float)pos * inv;
      RT[i] = make_float2(cosf(ang), sinf(ang));
    }
  }
}

template <bool SWAP>
DI void gemm_mainloop(const u16* __restrict__ A, const u16* __restrict__ Bt, int tm, int tn, char* lds, f32x16 (&acc)[2][2]) {
  const int tid = threadIdx.x, lane = tid & 63, w = tid >> 6, wm = w >> 1, wn = w & 1;
  const int r = lane & 31, h = lane >> 5;
  const u16* pa = A + (size_t)(tm * 256 + (tid >> 3)) * 1024 + (tid & 7) * 8;
  const u16* pb = Bt + (size_t)(tn * 128 + (tid >> 3)) * 1024 + (tid & 7) * 8;
  const int wofs = (tid >> 3) * 128 + ((((tid & 7) ^ ((tid >> 4) & 7))) << 4);
  const int swr = (r >> 1) & 7;
  uint4 ra[4], rb[2];
#pragma unroll
  for (int i = 0; i < 2; ++i)
#pragma unroll
    for (int j = 0; j < 2; ++j)
#pragma unroll
      for (int e = 0; e < 16; ++e) acc[i][j][e] = 0.f;
#pragma unroll
  for (int it = 0; it < 4; ++it) ra[it] = *(const uint4*)(pa + (size_t)it * 65536);
#pragma unroll
  for (int it = 0; it < 2; ++it) rb[it] = *(const uint4*)(pb + (size_t)it * 65536);
#pragma unroll
  for (int it = 0; it < 4; ++it) *(uint4*)(lds + it * 8192 + wofs) = ra[it];
#pragma unroll
  for (int it = 0; it < 2; ++it) *(uint4*)(lds + 32768 + it * 8192 + wofs) = rb[it];
  __syncthreads();
  for (int kt = 0; kt < 16; ++kt) {
    if (kt + 1 < 16) {
#pragma unroll
      for (int it = 0; it < 4; ++it) gld16(ra[it], pa + (size_t)it * 65536 + (kt + 1) * 64);
#pragma unroll
      for (int it = 0; it < 2; ++it) gld16(rb[it], pb + (size_t)it * 65536 + (kt + 1) * 64);
    }
    __builtin_amdgcn_sched_barrier(0);
    const char* ba = lds + (kt & 1) * 49152;
    const char* bb = ba + 32768;
    bf16x8 hf[2][2], wf[2][2];
    {
      const int co = ((h ^ swr) << 4);
#pragma unroll
      for (int i = 0; i < 2; ++i) hf[0][i] = *(const bf16x8*)(ba + (wm * 64 + i * 32 + r) * 128 + co);
#pragma unroll
      for (int j = 0; j < 2; ++j) wf[0][j] = *(const bf16x8*)(bb + (wn * 64 + j * 32 + r) * 128 + co);
    }
#pragma unroll
    for (int s = 0; s < 4; ++s) {
      if (s < 3) {
        const int co = (((2 * (s + 1) + h) ^ swr) << 4);
#pragma unroll
        for (int i = 0; i < 2; ++i) hf[(s + 1) & 1][i] = *(const bf16x8*)(ba + (wm * 64 + i * 32 + r) * 128 + co);
#pragma unroll
        for (int j = 0; j < 2; ++j) wf[(s + 1) & 1][j] = *(const bf16x8*)(bb + (wn * 64 + j * 32 + r) * 128 + co);
      }
#pragma unroll
      for (int i = 0; i < 2; ++i)
#pragma unroll
        for (int j = 0; j < 2; ++j) {
          if (SWAP) acc[j][i] = MFMA(wf[s & 1][j], hf[s & 1][i], acc[j][i]);
          else acc[i][j] = MFMA(hf[s & 1][i], wf[s & 1][j], acc[i][j]);
        }
      __builtin_amdgcn_sched_barrier(0);
    }
    if (kt + 1 < 16) {
      char* bw = lds + ((kt + 1) & 1) * 49152;
      wait_vm0();
#pragma unroll
      for (int it = 0; it < 4; ++it) *(uint4*)(bw + it * 8192 + wofs) = ra[it];
#pragma unroll
      for (int it = 0; it < 2; ++it) *(uint4*)(bw + 32768 + it * 8192 + wofs) = rb[it];
    }
    __syncthreads();
  }
}

DI float silu(float x) { return x / (1.f + __expf(-x)); }

DI float dpp_x1(float v) { return __int_as_float(__builtin_amdgcn_update_dpp(0, __float_as_int(v), 0xB1, 0xF, 0xF, true)); }
DI float dpp_x8(float v) { return __int_as_float(__builtin_amdgcn_update_dpp(0, __float_as_int(v), 0x128, 0xF, 0xF, true)); }
DI void store_bf16_tile(const f32x16& a, u16* base  , size_t ld, int h, int odd) {
#pragma unroll
  for (int g = 0; g < 4; ++g)
#pragma unroll
    for (int e = 0; e < 4; e += 2) {
      const float v0 = a[4 * g + e], v1 = a[4 * g + e + 1];
      const float n0 = dpp_x1(v0), n1 = dpp_x1(v1);
      const u32 o = odd ? pk2(n1, v1) : pk2(v0, n0);
      *(u32*)(base + (size_t)(8 * g + 4 * h + e + odd) * ld) = o;
      if (e == 2) __builtin_amdgcn_sched_barrier(0);
    }
}
DI void phase1(const Params& p, char* lds) {
  const u16* HN = (const u16*)(p.ws + WS_HN);
  const u16* WT = (const u16*)(p.ws + WS_WINT);
  const float2* RT = (const float2*)(p.ws + WS_ROPE);
  for (int tile = blockIdx.x; tile < 65 * 32; tile += gridDim.x) {
    const int tm = tile >> 5, tn = tile & 31;
    const int sec = tn >> 2;
    const bool sample = (tm == 64);
    f32x16 acc[2][2];
    gemm_mainloop<false>(HN, WT, tm, tn, lds, acc);
    int tid = threadIdx.x;
    asm volatile("" : "+v"(tid));
    const int lane = tid & 63, w = tid >> 6, wm = w >> 1, wn = w & 1;
    const int r = lane & 31, h = lane >> 5, odd = r & 1;
    const int tb = tm * 256 + wm * 64;
    const int fb = (tn & 3) * 128 + wn * 64;
    if (sec == 2 || sec == 6) {
#pragma unroll
      for (int i = 0; i < 2; ++i)
#pragma unroll
        for (int j = 0; j < 2; ++j) {
          const int fs = fb + j * 32 + r;
          char* trow = lds + (wn * 64 + j * 32 + r) * 528 + (wm * 64 + i * 32 + 4 * h) * 2;
#pragma unroll
          for (int g = 0; g < 4; ++g) {
            const int t = tb + i * 32 + 8 * g + 4 * h;
            const float v0 = acc[i][j][4 * g], v1 = acc[i][j][4 * g + 1], v2 = acc[i][j][4 * g + 2], v3 = acc[i][j][4 * g + 3];
            uint2 o; o.x = pk2(v0, v1); o.y = pk2(v2, v3);
            *(uint2*)(trow + g * 16) = o;
            float* d = nullptr;
            if (!sample) {
              const int b = t >> 13, s = t & 8191;
              if (sec == 6) d = p.out + O_BVP + (size_t)t * 512 + fs;
              else if (s >= 7680) d = p.out + O_AVP + ((size_t)(b * 512 + s - 7680)) * 512 + fs;
            } else {
              const int ts = t - NTOKP, b = ts >> 5, tt = ts & 31;
              if (sec == 6) d = p.out + O_BVS + (size_t)ts * 512 + fs;
              else d = p.out + O_AVS + ((size_t)(b * 512 + 480 + tt)) * 512 + fs;
            }
            if (d) { d[0] = v0; d[512] = v1; d[1024] = v2; d[1536] = v3; }
            __builtin_amdgcn_sched_barrier(0);
          }
        }
      __syncthreads();
      {
        u16* VT; size_t ldv;
        if (sec == 2) { VT = (u16*)(p.ws + (sample ? WS_VATS : WS_VAT)); ldv = sample ? 544 : 8192; }
        else { VT = (u16*)(p.ws + (sample ? WS_VBTS : WS_VBT)); ldv = sample ? 1056 : 8192; }
        const int sofs = sample ? (sec == 2 ? 512 : 1024) : 0;
#pragma unroll
        for (int it = 0; it < 8; ++it) {
          const int id = it * 512 + tid, row = id >> 5, c = id & 31;
          const uint4 v = *(const uint4*)(lds + row * 528 + c * 16);
          const int fs = (tn & 3) * 128 + row;
          if (!sample) {
            const int t0 = tm * 256 + c * 8, b = t0 >> 13, s = t0 & 8191;
            *(uint4*)(VT + ((size_t)(b * 512 + fs)) * ldv + s) = v;
          } else {
            const int b = c >> 2, tt = (c & 3) * 8;
            *(uint4*)(VT + ((size_t)(b * 512 + fs)) * ldv + sofs + tt) = v;
          }
        }
      }
      __syncthreads();
    } else {
      if (sec == 4 || sec == 5) {
        const float sgn = (r & 8) ? 1.f : -1.f;
        const int pos0 = sample ? (1024 + 4 * h) : ((tb & 8191) + 4 * h);
        const float2* rt = RT + pos0 * 8 + (r & 7);
#pragma unroll
        for (int i = 0; i < 2; ++i)
#pragma unroll
          for (int g = 0; g < 4; ++g) {
            const int po = (sample ? 0 : i * 32) + 8 * g;
            float2 cs[4];
#pragma unroll
            for (int e = 0; e < 4; ++e) cs[e] = rt[(po + e) * 8];
            __builtin_amdgcn_sched_barrier(0);
#pragma unroll
            for (int e = 0; e < 4; ++e) {
              const float x = acc[i][0][4 * g + e];
              const float xp = dpp_x8(x);
              if (r < 16) acc[i][0][4 * g + e] = x * cs[e].x + sgn * xp * cs[e].y;
            }
            __builtin_amdgcn_sched_barrier(0);
          }
      }
      if (sec == 3 || sec == 7) {
#pragma unroll
        for (int i = 0; i < 2; ++i)
#pragma unroll
          for (int j = 0; j < 2; ++j)
#pragma unroll
            for (int e = 0; e < 16; ++e) acc[i][j][e] = silu(acc[i][j][e]);
      }
      u16* dst; size_t trow0;
      if (sec == 0) { dst = (u16*)(p.ws + WS_QA); trow0 = tb; }
      else if (sec == 3) { dst = (u16*)(p.ws + WS_GA); trow0 = tb; }
      else if (sec == 4) { dst = (u16*)(p.ws + WS_QB); trow0 = tb; }
      else if (sec == 7) { dst = (u16*)(p.ws + WS_GB); trow0 = tb; }
      else if (sec == 1) {
        if (!sample) { dst = (u16*)(p.ws + WS_KA); trow0 = tb; }
        else { dst = (u16*)(p.ws + WS_KAS); trow0 = (size_t)(wm * 2) * 544 + 512; }
      } else {
        if (!sample) { dst = (u16*)(p.ws + WS_KB); trow0 = tb; }
        else { dst = (u16*)(p.ws + WS_KBS); trow0 = (size_t)(wm * 2) * 1056 + 1024; }
      }
      const size_t istep = sample ? (sec == 1 ? 544 : (sec == 5 ? 1056 : 32)) : 32;
#pragma unroll
      for (int i = 0; i < 2; ++i)
#pragma unroll
        for (int j = 0; j < 2; ++j)
          store_bf16_tile(acc[i][j], dst + (trow0 + i * istep) * 512 + fb + j * 32 + (r & ~1), 512, h, odd);
      if (sec == 1 || sec == 5) {
#pragma unroll
        for (int i = 0; i < 2; ++i) {
          float* d = nullptr;
          const int t0 = tb + i * 32;
          if (!sample) {
            const int b = t0 >> 13, s = t0 & 8191;
            if (sec == 5) d = p.out + O_BKP + (size_t)t0 * 512;
            else if (s >= 7680) d = p.out + O_AKP + ((size_t)(b * 512 + s - 7680)) * 512;
          } else {
            const int ts = t0 - NTOKP, b = ts >> 5;
            if (sec == 5) d = p.out + O_BKS + (size_t)ts * 512;
            else d = p.out + O_AKS + ((size_t)(b * 512 + 480)) * 512;
          }
          if (d) {
#pragma unroll
            for (int j = 0; j < 2; ++j)
#pragma unroll
              for (int e = 0; e < 16; ++e) {
                d[(size_t)(8 * (e >> 2) + 4 * h + (e & 3)) * 512 + fb + j * 32 + r] = acc[i][j][e];
                if ((e & 3) == 3) __builtin_amdgcn_sched_barrier(0);
              }
          }
        }
      }
    }
  }
}

constexpr float SM_C = 0.125f * 1.4426950408889634f;
template <int NQT, int DVT, bool BIAS>
DI void attn_wave(const u16* __restrict__ Q, int ldq, const u16* __restrict__ K, int ldk,
                  const u16* __restrict__ Vt, int ldv, int nkt, const float* bias_l2, int rel0,
                  f32x16 (&O)[NQT][DVT], float (&Mx)[NQT], float (&L)[NQT]) {
  const int lane = threadIdx.x & 63, r = lane & 31, h = lane >> 5;
  bf16x8 qf[NQT][4];
#pragma unroll
  for (int u = 0; u < NQT; ++u)
#pragma unroll
    for (int s = 0; s < 4; ++s) qf[u][s] = *(const bf16x8*)(Q + (size_t)(32 * u + r) * ldq + 16 * s + 8 * h);
#pragma unroll
  for (int u = 0; u < NQT; ++u) {
    Mx[u] = -INFINITY; L[u] = 0.f;
#pragma unroll
    for (int dt = 0; dt < DVT; ++dt)
#pragma unroll
      for (int e = 0; e < 16; ++e) O[u][dt][e] = 0.f;
  }
  const u16* kp = K + (size_t)rho(r) * ldk + 8 * h;
  const u16* vp = Vt + (size_t)r * ldv + 8 * h;
  bf16x8 kf[4];
#pragma unroll
  for (int s = 0; s < 4; ++s) kf[s] = *(const bf16x8*)(kp + 16 * s);
  for (int kt = 0; kt < nkt; ++kt) {
    bf16x8 vf[DVT][2];
#pragma unroll
    for (int dt = 0; dt < DVT; ++dt)
#pragma unroll
      for (int s2 = 0; s2 < 2; ++s2) vf[dt][s2] = *(const bf16x8*)(vp + (size_t)(32 * dt) * ldv + 32 * kt + 16 * s2);
    bf16x8 kn[4];
    {
      const int ktn = (kt + 1 < nkt) ? kt + 1 : kt;
#pragma unroll
      for (int s = 0; s < 4; ++s) kn[s] = *(const bf16x8*)(kp + (size_t)(32 * ktn) * ldk + 16 * s);
    }
    bf16x8 pf[NQT][2];
#pragma unroll
    for (int u = 0; u < NQT; ++u) {
      f32x16 S;
#pragma unroll
      for (int e = 0; e < 16; ++e) S[e] = 0.f;
#pragma unroll
      for (int s = 0; s < 4; ++s) S = MFMA(kf[s], qf[u][s], S);
      float t[16];
      if (BIAS) {
        const int relb = rel0 + 32 * u + r - 32 * kt - 8 * h;
        if (rel0 - 32 * kt - 31 >= 128) {
          const float bv = bias_l2[256];
#pragma unroll
          for (int e = 0; e < 16; ++e) t[e] = S[e] * SM_C + bv;
        } else {
#pragma unroll
          for (int e = 0; e < 16; ++e) {
            int rel = relb - ((e & 7) + 16 * (e >> 3));
            rel = rel < -128 ? -128 : (rel > 128 ? 128 : rel);
            t[e] = S[e] * SM_C + bias_l2[rel + 128];
          }
        }
      } else {
#pragma unroll
        for (int e = 0; e < 16; ++e) t[e] = S[e] * SM_C;
      }
      float mx = t[0];
#pragma unroll
      for (int e = 1; e < 16; ++e) mx = fmaxf(mx, t[e]);
      mx = fmaxf(mx, __shfl_xor(mx, 32));
      if (__any(mx > Mx[u] + 8.f)) {
        const float mn = fmaxf(Mx[u], mx);
        const float al = __builtin_amdgcn_exp2f(Mx[u] - mn);
        Mx[u] = mn; L[u] *= al;
#pragma unroll
        for (int dt = 0; dt < DVT; ++dt)
#pragma unroll
          for (int e = 0; e < 16; ++e) O[u][dt][e] *= al;
      }
      float ps = 0.f;
#pragma unroll
      for (int e = 0; e < 16; ++e) { t[e] = __builtin_amdgcn_exp2f(t[e] - Mx[u]); ps += t[e]; }
      L[u] += ps;
#pragma unroll
      for (int s2 = 0; s2 < 2; ++s2) {
        uint4 pk;
        pk.x = pk2(t[8 * s2], t[8 * s2 + 1]); pk.y = pk2(t[8 * s2 + 2], t[8 * s2 + 3]);
        pk.z = pk2(t[8 * s2 + 4], t[8 * s2 + 5]); pk.w = pk2(t[8 * s2 + 6], t[8 * s2 + 7]);
        pf[u][s2] = __builtin_bit_cast(bf16x8, pk);
      }
    }
#pragma unroll
    for (int u = 0; u < NQT; ++u)
#pragma unroll
      for (int dt = 0; dt < DVT; ++dt)
#pragma unroll
        for (int s2 = 0; s2 < 2; ++s2) O[u][dt] = MFMA(vf[dt][s2], pf[u][s2], O[u][dt]);
#pragma unroll
    for (int s = 0; s < 4; ++s) kf[s] = kn[s];
  }
#pragma unroll
  for (int u = 0; u < NQT; ++u) L[u] += __shfl_xor(L[u], 32);
}

template <int NQT>
DI void attnA_item(const Params& p, const u16* Q, const u16* K, const u16* Vt, int ldv, int nkt, int rel0,
                   const float* bias_l2, int tok0, int head) {
  f32x16 O[NQT][2]; float Mx[NQT], L[NQT];
  attn_wave<NQT, 2, true>(Q, 512, K, 512, Vt, ldv, nkt, bias_l2, rel0, O, Mx, L);
  const int lane = threadIdx.x & 63, r = lane & 31, h = lane >> 5;
  const u16* GA = (const u16*)(p.ws + WS_GA);
  u16* OB = (u16*)(p.ws + WS_HN);
#pragma unroll
  for (int u = 0; u < NQT; ++u) {
    const float inv = 1.f / L[u];
    const size_t tok = (size_t)(tok0 + 32 * u + r);
#pragma unroll
    for (int dt = 0; dt < 2; ++dt)
#pragma unroll
      for (int g = 0; g < 4; ++g) {
        const int dv = 32 * dt + 8 * g + 4 * h;
        const uint2 gg = *(const uint2*)(GA + tok * 512 + head * 64 + dv);
        uint2 o;
        o.x = pk2(O[u][dt][4 * g] * inv * bflo(gg.x), O[u][dt][4 * g + 1] * inv * bfhi(gg.x));
        o.y = pk2(O[u][dt][4 * g + 2] * inv * bflo(gg.y), O[u][dt][4 * g + 3] * inv * bfhi(gg.y));
        *(uint2*)(OB + tok * 1024 + head * 64 + dv) = o;
      }
  }
}

DI void attnB_epilogue(const Params& p, f32x16 (&O)[4], float Lsum, int tok0, int hb, float lam, float* xch) {
  const int lane = threadIdx.x & 63, r = lane & 31, h = lane >> 5, w = threadIdx.x >> 6, m = w >> 2, wsub = w & 3;
  const float inv = 1.f / Lsum;
  float* xw = xch + wsub * 4096 + lane;
  if (m == 1) {
    const float sc = inv * lam;
#pragma unroll
    for (int dt = 0; dt < 4; ++dt)
#pragma unroll
      for (int e = 0; e < 16; ++e) xw[(dt * 16 + e) * 64] = O[dt][e] * sc;
  }
  __syncthreads();
  if (m == 0) {
    float ss = 0.f;
#pragma unroll
    for (int dt = 0; dt < 4; ++dt)
#pragma unroll
      for (int e = 0; e < 16; ++e) { float o = O[dt][e] * inv - xw[(dt * 16 + e) * 64]; O[dt][e] = o; ss += o * o; }
    ss += __shfl_xor(ss, 32);
    const float rn = rsqrtf(ss * (1.f / 128.f) + 1e-6f) * 0.8f;
    const u16* GB = (const u16*)(p.ws + WS_GB);
    u16* OB = (u16*)(p.ws + WS_HN);
    const size_t tok = (size_t)(tok0 + r);
#pragma unroll
    for (int dt = 0; dt < 4; ++dt)
#pragma unroll
      for (int g = 0; g < 4; ++g) {
        const int dv = 32 * dt + 8 * g + 4 * h;
        const uint2 gg = *(const uint2*)(GB + tok * 512 + hb * 128 + dv);
        const float4 sg = *(const float4*)(p.subln + dv);
        uint2 o;
        o.x = pk2(O[dt][4 * g] * rn * sg.x * bflo(gg.x), O[dt][4 * g + 1] * rn * sg.y * bfhi(gg.x));
        o.y = pk2(O[dt][4 * g + 2] * rn * sg.z * bflo(gg.y), O[dt][4 * g + 3] * rn * sg.w * bfhi(gg.y));
        *(uint2*)(OB + tok * 1024 + 512 + hb * 128 + dv) = o;
      }
  }
  __syncthreads();
}

DI void attnB_item(const Params& p, const u16* Q, const u16* K, const u16* Vt, int ldv, int nkt, int tok0, int hb,
                   float lam, float* xch) {
  f32x16 O[1][4]; float Mx[1], L[1];
  attn_wave<1, 4, false>(Q, 512, K, 512, Vt, ldv, nkt, nullptr, 0, O, Mx, L);
  attnB_epilogue(p, O[0], L[0], tok0, hb, lam, xch);
}

typedef float f2 __attribute__((ext_vector_type(2)));
constexpr int BLK_V = 0, BLK_K = 49152, BLK_XCH = 81920, LDS_BIAS = 147456;
DI float half_max(float v) {
  auto rr = __builtin_amdgcn_permlane32_swap(__float_as_uint(v), __float_as_uint(v), false, false);
  return fmaxf(__uint_as_float(rr[0]), __uint_as_float(rr[1]));
}
DI void attnB_block(const Params& p, int b, int hb, int qt, float lam, char* lds) {
  const int tid = threadIdx.x, lane = tid & 63, r = lane & 31, h = lane >> 5, w = tid >> 6, m = w >> 2, wsub = w & 3;
  const bool late = (m == 1);
  const int q0 = qt * 128 + wsub * 32;
  const int nt = 2 * qt + 2;
  const int my_nt = (q0 >> 6) + 1;
  uint4 qraw[4];
  {
    const u16* Q = (const u16*)(p.ws + WS_QB) + (size_t)(b * SEQ + q0 + r) * 512 + hb * 128 + m * 64 + 8 * h;
#pragma unroll
    for (int s = 0; s < 4; ++s) gld16(qraw[s], Q + 16 * s);
  }
  f32x16 O[4];
#pragma unroll
  for (int dt = 0; dt < 4; ++dt)
#pragma unroll
    for (int e = 0; e < 16; ++e) O[dt][e] = 0.f;
  float Mx = -INFINITY;
  f2 L2 = {0.f, 0.f};
  const u16* gk = (const u16*)(p.ws + WS_KB) + (size_t)(b * SEQ + (tid >> 4)) * 512 + hb * 128 + (tid & 15) * 8;
  const u16* gv = (const u16*)(p.ws + WS_VBT) + (size_t)(b * 512 + hb * 128 + (tid >> 3)) * SEQ + (tid & 7) * 8;
  const int lk = BLK_K + ((tid >> 3) & 1) * 8192 + (tid >> 4) * 128 + ((((tid & 7) ^ ((tid >> 5) & 7))) << 4);
  const int lv = BLK_V + (tid >> 3) * 128 + ((((tid & 7) ^ ((tid >> 4) & 7))) << 4);
  const int rr = rho(r);
  const int swk = (rr >> 1) & 7, swv = (r >> 1) & 7;
  uint4 sk0, sk1, sv0, sv1;
  gld16(sk0, gk); gld16(sk1, gk + (size_t)32 * 512);
  gld16(sv0, gv); gld16(sv1, gv + (size_t)64 * SEQ);
  wait_vm0();
  *(uint4*)(lds + lk) = sk0; *(uint4*)(lds + lk + 4096) = sk1;
  *(uint4*)(lds + lv) = sv0; *(uint4*)(lds + lv + 8192) = sv1;
  bf16x8 qf[4];
#pragma unroll
  for (int s = 0; s < 4; ++s) qf[s] = __builtin_bit_cast(bf16x8, qraw[s]);
  bf16x8 pf[4];
#pragma unroll
  for (int s = 0; s < 4; ++s) pf[s] = qf[s];
  __syncthreads();
  int vs = 0;
  for (int t = 0; t <= nt; ++t) {
    if (t + 1 < nt) {
      gld16(sk0, gk + (size_t)(64 * (t + 1)) * 512);
      gld16(sk1, gk + (size_t)(64 * (t + 1) + 32) * 512);
      gld16(sv0, gv + 64 * (t + 1));
      gld16(sv1, gv + (size_t)64 * SEQ + 64 * (t + 1));
    }
    __builtin_amdgcn_sched_barrier(0);
    if (late && t >= 1 && t - 1 < my_nt) {
      const char* vb = lds + BLK_V + (vs == 0 ? 2 : vs - 1) * 16384;
#pragma unroll
      for (int ks = 0; ks < 4; ++ks) {
        const int co = (((2 * ks + h) ^ swv) << 4);
#pragma unroll
        for (int dt = 0; dt < 4; ++dt) {
          bf16x8 v = *(const bf16x8*)(vb + (32 * dt + r) * 128 + co);
          O[dt] = MFMA(v, pf[ks], O[dt]);
        }
      }
    }
    if (t < my_nt && t < nt) {
      const char* kb = lds + BLK_K + (t & 1) * 16384 + m * 8192;
      f32x16 S0, S1;
#pragma unroll
      for (int e = 0; e < 16; ++e) { S0[e] = 0.f; S1[e] = 0.f; }
      bf16x8 ka[4], kc[4];
#pragma unroll
      for (int s = 0; s < 4; ++s) {
        const int co = (((2 * s + h) ^ swk) << 4);
        ka[s] = *(const bf16x8*)(kb + rr * 128 + co);
        kc[s] = *(const bf16x8*)(kb + (32 + rr) * 128 + co);
      }
#pragma unroll
      for (int s = 0; s < 4; ++s) {
        S0 = MFMA(ka[s], qf[s], S0);
        S1 = MFMA(kc[s], qf[s], S1);
      }
      f2 tv[16];
      const f2 cc = {SM_C, SM_C};
#pragma unroll
      for (int e = 0; e < 8; ++e) {
        f2 a = {S0[2 * e], S0[2 * e + 1]}; tv[e] = a * cc;
        f2 c = {S1[2 * e], S1[2 * e + 1]}; tv[8 + e] = c * cc;
      }
      float mx = fmaxf(tv[0].x, tv[0].y);
#pragma unroll
      for (int e = 1; e < 16; ++e) mx = fmaxf(mx, fmaxf(tv[e].x, tv[e].y));
      mx = half_max(mx);
      if (__any(mx > Mx + 8.f)) {
        const float mn = fmaxf(Mx, mx);
        const float al = __builtin_amdgcn_exp2f(Mx - mn);
        Mx = mn; L2 *= al;
#pragma unroll
        for (int dt = 0; dt < 4; ++dt)
#pragma unroll
          for (int e = 0; e < 16; ++e) O[dt][e] *= al;
      }
      const f2 nm = {-Mx, -Mx};
#pragma unroll
      for (int e = 0; e < 16; ++e) {
        f2 d = tv[e] + nm;
        d.x = __builtin_amdgcn_exp2f(d.x); d.y = __builtin_amdgcn_exp2f(d.y);
        L2 += d;
        tv[e] = d;
      }
#pragma unroll
      for (int s2 = 0; s2 < 4; ++s2) {
        uint4 pa;
        pa.x = pk2(tv[4 * s2].x, tv[4 * s2].y); pa.y = pk2(tv[4 * s2 + 1].x, tv[4 * s2 + 1].y);
        pa.z = pk2(tv[4 * s2 + 2].x, tv[4 * s2 + 2].y); pa.w = pk2(tv[4 * s2 + 3].x, tv[4 * s2 + 3].y);
        pf[s2] = __builtin_bit_cast(bf16x8, pa);
      }
      if (!late) {
        const char* vb = lds + BLK_V + vs * 16384;
#pragma unroll
        for (int ks = 0; ks < 4; ++ks) {
          const int co = (((2 * ks + h) ^ swv) << 4);
#pragma unroll
          for (int dt = 0; dt < 4; ++dt) {
            bf16x8 v = *(const bf16x8*)(vb + (32 * dt + r) * 128 + co);
            O[dt] = MFMA(v, pf[ks], O[dt]);
          }
        }
      }
    }
    if (t + 1 < nt) {
      const int vn = (vs == 2 ? 0 : vs + 1);
      wait_vm0();
      *(uint4*)(lds + lk + ((t + 1) & 1) * 16384) = sk0; *(uint4*)(lds + lk + ((t + 1) & 1) * 16384 + 4096) = sk1;
      *(uint4*)(lds + lv + vn * 16384) = sv0; *(uint4*)(lds + lv + vn * 16384 + 8192) = sv1;
    }
    vs = (vs == 2 ? 0 : vs + 1);
    __syncthreads();
  }
  float L = L2.x + L2.y;
  L += __shfl_xor(L, 32);
  attnB_epilogue(p, O, L, b * SEQ + q0, hb, lam, (float*)(lds + BLK_XCH));
}

DI float phase2_setup(const Params& p, char* lds) {
  const int tid = threadIdx.x, lane = tid & 63;
  float* bias = (float*)(lds + LDS_BIAS);
  for (int i = tid; i < 8 * 257; i += 512) { int hh = i / 257, k = i - hh * 257; bias[hh * 260 + k] = p.rel_bias[i] * 1.4426950408889634f; }
  float a = p.lq1[lane] * p.lk1[lane], b = p.lq2[lane] * p.lk2[lane];
  a = wave_sum(a); b = wave_sum(b);
  __syncthreads();
  return expf(a) - expf(b) + 0.2f;
}
#define WAIT_VM(n) asm volatile("s_waitcnt vmcnt(" #n ")" ::: "memory")
DI void p3_tile(const Params& p, char* lds, int tok0) {
  int tid = threadIdx.x;
  asm volatile("" : "+v"(tid));
  const int lane = tid & 63, w = tid >> 6, r = lane & 31, h = lane >> 5;
  const u16* OB = (const u16*)(p.ws + WS_HN);
  float* red = (float*)(lds + 131072);
  __syncthreads();
#pragma unroll
  for (int half = 0; half < 2; ++half) {
    uint4 a[8];
#pragma unroll
    for (int it = 0; it < 8; ++it) a[it] = *(const uint4*)(OB + (size_t)(tok0 + half * 32 + it * 4 + (tid >> 7)) * 1024 + (tid & 127) * 8);
#pragma unroll
    for (int it = 0; it < 8; ++it) {
      const int row = half * 32 + it * 4 + (tid >> 7);
      *(uint4*)(lds + row * 2048 + ((((tid & 127) ^ (row & 15))) << 4)) = a[it];
    }
  }
  f32x16 acc[2][4];
#pragma unroll
  for (int i = 0; i < 2; ++i)
#pragma unroll
    for (int j = 0; j < 4; ++j)
#pragma unroll
      for (int e = 0; e < 16; ++e) acc[i][j][e] = 0.f;
  const char* wp = p.ws + WS_WOUTT + ((size_t)(w * 4) * 4096 + lane) * 16;
  const char* ap = lds + r * 2048;
  const int akey = r & 15;
  uint4 bq[3][4];
#pragma unroll
  for (int s = 0; s < 3; ++s)
#pragma unroll
    for (int j = 0; j < 4; ++j) gld16(bq[s][j], wp + (size_t)(j * 4096 + s * 64) * 16);
  __syncthreads();
#define P3_KSTEP(KS, SLOT, WAITN, REFILL)                                                        \
  {                                                                                              \
    const int co_ = ((((2 * (KS) + h) ^ akey)) << 4);                                            \
    const bf16x8 a0_ = *(const bf16x8*)(ap + co_);                                               \
    const bf16x8 a1_ = *(const bf16x8*)(ap + 65536 + co_);                                       \
    WAIT_VM(WAITN);                                                                              \
    __builtin_amdgcn_sched_barrier(0);                                                           \
    _Pragma("unroll") for (int j = 0; j < 4; ++j) {                                              \
      const bf16x8 bf_ = __builtin_bit_cast(bf16x8, bq[SLOT][j]);                                \
      acc[0][j] = MFMA(a0_, bf_, acc[0][j]);                                                     \
      acc[1][j] = MFMA(a1_, bf_, acc[1][j]);                                                     \
    }                                                                                            \
    __builtin_amdgcn_sched_barrier(0);                                                           \
    if (REFILL) {                                                                                \
      _Pragma("unroll") for (int j = 0; j < 4; ++j) gld16(bq[SLOT][j], wp + (size_t)(j * 4096 + ((KS) + 3) * 64) * 16); \
    }                                                                                            \
    __builtin_amdgcn_sched_barrier(0);                                                           \
  }
#pragma unroll 1
  for (int g = 0; g < 20; ++g) {
    P3_KSTEP(3 * g, 0, 8, true)
    P3_KSTEP(3 * g + 1, 1, 8, true)
    P3_KSTEP(3 * g + 2, 2, 8, true)
  }
  P3_KSTEP(60, 0, 8, true)
  P3_KSTEP(61, 1, 8, false)
  P3_KSTEP(62, 2, 4, false)
  P3_KSTEP(63, 0, 0, false)
  const float* xr = tok0 < NTOKP ? p.x_prompt + (size_t)tok0 * 1024 : p.x_sample + (size_t)(tok0 - NTOKP) * 1024;
  const unsigned cb = w * 128 + r;
#pragma unroll
  for (int i = 0; i < 2; ++i) {
#pragma unroll
    for (int e = 0; e < 16; ++e) {
      const int row = 32 * i + 8 * (e >> 2) + 4 * h + (e & 3);
      unsigned off = row * 1024 + cb;
      asm volatile("" : "+v"(off));
      float ssv = 0.f;
#pragma unroll
      for (int j = 0; j < 4; ++j) {
        const float y = acc[i][j][e] + xr[off + j * 32];
        acc[i][j][e] = y; ssv += y * y;
      }
      ssv += __shfl_xor(ssv, 1); ssv += __shfl_xor(ssv, 2); ssv += __shfl_xor(ssv, 4); ssv += __shfl_xor(ssv, 8); ssv += __shfl_xor(ssv, 16);
      if (r == 0) red[w * 64 + row] = ssv;
      if ((e & 3) == 3) __builtin_amdgcn_sched_barrier(0);
    }
  }
  __syncthreads();
  if (tid < 64) {
    float t = 0.f;
#pragma unroll
    for (int k = 0; k < 8; ++k) t += red[k * 64 + tid];
    red[512 + tid] = rsqrtf(t * (1.f / 1024.f) + 1e-6f);
  }
  __syncthreads();
  float* yr = p.out + O_YP + (size_t)tok0 * 1024;
  float gj[4];
#pragma unroll
  for (int j = 0; j < 4; ++j) gj[j] = p.final_gain[cb + j * 32];
#pragma unroll
  for (int i = 0; i < 2; ++i) {
#pragma unroll
    for (int e = 0; e < 16; ++e) {
      const int row = 32 * i + 8 * (e >> 2) + 4 * h + (e & 3);
      unsigned off = row * 1024 + cb;
      asm volatile("" : "+v"(off));
      const float ri = red[512 + row];
#pragma unroll
      for (int j = 0; j < 4; ++j) yr[off + j * 32] = acc[i][j][e] * ri * gj[j];
      if ((e & 3) == 3) __builtin_amdgcn_sched_barrier(0);
    }
  }
}

constexpr int NQUEUE = 12;
DI int q_pop(unsigned* ctr, int* slot) {
  __syncthreads();
  if (threadIdx.x == 0) *slot = (int)__hip_atomic_fetch_add(ctr, 1u, __ATOMIC_RELAXED, __HIP_MEMORY_SCOPE_AGENT);
  __syncthreads();
  return *slot;
}
DI void p2_all(const Params& p, char* lds, float lam) {
  const int w = threadIdx.x >> 6;
  unsigned* Q = (unsigned*)(p.ws + WS_QUEUE);
  int* slot = (int*)(lds + LDS_BIAS + 8320);
  float* xch = (float*)(lds + 65536);
  const float* bias = (const float*)(lds + LDS_BIAS);
  const u16* QA = (const u16*)(p.ws + WS_QA);
  const u16* QB = (const u16*)(p.ws + WS_QB);
  {
    const int it = q_pop(Q, slot);
    if (it < 8) {
      const int m = w >> 2, wsub = w & 3, id = it * 4 + wsub, b = id >> 2, hb = id & 3;
      attnB_item(p, QB + (size_t)(NTOKP + b * 32) * 512 + hb * 128 + m * 64,
                 (const u16*)(p.ws + WS_KBS) + (size_t)(b * 1056) * 512 + hb * 128 + m * 64,
                 (const u16*)(p.ws + WS_VBTS) + (size_t)(b * 512 + hb * 128) * 1056, 1056, 33, NTOKP + b * 32, hb, lam, xch);
    } else if (it < 16) {
      const int b = it - 8;
      attnA_item<1>(p, QA + (size_t)(NTOKP + b * 32) * 512 + w * 64,
                    (const u16*)(p.ws + WS_KAS) + (size_t)(b * 544) * 512 + w * 64,
                    (const u16*)(p.ws + WS_VATS) + (size_t)(b * 512 + w * 64) * 544, 544, 17, 512, bias + w * 260,
                    NTOKP + b * 32, w);
    }
    if (it < 16) {
      asm volatile("s_waitcnt vmcnt(0)" ::: "memory");
      __syncthreads();
      if (threadIdx.x == 0) {
        __builtin_amdgcn_fence(__ATOMIC_RELEASE, "agent");
        __hip_atomic_fetch_add(Q + 64 * 11, 1u, __ATOMIC_RELAXED, __HIP_MEMORY_SCOPE_AGENT);
      }
    }
  }
#pragma unroll 1
  for (int k = 0; k < 8; ++k) {
    const int x = (blockIdx.x + k) & 7;
#pragma unroll 1
    for (;;) {
      const int i = q_pop(Q + 64 * (1 + x), slot);
      if (i >= 64) break;
      attnB_block(p, x >> 2, x & 3, 63 - i, lam, lds);
    }
  }
#pragma unroll 1
  for (;;) {
    const int it = q_pop(Q + 64 * 9, slot);
    if (it >= 256) break;
    const int b = it >> 7, c = it & 127, cs = c > 8 ? c - 8 : 0;
    attnA_item<2>(p, QA + (size_t)(b * SEQ + c * 64) * 512 + w * 64,
                  (const u16*)(p.ws + WS_KA) + (size_t)(b * SEQ + cs * 64) * 512 + w * 64,
                  (const u16*)(p.ws + WS_VAT) + (size_t)(b * 512 + w * 64) * SEQ + cs * 64, SEQ,
                  (c + 1 - cs) * 2, 64 * (c - cs), bias + w * 260, b * SEQ + c * 64, w);
  }
#pragma unroll 1
  for (;;) {
    const int it = q_pop(Q + 64 * 10, slot);
    if (it >= 4) break;
    if (threadIdx.x == 0) {
      while (__hip_atomic_load(Q + 64 * 11, __ATOMIC_RELAXED, __HIP_MEMORY_SCOPE_AGENT) < 16u) __builtin_amdgcn_s_sleep(2);
      __builtin_amdgcn_fence(__ATOMIC_ACQUIRE, "agent");
    }
    __syncthreads();
    p3_tile(p, lds, NTOKP + it * 64);
  }
}

DI void phase3(const Params& p, char* lds) {
  const u16* OB = (const u16*)(p.ws + WS_HN);
  const u16* WT = (const u16*)(p.ws + WS_WOUTT);
  for (int tile = blockIdx.x; tile < 65 * 8; tile += gridDim.x) {
    const int tm = tile >> 3, tn = tile & 7;
    f32x16 acc[2][2];
    gemm_mainloop<false>(OB, WT, tm, tn, lds, acc);
    int tid = threadIdx.x;
    asm volatile("" : "+v"(tid));
    const int lane = tid & 63, w = tid >> 6, wm = w >> 1, wn = w & 1;
    const int r = lane & 31, h = lane >> 5;
#pragma unroll
    for (int i = 0; i < 2; ++i) {
      const int t0 = tm * 256 + wm * 64 + i * 32;
      const float* xr = t0 < NTOKP ? p.x_prompt + (size_t)t0 * 1024 : p.x_sample + (size_t)(t0 - NTOKP) * 1024;
      float* yr = p.out + O_YP + (size_t)t0 * 1024;
#pragma unroll
      for (int j = 0; j < 2; ++j) {
        const int f = tn * 128 + wn * 64 + j * 32 + r;
#pragma unroll
        for (int e = 0; e < 16; ++e) {
          const size_t o = (size_t)(8 * (e >> 2) + 4 * h + (e & 3)) * 1024 + f;
          yr[o] = xr[o] + acc[i][j][e];
          if ((e & 3) == 3) __builtin_amdgcn_sched_barrier(0);
        }
      }
    }
  }
}

DI void phase4(const Params& p) {
  const int lane = threadIdx.x & 63, w = threadIdx.x >> 6;
  for (int row = blockIdx.x * 8 + w; row < NTOK; row += gridDim.x * 8) {
    float* y = p.out + O_YP + (size_t)row * 1024;
    float4 v[4]; float ss = 0.f;
#pragma unroll
    for (int it = 0; it < 4; ++it) { v[it] = *(const float4*)(y + it * 256 + lane * 4); ss += v[it].x * v[it].x + v[it].y * v[it].y + v[it].z * v[it].z + v[it].w * v[it].w; }
    ss = wave_sum(ss);
    const float inv = rsqrtf(ss * (1.f / 1024.f) + 1e-6f);
#pragma unroll
    for (int it = 0; it < 4; ++it) {
      float4 g = *(const float4*)(p.final_gain + it * 256 + lane * 4);
      *(float4*)(y + it * 256 + lane * 4) = make_float4(v[it].x * inv * g.x, v[it].y * inv * g.y, v[it].z * inv * g.z, v[it].w * inv * g.w);
    }
  }
}

__global__ void __launch_bounds__(512) fwd_megakernel(Params p) {
  __shared__ __attribute__((aligned(16))) char lds[155904];
  cg::grid_group grid = cg::this_grid();
  unsigned* ctr = (unsigned*)(p.ws + WS_BAR);
  const unsigned G = gridDim.x;
  if (blockIdx.x == 0 && threadIdx.x == 0) *ctr = 0u;
  if (blockIdx.x == 0 && threadIdx.x < NQUEUE) ((unsigned*)(p.ws + WS_QUEUE))[64 * threadIdx.x] = 0u;
  phase0(p, lds);
  grid.sync();
  phase1(p, lds);
  ctr_barrier(ctr, G);
  {
    const float lam = phase2_setup(p, lds);
    p2_all(p, lds, lam);
  }
  ctr_barrier(ctr, 2 * G);
  for (int t = blockIdx.x; t < 256; t += gridDim.x) p3_tile(p, lds, t * 64);
}

extern "C" void kernel_launch(void* const* d_in, const int* in_sizes, int n_in, void* d_out, int out_size, void* d_ws,
                              size_t ws_size, hipStream_t stream) {
  static int grid_blocks = 0;
  if (!grid_blocks) {
    int dev = 0, cus = 0, per_cu = 0;
    hipGetDevice(&dev);
    hipDeviceGetAttribute(&cus, hipDeviceAttributeMultiprocessorCount, dev);
    hipOccupancyMaxActiveBlocksPerMultiprocessor(&per_cu, fwd_megakernel, 512, 0);
    if (per_cu < 1) per_cu = 1;
    grid_blocks = cus;
  }
  Params p{};
  p.x_prompt = (const float*)d_in[0]; p.x_sample = (const float*)d_in[1];
  p.cache_a_k = (const float*)d_in[2]; p.cache_a_v = (const float*)d_in[3];
  p.cache_b_k = (const float*)d_in[4]; p.cache_b_v = (const float*)d_in[5];
  p.norm_gain = (const float*)d_in[6]; p.w_in = (const float*)d_in[7]; p.w_out = (const float*)d_in[8];
  p.rel_bias = (const float*)d_in[9];
  p.lq1 = (const float*)d_in[10]; p.lk1 = (const float*)d_in[11]; p.lq2 = (const float*)d_in[12]; p.lk2 = (const float*)d_in[13];
  p.subln = (const float*)d_in[14]; p.final_gain = (const float*)d_in[15];
  p.out = (float*)d_out; p.ws = (char*)d_ws;
  void* args[] = {&p};
  hipError_t e = hipLaunchCooperativeKernel((void*)fwd_megakernel, dim3(grid_blocks), dim3(512), args, 0, stream);
  if (e != hipSuccess) fprintf(stderr, "cooperative launch failed: %s (grid %d)\n", hipGetErrorString(e), grid_blocks);
}
```

```cpp
#include <hip/hip_runtime.h>
#include <hip/hip_cooperative_groups.h>
#include <cstdio>
namespace cg = cooperative_groups;

typedef short bf16x8 __attribute__((ext_vector_type(8)));
typedef float f32x16 __attribute__((ext_vector_type(16)));
typedef __bf16 bf2_t __attribute__((ext_vector_type(2)));
typedef float f2_t __attribute__((ext_vector_type(2)));
typedef unsigned u32;
typedef unsigned short u16;
#define DI __device__ __forceinline__
#define MFMA(a, b, c) __builtin_amdgcn_mfma_f32_32x32x16_bf16((a), (b), (c), 0, 0, 0)

constexpr int NTOKP = 16384;
constexpr int NTOK = 16640;
constexpr int SEQ = 8192;
constexpr size_t O_YP = 0;
constexpr size_t O_AKP = 17039360, O_AVP = 17563648, O_BKP = 18087936, O_BVP = 26476544;
constexpr size_t O_AKS = 34865152, O_AVS = 36962304, O_BKS = 39059456, O_BVS = 39190528;
constexpr size_t WS_WINT = 0;
constexpr size_t WS_WOUTT = WS_WINT + 8388608;
constexpr size_t WS_HN = WS_WOUTT + 2097152;
constexpr size_t WS_QA = WS_HN + 34078720;
constexpr size_t WS_KA = WS_QA + 17039360;
constexpr size_t WS_KAS = WS_KA + 16777216;
constexpr size_t WS_VAT = WS_KAS + 4456448;
constexpr size_t WS_VATS = WS_VAT + 16777216;
constexpr size_t WS_GA = WS_VATS + 4456448;
constexpr size_t WS_QB = WS_GA + 17039360;
constexpr size_t WS_KB = WS_QB + 17039360;
constexpr size_t WS_KBS = WS_KB + 16777216;
constexpr size_t WS_VBT = WS_KBS + 8650752;
constexpr size_t WS_VBTS = WS_VBT + 16777216;
constexpr size_t WS_GB = WS_VBTS + 8650752;
constexpr size_t WS_ROPE = WS_GB + 17039360;
constexpr size_t WS_BAR = WS_ROPE + 524288;
constexpr size_t WS_QUEUE = WS_BAR + 4096;
constexpr size_t WS_END = WS_QUEUE + 4096;

struct Params {
  const float* x_prompt; const float* x_sample;
  const float* cache_a_k; const float* cache_a_v; const float* cache_b_k; const float* cache_b_v;
  const float* norm_gain; const float* w_in; const float* w_out; const float* rel_bias;
  const float* lq1; const float* lk1; const float* lq2; const float* lk2;
  const float* subln; const float* final_gain;
  float* out; char* ws;
};

DI u32 pk2(float a, float b) { f2_t v = {a, b}; bf2_t r = __builtin_convertvector(v, bf2_t); return __builtin_bit_cast(u32, r); }
DI float bflo(u32 v) { return __uint_as_float(v << 16); }
DI float bfhi(u32 v) { return __uint_as_float(v & 0xffff0000u); }
DI int rho(int r) { return (r & ~12) | ((r & 4) << 1) | ((r & 8) >> 1); }
DI void gld16(uint4& dst, const void* p) { asm volatile("global_load_dwordx4 %0, %1, off" : "=v"(dst) : "v"(p) : "memory"); }
#define WAIT_VM(n) asm volatile("s_waitcnt vmcnt(" #n ")" ::: "memory")
DI void wait_vm0() { asm volatile("s_waitcnt vmcnt(0)" ::: "memory"); }
DI float wave_sum(float v) {
#pragma unroll
  for (int o = 32; o > 0; o >>= 1) v += __shfl_xor(v, o);
  return v;
}


DI void ctr_barrier(unsigned* ctr, unsigned target) {
  __syncthreads();
  if (threadIdx.x == 0) {
    __builtin_amdgcn_fence(__ATOMIC_RELEASE, "agent");
    __hip_atomic_fetch_add(ctr, 1u, __ATOMIC_RELAXED, __HIP_MEMORY_SCOPE_AGENT);
    while (__hip_atomic_load(ctr, __ATOMIC_RELAXED, __HIP_MEMORY_SCOPE_AGENT) < target) __builtin_amdgcn_s_sleep(1);
    __builtin_amdgcn_fence(__ATOMIC_ACQUIRE, "agent");
  }
  __syncthreads();
}

DI void phase0(const Params& p, char* lds) {
  const int tid = threadIdx.x, bid = blockIdx.x, nb = gridDim.x;
  const int lane = tid & 63, w = tid >> 6;
  float* tile = (float*)lds;
  for (int i = bid * 512 + tid; i < 131072; i += nb * 512) {
    const int ln = i & 63, s_ = (i >> 6) & 63, ct = i >> 12, r_ = ln & 31, h_ = ln >> 5;
    float v[8];
#pragma unroll
    for (int j = 0; j < 8; ++j) v[j] = p.w_out[(size_t)(16 * s_ + 8 * h_ + j) * 1024 + ct * 32 + r_];
    uint4 o; o.x = pk2(v[0], v[1]); o.y = pk2(v[2], v[3]); o.z = pk2(v[4], v[5]); o.w = pk2(v[6], v[7]);
    *(uint4*)(p.ws + WS_WOUTT + (size_t)i * 16) = o;
  }
  for (int t = bid; t < 1024; t += nb) {
    const float* W; u16* WT; int N, kt, nt;
    { W = p.w_in; WT = (u16*)(p.ws + WS_WINT); N = 4096; kt = t >> 6; nt = t & 63; }
#pragma unroll
    for (int it = 0; it < 8; ++it) {
      int idx = it * 512 + tid, kk = idx >> 6, nn = idx & 63;
      tile[kk * 65 + nn] = W[(size_t)(kt * 64 + kk) * N + nt * 64 + nn];
    }
    __syncthreads();
    {
      int n = tid >> 3, kg = tid & 7;
      float v[8];
#pragma unroll
      for (int j = 0; j < 8; ++j) v[j] = tile[(kg * 8 + j) * 65 + n];
      uint4 o; o.x = pk2(v[0], v[1]); o.y = pk2(v[2], v[3]); o.z = pk2(v[4], v[5]); o.w = pk2(v[6], v[7]);
      *(uint4*)(WT + (size_t)(nt * 64 + n) * 1024 + kt * 64 + kg * 8) = o;
    }
    __syncthreads();
  }
  {
    u16* HN = (u16*)(p.ws + WS_HN);
    for (int row = bid * 8 + w; row < NTOK; row += nb * 8) {
      const float* src = row < NTOKP ? p.x_prompt + (size_t)row * 1024 : p.x_sample + (size_t)(row - NTOKP) * 1024;
      float4 v[4]; float ss = 0.f;
#pragma unroll
      for (int it = 0; it < 4; ++it) { v[it] = *(const float4*)(src + it * 256 + lane * 4); ss += v[it].x * v[it].x + v[it].y * v[it].y + v[it].z * v[it].z + v[it].w * v[it].w; }
      ss = wave_sum(ss);
      float inv = rsqrtf(ss * (1.f / 1024.f) + 1e-6f);
#pragma unroll
      for (int it = 0; it < 4; ++it) {
        float4 g = *(const float4*)(p.norm_gain + it * 256 + lane * 4);
        uint2 o; o.x = pk2(v[it].x * inv * g.x, v[it].y * inv * g.y); o.y = pk2(v[it].z * inv * g.z, v[it].w * inv * g.w);
        *(uint2*)(HN + (size_t)row * 1024 + it * 256 + lane * 4) = o;
      }
    }
  }
  const int gt = bid * 512 + tid, gn = nb * 512;
  {
    u16* KAS = (u16*)(p.ws + WS_KAS);
    for (int i = gt; i < 524288; i += gn) {
      int e = i * 4, b = e >> 18, key = (e >> 9) & 511, f = e & 511;
      float4 v = *(const float4*)(p.cache_a_k + e);
      uint2 o; o.x = pk2(v.x, v.y); o.y = pk2(v.z, v.w);
      *(uint2*)(KAS + (size_t)(b * 544 + key) * 512 + f) = o;
      if (key >= 32) *(float4*)(p.out + O_AKS + (size_t)(b * 512 + key - 32) * 512 + f) = v;
    }
    u16* KBS = (u16*)(p.ws + WS_KBS);
    for (int i = gt; i < 1048576; i += gn) {
      int e = i * 4, b = e >> 19, key = (e >> 9) & 1023, f = e & 511;
      float4 v = *(const float4*)(p.cache_b_k + e);
      uint2 o; o.x = pk2(v.x, v.y); o.y = pk2(v.z, v.w);
      *(uint2*)(KBS + (size_t)(b * 1056 + key) * 512 + f) = o;
    }
    u16* VATS = (u16*)(p.ws + WS_VATS);
    for (int i = gt; i < 262144; i += gn) {
      int f = i & 511, kg = (i >> 9) & 63, b = i >> 15;
      float v[8];
#pragma unroll
      for (int j = 0; j < 8; ++j) v[j] = p.cache_a_v[(size_t)(b * 512 + kg * 8 + j) * 512 + f];
      uint4 o; o.x = pk2(v[0], v[1]); o.y = pk2(v[2], v[3]); o.z = pk2(v[4], v[5]); o.w = pk2(v[6], v[7]);
      *(uint4*)(VATS + (size_t)(b * 512 + f) * 544 + kg * 8) = o;
      if (kg >= 4) {
#pragma unroll
        for (int j = 0; j < 8; ++j) p.out[O_AVS + (size_t)(b * 512 + kg * 8 + j - 32) * 512 + f] = v[j];
      }
    }
    u16* VBTS = (u16*)(p.ws + WS_VBTS);
    for (int i = gt; i < 524288; i += gn) {
      int f = i & 511, kg = (i >> 9) & 127, b = i >> 16;
      float v[8];
#pragma unroll
      for (int j = 0; j < 8; ++j) v[j] = p.cache_b_v[(size_t)(b * 1024 + kg * 8 + j) * 512 + f];
      uint4 o; o.x = pk2(v[0], v[1]); o.y = pk2(v[2], v[3]); o.z = pk2(v[4], v[5]); o.w = pk2(v[6], v[7]);
      *(uint4*)(VBTS + (size_t)(b * 512 + f) * 1056 + kg * 8) = o;
    }
  }
  {
    float2* RT = (float2*)(p.ws + WS_ROPE);
    for (int i = gt; i < 65536; i += gn) {
      int pos = i >> 3, m = i & 7;
      float inv = powf(500000.f, -(float)m * 0.125f);
      float ang = (float)pos * inv;
      RT[i] = make_float2(cosf(ang), sinf(ang));
    }
  }
}

template <int NJ>
DI void gemm_mainloop(const u16* __restrict__ A, const u16* __restrict__ Bt, int row0, int col0, char* lds, f32x16 (&acc)[2][NJ]) {
  constexpr int STAGE = 32768 + NJ * 8192;
  int tid = threadIdx.x;
  asm volatile("" : "+v"(tid));
  const int lane = tid & 63, w = tid >> 6, wm = w >> 1, wn = w & 1;
  const int r = lane & 31, h = lane >> 5;
  const u16* pa = A + (size_t)(row0 + (tid >> 3)) * 1024 + (tid & 7) * 8;
  const u16* pb = Bt + (size_t)(col0 + (tid >> 3)) * 1024 + (tid & 7) * 8;
  const int wofs = (tid >> 3) * 128 + ((((tid & 7) ^ ((tid >> 4) & 7))) << 4);
  const int swr = (r >> 1) & 7;
#pragma unroll
  for (int i = 0; i < 2; ++i)
#pragma unroll
    for (int j = 0; j < NJ; ++j)
#pragma unroll
      for (int e = 0; e < 16; ++e) acc[i][j][e] = 0.f;
  uint4 ra[4], rb[NJ];
#define GM_ISSUE(KB)                                                                          \
  { _Pragma("unroll") for (int it = 0; it < 4; ++it) gld16(ra[it], pa + (size_t)it * 65536 + (KB) * 64); \
    _Pragma("unroll") for (int it = 0; it < NJ; ++it) gld16(rb[it], pb + (size_t)it * 65536 + (KB) * 64); }
#define GM_PARK(ST)                                                                           \
  { char* bw_ = lds + (ST) * STAGE;                                                           \
    _Pragma("unroll") for (int it = 0; it < 4; ++it) *(uint4*)(bw_ + it * 8192 + wofs) = ra[it]; \
    _Pragma("unroll") for (int it = 0; it < NJ; ++it) *(uint4*)(bw_ + 32768 + it * 8192 + wofs) = rb[it]; }
  GM_ISSUE(0)
  WAIT_VM(0);
  GM_PARK(0)
  __syncthreads();
#pragma unroll 1
  for (int kt = 0; kt < 16; ++kt) {
    if (kt + 1 < 16) GM_ISSUE(kt + 1)
    __builtin_amdgcn_sched_barrier(0);
    const char* ba = lds + (kt & 1) * STAGE;
    const char* bb = ba + 32768;
    bf16x8 hf[2][2], wf[NJ];
    {
      const int co = ((h ^ swr) << 4);
#pragma unroll
      for (int i = 0; i < 2; ++i) hf[0][i] = *(const bf16x8*)(ba + (wm * 64 + i * 32 + r) * 128 + co);
#pragma unroll
      for (int j = 0; j < NJ; ++j) wf[j] = *(const bf16x8*)(bb + (wn * 32 * NJ + j * 32 + r) * 128 + co);
    }
#pragma unroll
    for (int s = 0; s < 4; ++s) {
      const int co = (((2 * (s + 1) + h) ^ swr) << 4);
      if (s < 3) {
#pragma unroll
        for (int i = 0; i < 2; ++i) hf[(s + 1) & 1][i] = *(const bf16x8*)(ba + (wm * 64 + i * 32 + r) * 128 + co);
      }
#pragma unroll
      for (int j = 0; j < NJ; ++j) {
        acc[0][j] = MFMA(hf[s & 1][0], wf[j], acc[0][j]);
        acc[1][j] = MFMA(hf[s & 1][1], wf[j], acc[1][j]);
        if (s < 3) wf[j] = *(const bf16x8*)(bb + (wn * 32 * NJ + j * 32 + r) * 128 + co);
      }
      __builtin_amdgcn_sched_barrier(0);
    }
    if (kt + 1 < 16) {
      WAIT_VM(0);
      GM_PARK((kt + 1) & 1)
    }
    __syncthreads();
  }
#undef GM_ISSUE
#undef GM_PARK
}

DI float silu(float x) { return x * __builtin_amdgcn_rcpf(1.f + __expf(-x)); }

DI float dpp_x1(float v) { return __int_as_float(__builtin_amdgcn_update_dpp(0, __float_as_int(v), 0xB1, 0xF, 0xF, true)); }
DI float dpp_x8(float v) { return __int_as_float(__builtin_amdgcn_update_dpp(0, __float_as_int(v), 0x128, 0xF, 0xF, true)); }
DI void store_bf16_tile(const f32x16& a, u16* base  , size_t ld, int h, int odd) {
#pragma unroll
  for (int g = 0; g < 4; ++g)
#pragma unroll
    for (int e = 0; e < 4; e += 2) {
      const float v0 = a[4 * g + e], v1 = a[4 * g + e + 1];
      const float n0 = dpp_x1(v0), n1 = dpp_x1(v1);
      const u32 o = odd ? pk2(n1, v1) : pk2(v0, n0);
      *(u32*)(base + (size_t)(8 * g + 4 * h + e + odd) * ld) = o;
      if (e == 2) __builtin_amdgcn_sched_barrier(0);
    }
}
template <int NJ, int sec>
DI void p1_tile(const Params& p, char* lds, int tm, int col0) {
  constexpr int WN = 32 * NJ;
  const u16* HN = (const u16*)(p.ws + WS_HN);
  const u16* WT = (const u16*)(p.ws + WS_WINT);
  const float2* RT = (const float2*)(p.ws + WS_ROPE);
  const int fbase = col0 & 511;
  const bool sample = (tm == 64);
  f32x16 acc[2][NJ];
  gemm_mainloop<NJ>(HN, WT, tm * 256, col0, lds, acc);
  int tid = threadIdx.x;
  asm volatile("" : "+v"(tid));
  const int lane = tid & 63, w = tid >> 6, wm = w >> 1, wn = w & 1;
  const int r = lane & 31, h = lane >> 5, odd = r & 1;
  const int tb = tm * 256 + wm * 64;
  const int fb = fbase + wn * WN;
  if (sec == 2 || sec == 6) {
#pragma unroll
    for (int i = 0; i < 2; ++i) {
      float* dbase = nullptr;
      {
        const int t0 = tb + i * 32;
        if (!sample) {
          const int b = t0 >> 13, s0 = t0 & 8191;
          if (sec == 6) dbase = p.out + O_BVP + (size_t)t0 * 512;
          else if (s0 >= 7680) dbase = p.out + O_AVP + ((size_t)(b * 512 + s0 - 7680)) * 512;
        } else {
          const int ts = t0 - NTOKP, b = ts >> 5;
          if (sec == 6) dbase = p.out + O_BVS + (size_t)ts * 512;
          else dbase = p.out + O_AVS + ((size_t)(b * 512 + 480)) * 512;
        }
      }
#pragma unroll
      for (int j = 0; j < NJ; ++j) {
        unsigned lo = (wn * WN + j * 32 + r) * 528 + (wm * 64 + i * 32 + 4 * h) * 2;
        asm volatile("" : "+v"(lo));
#pragma unroll
        for (int g = 0; g < 4; ++g) {
          const float v0 = acc[i][j][4 * g], v1 = acc[i][j][4 * g + 1], v2 = acc[i][j][4 * g + 2], v3 = acc[i][j][4 * g + 3];
          uint2 o; o.x = pk2(v0, v1); o.y = pk2(v2, v3);
          *(uint2*)(lds + lo + g * 16) = o;
          if (dbase) {
            unsigned off = (8 * g + 4 * h) * 512 + fb + j * 32 + r;
            asm volatile("" : "+v"(off));
            dbase[off] = v0; dbase[off + 512] = v1; dbase[off + 1024] = v2; dbase[off + 1536] = v3;
          }
          __builtin_amdgcn_sched_barrier(0);
        }
      }
    }
    __syncthreads();
    {
      u16* VT; size_t ldv;
      if (sec == 2) { VT = (u16*)(p.ws + (sample ? WS_VATS : WS_VAT)); ldv = sample ? 544 : 8192; }
      else { VT = (u16*)(p.ws + (sample ? WS_VBTS : WS_VBT)); ldv = sample ? 1056 : 8192; }
      const int sofs = sample ? (sec == 2 ? 512 : 1024) : 0;
#pragma unroll
      for (int it = 0; it < 4 * NJ; ++it) {
        const int id = it * 512 + tid, row = id >> 5, c = id & 31;
        const uint4 v = *(const uint4*)(lds + row * 528 + c * 16);
        const int fs = fbase + row;
        if (!sample) {
          const int t0 = tm * 256 + c * 8, b = t0 >> 13, s = t0 & 8191;
          *(uint4*)(VT + ((size_t)(b * 512 + fs)) * ldv + s) = v;
        } else {
          const int b = c >> 2, tt = (c & 3) * 8;
          *(uint4*)(VT + ((size_t)(b * 512 + fs)) * ldv + sofs + tt) = v;
        }
        if ((it & 3) == 3) __builtin_amdgcn_sched_barrier(0);
      }
    }
    __syncthreads();
  } else {
    if (sec == 4 || sec == 5) {
      const float sgn = (r & 8) ? 1.f : -1.f;
      const int pos0 = sample ? (1024 + 4 * h) : ((tb & 8191) + 4 * h);
      const float2* rt = RT + pos0 * 8 + (r & 7);
#pragma unroll
      for (int i = 0; i < 2; ++i)
#pragma unroll
        for (int g = 0; g < 4; ++g) {
          const int po = (sample ? 0 : i * 32) + 8 * g;
          float2 cs[4];
#pragma unroll
          for (int e = 0; e < 4; ++e) cs[e] = rt[(po + e) * 8];
          __builtin_amdgcn_sched_barrier(0);
#pragma unroll
          for (int j = 0; j < NJ; j += 2)
#pragma unroll
            for (int e = 0; e < 4; ++e) {
              const float x = acc[i][j][4 * g + e];
              const float xp = dpp_x8(x);
              if (r < 16) acc[i][j][4 * g + e] = x * cs[e].x + sgn * xp * cs[e].y;
            }
          __builtin_amdgcn_sched_barrier(0);
        }
    }
    if (sec == 3 || sec == 7) {
#pragma unroll
      for (int i = 0; i < 2; ++i)
#pragma unroll
        for (int j = 0; j < NJ; ++j)
#pragma unroll
          for (int e = 0; e < 16; ++e) acc[i][j][e] = silu(acc[i][j][e]);
    }
    u16* dst; size_t trow0;
    if (sec == 0) { dst = (u16*)(p.ws + WS_QA); trow0 = tb; }
    else if (sec == 3) { dst = (u16*)(p.ws + WS_GA); trow0 = tb; }
    else if (sec == 4) { dst = (u16*)(p.ws + WS_QB); trow0 = tb; }
    else if (sec == 7) { dst = (u16*)(p.ws + WS_GB); trow0 = tb; }
    else if (sec == 1) {
      if (!sample) { dst = (u16*)(p.ws + WS_KA); trow0 = tb; }
      else { dst = (u16*)(p.ws + WS_KAS); trow0 = (size_t)(wm * 2) * 544 + 512; }
    } else {
      if (!sample) { dst = (u16*)(p.ws + WS_KB); trow0 = tb; }
      else { dst = (u16*)(p.ws + WS_KBS); trow0 = (size_t)(wm * 2) * 1056 + 1024; }
    }
    const size_t istep = sample ? (sec == 1 ? 544 : (sec == 5 ? 1056 : 32)) : 32;
#pragma unroll
    for (int i = 0; i < 2; ++i)
#pragma unroll
      for (int j = 0; j < NJ; ++j)
        store_bf16_tile(acc[i][j], dst + (trow0 + i * istep) * 512 + fb + j * 32 + (r & ~1), 512, h, odd);
    if (sec == 1 || sec == 5) {
#pragma unroll
      for (int i = 0; i < 2; ++i) {
        float* d = nullptr;
        const int t0 = tb + i * 32;
        if (!sample) {
          const int b = t0 >> 13, s = t0 & 8191;
          if (sec == 5) d = p.out + O_BKP + (size_t)t0 * 512;
          else if (s >= 7680) d = p.out + O_AKP + ((size_t)(b * 512 + s - 7680)) * 512;
        } else {
          const int ts = t0 - NTOKP, b = ts >> 5;
          if (sec == 5) d = p.out + O_BKS + (size_t)ts * 512;
          else d = p.out + O_AKS + ((size_t)(b * 512 + 480)) * 512;
        }
        if (d) {
#pragma unroll
          for (int j = 0; j < NJ; ++j)
#pragma unroll
            for (int e = 0; e < 16; ++e) {
              d[(size_t)(8 * (e >> 2) + 4 * h + (e & 3)) * 512 + fb + j * 32 + r] = acc[i][j][e];
              if ((e & 3) == 3) __builtin_amdgcn_sched_barrier(0);
            }
        }
      }
    }
  }
}
template <int NJ>
DI void p1_dispatch(const Params& p, char* lds, int tm, int col0) {
  switch (col0 >> 9) {
    case 0: p1_tile<NJ, 0>(p, lds, tm, col0); break;
    case 1: p1_tile<NJ, 1>(p, lds, tm, col0); break;
    case 2: p1_tile<NJ, 2>(p, lds, tm, col0); break;
    case 3: p1_tile<NJ, 3>(p, lds, tm, col0); break;
    case 4: p1_tile<NJ, 4>(p, lds, tm, col0); break;
    case 5: p1_tile<NJ, 5>(p, lds, tm, col0); break;
    case 6: p1_tile<NJ, 6>(p, lds, tm, col0); break;
    default: p1_tile<NJ, 7>(p, lds, tm, col0); break;
  }
}
DI void phase1(const Params& p, char* lds) {
  for (int tile = blockIdx.x; tile < 1024; tile += gridDim.x) p1_dispatch<4>(p, lds, tile >> 4, (tile & 15) * 256);
  for (int tile = blockIdx.x; tile < 32; tile += gridDim.x) p1_dispatch<2>(p, lds, 64, tile * 128);
}

constexpr float SM_C = 0.125f * 1.4426950408889634f;
template <int NQT, int DVT, bool BIAS>
DI void attn_wave(const u16* __restrict__ Q, int ldq, const u16* __restrict__ K, int ldk,
                  const u16* __restrict__ Vt, int ldv, int nkt, const float* bias_l2, int rel0,
                  f32x16 (&O)[NQT][DVT], float (&Mx)[NQT], float (&L)[NQT]) {
  const int lane = threadIdx.x & 63, r = lane & 31, h = lane >> 5;
  bf16x8 qf[NQT][4];
#pragma unroll
  for (int u = 0; u < NQT; ++u)
#pragma unroll
    for (int s = 0; s < 4; ++s) qf[u][s] = *(const bf16x8*)(Q + (size_t)(32 * u + r) * ldq + 16 * s + 8 * h);
#pragma unroll
  for (int u = 0; u < NQT; ++u) {
    Mx[u] = -INFINITY; L[u] = 0.f;
#pragma unroll
    for (int dt = 0; dt < DVT; ++dt)
#pragma unroll
      for (int e = 0; e < 16; ++e) O[u][dt][e] = 0.f;
  }
  const u16* kp = K + (size_t)rho(r) * ldk + 8 * h;
  const u16* vp = Vt + (size_t)r * ldv + 8 * h;
  bf16x8 kf[4];
#pragma unroll
  for (int s = 0; s < 4; ++s) kf[s] = *(const bf16x8*)(kp + 16 * s);
  for (int kt = 0; kt < nkt; ++kt) {
    bf16x8 vf[DVT][2];
#pragma unroll
    for (int dt = 0; dt < DVT; ++dt)
#pragma unroll
      for (int s2 = 0; s2 < 2; ++s2) vf[dt][s2] = *(const bf16x8*)(vp + (size_t)(32 * dt) * ldv + 32 * kt + 16 * s2);
    bf16x8 kn[4];
    {
      const int ktn = (kt + 1 < nkt) ? kt + 1 : kt;
#pragma unroll
      for (int s = 0; s < 4; ++s) kn[s] = *(const bf16x8*)(kp + (size_t)(32 * ktn) * ldk + 16 * s);
    }
    bf16x8 pf[NQT][2];
#pragma unroll
    for (int u = 0; u < NQT; ++u) {
      f32x16 S;
#pragma unroll
      for (int e = 0; e < 16; ++e) S[e] = 0.f;
#pragma unroll
      for (int s = 0; s < 4; ++s) S = MFMA(kf[s], qf[u][s], S);
      float t[16];
      if (BIAS) {
        const int relb = rel0 + 32 * u + r - 32 * kt - 8 * h;
        if (rel0 - 32 * kt - 31 >= 128) {
          const float bv = bias_l2[256];
#pragma unroll
          for (int e = 0; e < 16; ++e) t[e] = S[e] * SM_C + bv;
        } else {
#pragma unroll
          for (int e = 0; e < 16; ++e) {
            int rel = relb - ((e & 7) + 16 * (e >> 3));
            rel = rel < -128 ? -128 : (rel > 128 ? 128 : rel);
            t[e] = S[e] * SM_C + bias_l2[rel + 128];
          }
        }
      } else {
#pragma unroll
        for (int e = 0; e < 16; ++e) t[e] = S[e] * SM_C;
      }
      float mx = t[0];
#pragma unroll
      for (int e = 1; e < 16; ++e) mx = fmaxf(mx, t[e]);
      mx = fmaxf(mx, __shfl_xor(mx, 32));
      if (__any(mx > Mx[u] + 8.f)) {
        const float mn = fmaxf(Mx[u], mx);
        const float al = __builtin_amdgcn_exp2f(Mx[u] - mn);
        Mx[u] = mn; L[u] *= al;
#pragma unroll
        for (int dt = 0; dt < DVT; ++dt)
#pragma unroll
          for (int e = 0; e < 16; ++e) O[u][dt][e] *= al;
      }
      float ps = 0.f;
#pragma unroll
      for (int e = 0; e < 16; ++e) { t[e] = __builtin_amdgcn_exp2f(t[e] - Mx[u]); ps += t[e]; }
      L[u] += ps;
#pragma unroll
      for (int s2 = 0; s2 < 2; ++s2) {
        uint4 pk;
        pk.x = pk2(t[8 * s2], t[8 * s2 + 1]); pk.y = pk2(t[8 * s2 + 2], t[8 * s2 + 3]);
        pk.z = pk2(t[8 * s2 + 4], t[8 * s2 + 5]); pk.w = pk2(t[8 * s2 + 6], t[8 * s2 + 7]);
        pf[u][s2] = __builtin_bit_cast(bf16x8, pk);
      }
    }
#pragma unroll
    for (int u = 0; u < NQT; ++u)
#pragma unroll
      for (int dt = 0; dt < DVT; ++dt)
#pragma unroll
        for (int s2 = 0; s2 < 2; ++s2) O[u][dt] = MFMA(vf[dt][s2], pf[u][s2], O[u][dt]);
#pragma unroll
    for (int s = 0; s < 4; ++s) kf[s] = kn[s];
  }
#pragma unroll
  for (int u = 0; u < NQT; ++u) L[u] += __shfl_xor(L[u], 32);
}

template <int NQT>
DI void attnA_item(const Params& p, const u16* Q, const u16* K, const u16* Vt, int ldv, int nkt, int rel0,
                   const float* bias_l2, int tok0, int head) {
  f32x16 O[NQT][2]; float Mx[NQT], L[NQT];
  attn_wave<NQT, 2, true>(Q, 512, K, 512, Vt, ldv, nkt, bias_l2, rel0, O, Mx, L);
  const int lane = threadIdx.x & 63, r = lane & 31, h = lane >> 5;
  const u16* GA = (const u16*)(p.ws + WS_GA);
  u16* OB = (u16*)(p.ws + WS_HN);
#pragma unroll
  for (int u = 0; u < NQT; ++u) {
    const float inv = 1.f / L[u];
    const size_t tok = (size_t)(tok0 + 32 * u + r);
#pragma unroll
    for (int dt = 0; dt < 2; ++dt)
#pragma unroll
      for (int g = 0; g < 4; ++g) {
        const int dv = 32 * dt + 8 * g + 4 * h;
        const uint2 gg = *(const uint2*)(GA + tok * 512 + head * 64 + dv);
        uint2 o;
        o.x = pk2(O[u][dt][4 * g] * inv * bflo(gg.x), O[u][dt][4 * g + 1] * inv * bfhi(gg.x));
        o.y = pk2(O[u][dt][4 * g + 2] * inv * bflo(gg.y), O[u][dt][4 * g + 3] * inv * bfhi(gg.y));
        *(uint2*)(OB + tok * 1024 + head * 64 + dv) = o;
      }
  }
}

DI void attnB_epilogue(const Params& p, f32x16 (&O)[4], float Lsum, int tok0, int hb, float lam, float* xch) {
  const int lane = threadIdx.x & 63, r = lane & 31, h = lane >> 5, w = threadIdx.x >> 6, m = w >> 2, wsub = w & 3;
  const float inv = 1.f / Lsum;
  float* xw = xch + wsub * 4096 + lane;
  if (m == 1) {
    const float sc = inv * lam;
#pragma unroll
    for (int dt = 0; dt < 4; ++dt)
#pragma unroll
      for (int e = 0; e < 16; ++e) xw[(dt * 16 + e) * 64] = O[dt][e] * sc;
  }
  __syncthreads();
  if (m == 0) {
    float ss = 0.f;
#pragma unroll
    for (int dt = 0; dt < 4; ++dt)
#pragma unroll
      for (int e = 0; e < 16; ++e) { float o = O[dt][e] * inv - xw[(dt * 16 + e) * 64]; O[dt][e] = o; ss += o * o; }
    ss += __shfl_xor(ss, 32);
    const float rn = rsqrtf(ss * (1.f / 128.f) + 1e-6f) * 0.8f;
    const u16* GB = (const u16*)(p.ws + WS_GB);
    u16* OB = (u16*)(p.ws + WS_HN);
    const size_t tok = (size_t)(tok0 + r);
#pragma unroll
    for (int dt = 0; dt < 4; ++dt)
#pragma unroll
      for (int g = 0; g < 4; ++g) {
        const int dv = 32 * dt + 8 * g + 4 * h;
        const uint2 gg = *(const uint2*)(GB + tok * 512 + hb * 128 + dv);
        const float4 sg = *(const float4*)(p.subln + dv);
        uint2 o;
        o.x = pk2(O[dt][4 * g] * rn * sg.x * bflo(gg.x), O[dt][4 * g + 1] * rn * sg.y * bfhi(gg.x));
        o.y = pk2(O[dt][4 * g + 2] * rn * sg.z * bflo(gg.y), O[dt][4 * g + 3] * rn * sg.w * bfhi(gg.y));
        *(uint2*)(OB + tok * 1024 + 512 + hb * 128 + dv) = o;
      }
  }
  __syncthreads();
}

DI void attnB_item(const Params& p, const u16* Q, const u16* K, const u16* Vt, int ldv, int nkt, int tok0, int hb,
                   float lam, float* xch) {
  f32x16 O[1][4]; float Mx[1], L[1];
  attn_wave<1, 4, false>(Q, 512, K, 512, Vt, ldv, nkt, nullptr, 0, O, Mx, L);
  attnB_epilogue(p, O[0], L[0], tok0, hb, lam, xch);
}

typedef float f2 __attribute__((ext_vector_type(2)));
constexpr int BLK_V = 0, BLK_K = 49152, BLK_XCH = 81920, LDS_BIAS = 147456;
DI float half_max(float v) {
  auto rr = __builtin_amdgcn_permlane32_swap(__float_as_uint(v), __float_as_uint(v), false, false);
  return fmaxf(__uint_as_float(rr[0]), __uint_as_float(rr[1]));
}
DI void attnB_block(const Params& p, int b, int hb, int qt, float lam, char* lds) {
  const int tid = threadIdx.x, lane = tid & 63, r = lane & 31, h = lane >> 5, w = tid >> 6, m = w >> 2, wsub = w & 3;
  const bool late = (m == 1);
  const int q0 = qt * 128 + wsub * 32;
  const int nt = 2 * qt + 2;
  const int my_nt = (q0 >> 6) + 1;
  uint4 qraw[4];
  {
    const u16* Q = (const u16*)(p.ws + WS_QB) + (size_t)(b * SEQ + q0 + r) * 512 + hb * 128 + m * 64 + 8 * h;
#pragma unroll
    for (int s = 0; s < 4; ++s) gld16(qraw[s], Q + 16 * s);
  }
  f32x16 O[4];
#pragma unroll
  for (int dt = 0; dt < 4; ++dt)
#pragma unroll
    for (int e = 0; e < 16; ++e) O[dt][e] = 0.f;
  float Mx = -INFINITY;
  f2 L2 = {0.f, 0.f};
  const u16* gk = (const u16*)(p.ws + WS_KB) + (size_t)(b * SEQ + (tid >> 4)) * 512 + hb * 128 + (tid & 15) * 8;
  const u16* gv = (const u16*)(p.ws + WS_VBT) + (size_t)(b * 512 + hb * 128 + (tid >> 3)) * SEQ + (tid & 7) * 8;
  const int lk = BLK_K + ((tid >> 3) & 1) * 8192 + (tid >> 4) * 128 + ((((tid & 7) ^ ((tid >> 5) & 7))) << 4);
  const int lv = BLK_V + (tid >> 3) * 128 + ((((tid & 7) ^ ((tid >> 4) & 7))) << 4);
  const int rr = rho(r);
  const int swk = (rr >> 1) & 7, swv = (r >> 1) & 7;
  uint4 sk0, sk1, sv0, sv1;
  gld16(sk0, gk); gld16(sk1, gk + (size_t)32 * 512);
  gld16(sv0, gv); gld16(sv1, gv + (size_t)64 * SEQ);
  wait_vm0();
  *(uint4*)(lds + lk) = sk0; *(uint4*)(lds + lk + 4096) = sk1;
  *(uint4*)(lds + lv) = sv0; *(uint4*)(lds + lv + 8192) = sv1;
  bf16x8 qf[4];
#pragma unroll
  for (int s = 0; s < 4; ++s) qf[s] = __builtin_bit_cast(bf16x8, qraw[s]);
  bf16x8 pf[4];
#pragma unroll
  for (int s = 0; s < 4; ++s) pf[s] = qf[s];
  __syncthreads();
  int vs = 0;
  for (int t = 0; t <= nt; ++t) {
    if (t + 1 < nt) {
      gld16(sk0, gk + (size_t)(64 * (t + 1)) * 512);
      gld16(sk1, gk + (size_t)(64 * (t + 1) + 32) * 512);
      gld16(sv0, gv + 64 * (t + 1));
      gld16(sv1, gv + (size_t)64 * SEQ + 64 * (t + 1));
    }
    __builtin_amdgcn_sched_barrier(0);
    if (late && t >= 1 && t - 1 < my_nt) {
      const char* vb = lds + BLK_V + (vs == 0 ? 2 : vs - 1) * 16384;
#pragma unroll
      for (int ks = 0; ks < 4; ++ks) {
        const int co = (((2 * ks + h) ^ swv) << 4);
#pragma unroll
        for (int dt = 0; dt < 4; ++dt) {
          bf16x8 v = *(const bf16x8*)(vb + (32 * dt + r) * 128 + co);
          O[dt] = MFMA(v, pf[ks], O[dt]);
        }
      }
    }
    if (t < my_nt && t < nt) {
      const char* kb = lds + BLK_K + (t & 1) * 16384 + m * 8192;
      f32x16 S0, S1;
#pragma unroll
      for (int e = 0; e < 16; ++e) { S0[e] = 0.f; S1[e] = 0.f; }
      bf16x8 ka[4], kc[4];
#pragma unroll
      for (int s = 0; s < 4; ++s) {
        const int co = (((2 * s + h) ^ swk) << 4);
        ka[s] = *(const bf16x8*)(kb + rr * 128 + co);
        kc[s] = *(const bf16x8*)(kb + (32 + rr) * 128 + co);
      }
#pragma unroll
      for (int s = 0; s < 4; ++s) {
        S0 = MFMA(ka[s], qf[s], S0);
        S1 = MFMA(kc[s], qf[s], S1);
      }
      f2 tv[16];
      const f2 cc = {SM_C, SM_C};
#pragma unroll
      for (int e = 0; e < 8; ++e) {
        f2 a = {S0[2 * e], S0[2 * e + 1]}; tv[e] = a * cc;
        f2 c = {S1[2 * e], S1[2 * e + 1]}; tv[8 + e] = c * cc;
      }
      float mx = fmaxf(tv[0].x, tv[0].y);
#pragma unroll
      for (int e = 1; e < 16; ++e) mx = fmaxf(mx, fmaxf(tv[e].x, tv[e].y));
      mx = half_max(mx);
      if (__any(mx > Mx + 8.f)) {
        const float mn = fmaxf(Mx, mx);
        const float al = __builtin_amdgcn_exp2f(Mx - mn);
        Mx = mn; L2 *= al;
#pragma unroll
        for (int dt = 0; dt < 4; ++dt)
#pragma unroll
          for (int e = 0; e < 16; ++e) O[dt][e] *= al;
      }
      const f2 nm = {-Mx, -Mx};
#pragma unroll
      for (int e = 0; e < 16; ++e) {
        f2 d = tv[e] + nm;
        d.x = __builtin_amdgcn_exp2f(d.x); d.y = __builtin_amdgcn_exp2f(d.y);
        L2 += d;
        tv[e] = d;
      }
#pragma unroll
      for (int s2 = 0; s2 < 4; ++s2) {
        uint4 pa;
        pa.x = pk2(tv[4 * s2].x, tv[4 * s2].y); pa.y = pk2(tv[4 * s2 + 1].x, tv[4 * s2 + 1].y);
        pa.z = pk2(tv[4 * s2 + 2].x, tv[4 * s2 + 2].y); pa.w = pk2(tv[4 * s2 + 3].x, tv[4 * s2 + 3].y);
        pf[s2] = __builtin_bit_cast(bf16x8, pa);
      }
      if (!late) {
        const char* vb = lds + BLK_V + vs * 16384;
#pragma unroll
        for (int ks = 0; ks < 4; ++ks) {
          const int co = (((2 * ks + h) ^ swv) << 4);
#pragma unroll
          for (int dt = 0; dt < 4; ++dt) {
            bf16x8 v = *(const bf16x8*)(vb + (32 * dt + r) * 128 + co);
            O[dt] = MFMA(v, pf[ks], O[dt]);
          }
        }
      }
    }
    if (t + 1 < nt) {
      const int vn = (vs == 2 ? 0 : vs + 1);
      wait_vm0();
      *(uint4*)(lds + lk + ((t + 1) & 1) * 16384) = sk0; *(uint4*)(lds + lk + ((t + 1) & 1) * 16384 + 4096) = sk1;
      *(uint4*)(lds + lv + vn * 16384) = sv0; *(uint4*)(lds + lv + vn * 16384 + 8192) = sv1;
    }
    vs = (vs == 2 ? 0 : vs + 1);
    __syncthreads();
  }
  float L = L2.x + L2.y;
  L += __shfl_xor(L, 32);
  attnB_epilogue(p, O, L, b * SEQ + q0, hb, lam, (float*)(lds + BLK_XCH));
}

DI float phase2_setup(const Params& p, char* lds) {
  const int tid = threadIdx.x, lane = tid & 63;
  float* bias = (float*)(lds + LDS_BIAS);
  for (int i = tid; i < 8 * 257; i += 512) { int hh = i / 257, k = i - hh * 257; bias[hh * 260 + k] = p.rel_bias[i] * 1.4426950408889634f; }
  float a = p.lq1[lane] * p.lk1[lane], b = p.lq2[lane] * p.lk2[lane];
  a = wave_sum(a); b = wave_sum(b);
  __syncthreads();
  return expf(a) - expf(b) + 0.2f;
}
DI void p3_tile(const Params& p, char* lds, int tok0) {
  int tid = threadIdx.x;
  asm volatile("" : "+v"(tid));
  const int lane = tid & 63, w = tid >> 6, r = lane & 31, h = lane >> 5;
  const u16* OB = (const u16*)(p.ws + WS_HN);
  float* red = (float*)(lds + 131072);
  __syncthreads();
#pragma unroll
  for (int half = 0; half < 2; ++half) {
    uint4 a[8];
#pragma unroll
    for (int it = 0; it < 8; ++it) a[it] = *(const uint4*)(OB + (size_t)(tok0 + half * 32 + it * 4 + (tid >> 7)) * 1024 + (tid & 127) * 8);
#pragma unroll
    for (int it = 0; it < 8; ++it) {
      const int row = half * 32 + it * 4 + (tid >> 7);
      *(uint4*)(lds + row * 2048 + ((((tid & 127) ^ (row & 15))) << 4)) = a[it];
    }
  }
  f32x16 acc[2][4];
#pragma unroll
  for (int i = 0; i < 2; ++i)
#pragma unroll
    for (int j = 0; j < 4; ++j)
#pragma unroll
      for (int e = 0; e < 16; ++e) acc[i][j][e] = 0.f;
  const char* wp = p.ws + WS_WOUTT + ((size_t)(w * 4) * 4096 + lane) * 16;
  const char* ap = lds + r * 2048;
  const int akey = r & 15;
  uint4 bq[3][4];
#pragma unroll
  for (int s = 0; s < 3; ++s)
#pragma unroll
    for (int j = 0; j < 4; ++j) gld16(bq[s][j], wp + (size_t)(j * 4096 + s * 64) * 16);
  __syncthreads();
#define P3_KSTEP(KS, SLOT, WAITN, REFILL)                                                        \
  {                                                                                              \
    const int co_ = ((((2 * (KS) + h) ^ akey)) << 4);                                            \
    const bf16x8 a0_ = *(const bf16x8*)(ap + co_);                                               \
    const bf16x8 a1_ = *(const bf16x8*)(ap + 65536 + co_);                                       \
    WAIT_VM(WAITN);                                                                              \
    __builtin_amdgcn_sched_barrier(0);                                                           \
    _Pragma("unroll") for (int j = 0; j < 4; ++j) {                                              \
      const bf16x8 bf_ = __builtin_bit_cast(bf16x8, bq[SLOT][j]);                                \
      acc[0][j] = MFMA(a0_, bf_, acc[0][j]);                                                     \
      acc[1][j] = MFMA(a1_, bf_, acc[1][j]);                                                     \
    }                                                                                            \
    __builtin_amdgcn_sched_barrier(0);                                                           \
    if (REFILL) {                                                                                \
      _Pragma("unroll") for (int j = 0; j < 4; ++j) gld16(bq[SLOT][j], wp + (size_t)(j * 4096 + ((KS) + 3) * 64) * 16); \
    }                                                                                            \
    __builtin_amdgcn_sched_barrier(0);                                                           \
  }
#pragma unroll 1
  for (int g = 0; g < 20; ++g) {
    P3_KSTEP(3 * g, 0, 8, true)
    P3_KSTEP(3 * g + 1, 1, 8, true)
    P3_KSTEP(3 * g + 2, 2, 8, true)
  }
  P3_KSTEP(60, 0, 8, true)
  P3_KSTEP(61, 1, 8, false)
  P3_KSTEP(62, 2, 4, false)
  P3_KSTEP(63, 0, 0, false)
  const float* xr = tok0 < NTOKP ? p.x_prompt + (size_t)tok0 * 1024 : p.x_sample + (size_t)(tok0 - NTOKP) * 1024;
  const unsigned cb = w * 128 + r;
#pragma unroll
  for (int i = 0; i < 2; ++i) {
#pragma unroll
    for (int e = 0; e < 16; ++e) {
      const int row = 32 * i + 8 * (e >> 2) + 4 * h + (e & 3);
      unsigned off = row * 1024 + cb;
      asm volatile("" : "+v"(off));
      float ssv = 0.f;
#pragma unroll
      for (int j = 0; j < 4; ++j) {
        const float y = acc[i][j][e] + xr[off + j * 32];
        acc[i][j][e] = y; ssv += y * y;
      }
      ssv += __shfl_xor(ssv, 1); ssv += __shfl_xor(ssv, 2); ssv += __shfl_xor(ssv, 4); ssv += __shfl_xor(ssv, 8); ssv += __shfl_xor(ssv, 16);
      if (r == 0) red[w * 64 + row] = ssv;
      if ((e & 3) == 3) __builtin_amdgcn_sched_barrier(0);
    }
  }
  __syncthreads();
  if (tid < 64) {
    float t = 0.f;
#pragma unroll
    for (int k = 0; k < 8; ++k) t += red[k * 64 + tid];
    red[512 + tid] = rsqrtf(t * (1.f / 1024.f) + 1e-6f);
  }
  __syncthreads();
  float* yr = p.out + O_YP + (size_t)tok0 * 1024;
  float gj[4];
#pragma unroll
  for (int j = 0; j < 4; ++j) gj[j] = p.final_gain[cb + j * 32];
#pragma unroll
  for (int i = 0; i < 2; ++i) {
#pragma unroll
    for (int e = 0; e < 16; ++e) {
      const int row = 32 * i + 8 * (e >> 2) + 4 * h + (e & 3);
      unsigned off = row * 1024 + cb;
      asm volatile("" : "+v"(off));
      const float ri = red[512 + row];
#pragma unroll
      for (int j = 0; j < 4; ++j) yr[off + j * 32] = acc[i][j][e] * ri * gj[j];
      if ((e & 3) == 3) __builtin_amdgcn_sched_barrier(0);
    }
  }
}

constexpr int NQUEUE = 12;
DI int q_pop(unsigned* ctr, int* slot) {
  __syncthreads();
  if (threadIdx.x == 0) *slot = (int)__hip_atomic_fetch_add(ctr, 1u, __ATOMIC_RELAXED, __HIP_MEMORY_SCOPE_AGENT);
  __syncthreads();
  return *slot;
}
DI void p2_all(const Params& p, char* lds, float lam) {
  const int w = threadIdx.x >> 6;
  unsigned* Q = (unsigned*)(p.ws + WS_QUEUE);
  int* slot = (int*)(lds + LDS_BIAS + 8320);
  float* xch = (float*)(lds + 65536);
  const float* bias = (const float*)(lds + LDS_BIAS);
  const u16* QA = (const u16*)(p.ws + WS_QA);
  const u16* QB = (const u16*)(p.ws + WS_QB);
  {
    const int it = q_pop(Q, slot);
    if (it < 8) {
      const int m = w >> 2, wsub = w & 3, id = it * 4 + wsub, b = id >> 2, hb = id & 3;
      attnB_item(p, QB + (size_t)(NTOKP + b * 32) * 512 + hb * 128 + m * 64,
                 (const u16*)(p.ws + WS_KBS) + (size_t)(b * 1056) * 512 + hb * 128 + m * 64,
                 (const u16*)(p.ws + WS_VBTS) + (size_t)(b * 512 + hb * 128) * 1056, 1056, 33, NTOKP + b * 32, hb, lam, xch);
    } else if (it < 16) {
      const int b = it - 8;
      attnA_item<1>(p, QA + (size_t)(NTOKP + b * 32) * 512 + w * 64,
                    (const u16*)(p.ws + WS_KAS) + (size_t)(b * 544) * 512 + w * 64,
                    (const u16*)(p.ws + WS_VATS) + (size_t)(b * 512 + w * 64) * 544, 544, 17, 512, bias + w * 260,
                    NTOKP + b * 32, w);
    }
    if (it < 16) {
      asm volatile("s_waitcnt vmcnt(0)" ::: "memory");
      __syncthreads();
      if (threadIdx.x == 0) {
        __builtin_amdgcn_fence(__ATOMIC_RELEASE, "agent");
        __hip_atomic_fetch_add(Q + 64 * 11, 1u, __ATOMIC_RELAXED, __HIP_MEMORY_SCOPE_AGENT);
      }
    }
  }
#pragma unroll 1
  for (int k = 0; k < 8; ++k) {
    const int x = (blockIdx.x + k) & 7;
#pragma unroll 1
    for (;;) {
      const int i = q_pop(Q + 64 * (1 + x), slot);
      if (i >= 64) break;
      attnB_block(p, x >> 2, x & 3, 63 - i, lam, lds);
    }
  }
#pragma unroll 1
  for (;;) {
    const int it = q_pop(Q + 64 * 9, slot);
    if (it >= 256) break;
    const int b = it >> 7, c = it & 127, cs = c > 8 ? c - 8 : 0;
    attnA_item<2>(p, QA + (size_t)(b * SEQ + c * 64) * 512 + w * 64,
                  (const u16*)(p.ws + WS_KA) + (size_t)(b * SEQ + cs * 64) * 512 + w * 64,
                  (const u16*)(p.ws + WS_VAT) + (size_t)(b * 512 + w * 64) * SEQ + cs * 64, SEQ,
                  (c + 1 - cs) * 2, 64 * (c - cs), bias + w * 260, b * SEQ + c * 64, w);
  }
#pragma unroll 1
  for (;;) {
    const int it = q_pop(Q + 64 * 10, slot);
    if (it >= 4) break;
    if (threadIdx.x == 0) {
      while (__hip_atomic_load(Q + 64 * 11, __ATOMIC_RELAXED, __HIP_MEMORY_SCOPE_AGENT) < 16u) __builtin_amdgcn_s_sleep(2);
      __builtin_amdgcn_fence(__ATOMIC_ACQUIRE, "agent");
    }
    __syncthreads();
    p3_tile(p, lds, NTOKP + it * 64);
  }
}

DI void phase4(const Params& p) {
  const int lane = threadIdx.x & 63, w = threadIdx.x >> 6;
  for (int row = blockIdx.x * 8 + w; row < NTOK; row += gridDim.x * 8) {
    float* y = p.out + O_YP + (size_t)row * 1024;
    float4 v[4]; float ss = 0.f;
#pragma unroll
    for (int it = 0; it < 4; ++it) { v[it] = *(const float4*)(y + it * 256 + lane * 4); ss += v[it].x * v[it].x + v[it].y * v[it].y + v[it].z * v[it].z + v[it].w * v[it].w; }
    ss = wave_sum(ss);
    const float inv = rsqrtf(ss * (1.f / 1024.f) + 1e-6f);
#pragma unroll
    for (int it = 0; it < 4; ++it) {
      float4 g = *(const float4*)(p.final_gain + it * 256 + lane * 4);
      *(float4*)(y + it * 256 + lane * 4) = make_float4(v[it].x * inv * g.x, v[it].y * inv * g.y, v[it].z * inv * g.z, v[it].w * inv * g.w);
    }
  }
}

__global__ void __launch_bounds__(512) fwd_megakernel(Params p) {
  __shared__ __attribute__((aligned(16))) char lds[155904];
  cg::grid_group grid = cg::this_grid();
  unsigned* ctr = (unsigned*)(p.ws + WS_BAR);
  const unsigned G = gridDim.x;
  if (blockIdx.x == 0 && threadIdx.x == 0) *ctr = 0u;
  if (blockIdx.x == 0 && threadIdx.x < NQUEUE) ((unsigned*)(p.ws + WS_QUEUE))[64 * threadIdx.x] = 0u;
  phase0(p, lds);
  grid.sync();
  phase1(p, lds);
  ctr_barrier(ctr, G);
  {
    const float lam = phase2_setup(p, lds);
    p2_all(p, lds, lam);
  }
  ctr_barrier(ctr, 2 * G);
  for (int t = blockIdx.x; t < 256; t += gridDim.x) p3_tile(p, lds, t * 64);
}

extern "C" void kernel_launch(void* const* d_in, const int* in_sizes, int n_in, void* d_out, int out_size, void* d_ws,
                              size_t ws_size, hipStream_t stream) {
  static int grid_blocks = 0;
  if (!grid_blocks) {
    int dev = 0, cus = 0, per_cu = 0;
    hipGetDevice(&dev);
    hipDeviceGetAttribute(&cus, hipDeviceAttributeMultiprocessorCount, dev);
    hipOccupancyMaxActiveBlocksPerMultiprocessor(&per_cu, fwd_megakernel, 512, 0);
    if (per_cu < 1) per_cu = 1;
    grid_blocks = cus;
  }
  Params p{};
  p.x_prompt = (const float*)d_in[0]; p.x_sample = (const float*)d_in[1];
  p.cache_a_k = (const float*)d_in[2]; p.cache_a_v = (const float*)d_in[3];
  p.cache_b_k = (const float*)d_in[4]; p.cache_b_v = (const float*)d_in[5];
  p.norm_gain = (const float*)d_in[6]; p.w_in = (const float*)d_in[7]; p.w_out = (const float*)d_in[8];
  p.rel_bias = (const float*)d_in[9];
  p.lq1 = (const float*)d_in[10]; p.lk1 = (const float*)d_in[11]; p.lq2 = (const float*)d_in[12]; p.lk2 = (const float*)d_in[13];
  p.subln = (const float*)d_in[14]; p.final_gain = (const float*)d_in[15];
  p.out = (float*)d_out; p.ws = (char*)d_ws;
  void* args[] = {&p};
  hipError_t e = hipLaunchCooperativeKernel((void*)fwd_megakernel, dim3(grid_blocks), dim3(512), args, 0, stream);
  if (e != hipSuccess) fprintf(stderr, "cooperative launch failed: %s (grid %d)\n", hipGetErrorString(e), grid_blocks);
}
```

```cpp
#include <hip/hip_runtime.h>
#include <hip/hip_cooperative_groups.h>
#include <cstdio>
namespace cg = cooperative_groups;

typedef short bf16x8 __attribute__((ext_vector_type(8)));
typedef float f32x16 __attribute__((ext_vector_type(16)));
typedef __bf16 bf2_t __attribute__((ext_vector_type(2)));
typedef float f2_t __attribute__((ext_vector_type(2)));
typedef unsigned u32;
typedef unsigned short u16;
#define DI __device__ __forceinline__
#define MFMA(a, b, c) __builtin_amdgcn_mfma_f32_32x32x16_bf16((a), (b), (c), 0, 0, 0)

constexpr int NTOKP = 16384;
constexpr int NTOK = 16640;
constexpr int SEQ = 8192;
constexpr size_t O_YP = 0;
constexpr size_t O_AKP = 17039360, O_AVP = 17563648, O_BKP = 18087936, O_BVP = 26476544;
constexpr size_t O_AKS = 34865152, O_AVS = 36962304, O_BKS = 39059456, O_BVS = 39190528;
constexpr size_t WS_WINT = 0;
constexpr size_t WS_WOUTT = WS_WINT + 8388608;
constexpr size_t WS_HN = WS_WOUTT + 2097152;
constexpr size_t WS_QA = WS_HN + 34078720;
constexpr size_t WS_KA = WS_QA + 17039360;
constexpr size_t WS_KAS = WS_KA + 16777216;
constexpr size_t WS_VAT = WS_KAS + 4456448;
constexpr size_t WS_VATS = WS_VAT + 16777216;
constexpr size_t WS_GA = WS_VATS + 4456448;
constexpr size_t WS_QB = WS_GA + 17039360;
constexpr size_t WS_KB = WS_QB + 17039360;
constexpr size_t WS_KBS = WS_KB + 16777216;
constexpr size_t WS_VBT = WS_KBS + 8650752;
constexpr size_t WS_VBTS = WS_VBT + 16777216;
constexpr size_t WS_GB = WS_VBTS + 8650752;
constexpr size_t WS_ROPE = WS_GB + 17039360;
constexpr size_t WS_BAR = WS_ROPE + 524288;
constexpr size_t WS_QUEUE = WS_BAR + 4096;
constexpr size_t WS_END = WS_QUEUE + 4096;

struct Params {
  const float* x_prompt; const float* x_sample;
  const float* cache_a_k; const float* cache_a_v; const float* cache_b_k; const float* cache_b_v;
  const float* norm_gain; const float* w_in; const float* w_out; const float* rel_bias;
  const float* lq1; const float* lk1; const float* lq2; const float* lk2;
  const float* subln; const float* final_gain;
  float* out; char* ws;
};

DI u32 pk2(float a, float b) { f2_t v = {a, b}; bf2_t r = __builtin_convertvector(v, bf2_t); return __builtin_bit_cast(u32, r); }
DI float bflo(u32 v) { return __uint_as_float(v << 16); }
DI float bfhi(u32 v) { return __uint_as_float(v & 0xffff0000u); }
DI int rho(int r) { return (r & ~12) | ((r & 4) << 1) | ((r & 8) >> 1); }
DI void gld16(uint4& dst, const void* p) { asm volatile("global_load_dwordx4 %0, %1, off" : "=v"(dst) : "v"(p) : "memory"); }
#define WAIT_VM(n) asm volatile("s_waitcnt vmcnt(" #n ")" ::: "memory")
DI void wait_vm0() { asm volatile("s_waitcnt vmcnt(0)" ::: "memory"); }
DI float wave_sum(float v) {
#pragma unroll
  for (int o = 32; o > 0; o >>= 1) v += __shfl_xor(v, o);
  return v;
}


DI void ctr_barrier(unsigned* ctr, unsigned target) {
  __syncthreads();
  if (threadIdx.x == 0) {
    __builtin_amdgcn_fence(__ATOMIC_RELEASE, "agent");
    __hip_atomic_fetch_add(ctr, 1u, __ATOMIC_RELAXED, __HIP_MEMORY_SCOPE_AGENT);
    while (__hip_atomic_load(ctr, __ATOMIC_RELAXED, __HIP_MEMORY_SCOPE_AGENT) < target) __builtin_amdgcn_s_sleep(1);
    __builtin_amdgcn_fence(__ATOMIC_ACQUIRE, "agent");
  }
  __syncthreads();
}

DI void phase0(const Params& p, char* lds) {
  const int tid = threadIdx.x, bid = blockIdx.x, nb = gridDim.x;
  const int lane = tid & 63, w = tid >> 6;
  float* tile = (float*)lds;
  for (int i = bid * 512 + tid; i < 131072; i += nb * 512) {
    const int ln = i & 63, s_ = (i >> 6) & 63, ct = i >> 12, r_ = ln & 31, h_ = ln >> 5;
    float v[8];
#pragma unroll
    for (int j = 0; j < 8; ++j) v[j] = p.w_out[(size_t)(16 * s_ + 8 * h_ + j) * 1024 + ct * 32 + r_];
    uint4 o; o.x = pk2(v[0], v[1]); o.y = pk2(v[2], v[3]); o.z = pk2(v[4], v[5]); o.w = pk2(v[6], v[7]);
    *(uint4*)(p.ws + WS_WOUTT + (size_t)i * 16) = o;
  }
  for (int t = bid; t < 1024; t += nb) {
    const float* W; u16* WT; int N, kt, nt;
    { W = p.w_in; WT = (u16*)(p.ws + WS_WINT); N = 4096; kt = t >> 6; nt = t & 63; }
#pragma unroll
    for (int it = 0; it < 8; ++it) {
      int idx = it * 512 + tid, kk = idx >> 6, nn = idx & 63;
      tile[kk * 65 + nn] = W[(size_t)(kt * 64 + kk) * N + nt * 64 + nn];
    }
    __syncthreads();
    {
      int n = tid >> 3, kg = tid & 7;
      float v[8];
#pragma unroll
      for (int j = 0; j < 8; ++j) v[j] = tile[(kg * 8 + j) * 65 + n];
      uint4 o; o.x = pk2(v[0], v[1]); o.y = pk2(v[2], v[3]); o.z = pk2(v[4], v[5]); o.w = pk2(v[6], v[7]);
      *(uint4*)(WT + (size_t)(nt * 64 + n) * 1024 + kt * 64 + kg * 8) = o;
    }
    __syncthreads();
  }
  {
    u16* HN = (u16*)(p.ws + WS_HN);
#pragma unroll 2
    for (int row = bid * 8 + w; row < NTOK; row += nb * 8) {
      const float* src = row < NTOKP ? p.x_prompt + (size_t)row * 1024 : p.x_sample + (size_t)(row - NTOKP) * 1024;
      float4 v[4]; float ss = 0.f;
#pragma unroll
      for (int it = 0; it < 4; ++it) { v[it] = *(const float4*)(src + it * 256 + lane * 4); ss += v[it].x * v[it].x + v[it].y * v[it].y + v[it].z * v[it].z + v[it].w * v[it].w; }
      ss = wave_sum(ss);
      float inv = rsqrtf(ss * (1.f / 1024.f) + 1e-6f);
#pragma unroll
      for (int it = 0; it < 4; ++it) {
        float4 g = *(const float4*)(p.norm_gain + it * 256 + lane * 4);
        uint2 o; o.x = pk2(v[it].x * inv * g.x, v[it].y * inv * g.y); o.y = pk2(v[it].z * inv * g.z, v[it].w * inv * g.w);
        *(uint2*)(HN + (size_t)row * 1024 + it * 256 + lane * 4) = o;
      }
    }
  }
  const int gt = bid * 512 + tid, gn = nb * 512;
  {
    u16* KAS = (u16*)(p.ws + WS_KAS);
#pragma unroll 4
    for (int i = gt; i < 524288; i += gn) {
      int e = i * 4, b = e >> 18, key = (e >> 9) & 511, f = e & 511;
      float4 v = *(const float4*)(p.cache_a_k + e);
      uint2 o; o.x = pk2(v.x, v.y); o.y = pk2(v.z, v.w);
      *(uint2*)(KAS + (size_t)(b * 544 + key) * 512 + f) = o;
      if (key >= 32) *(float4*)(p.out + O_AKS + (size_t)(b * 512 + key - 32) * 512 + f) = v;
    }
    u16* KBS = (u16*)(p.ws + WS_KBS);
#pragma unroll 4
    for (int i = gt; i < 1048576; i += gn) {
      int e = i * 4, b = e >> 19, key = (e >> 9) & 1023, f = e & 511;
      float4 v = *(const float4*)(p.cache_b_k + e);
      uint2 o; o.x = pk2(v.x, v.y); o.y = pk2(v.z, v.w);
      *(uint2*)(KBS + (size_t)(b * 1056 + key) * 512 + f) = o;
    }
    u16* VATS = (u16*)(p.ws + WS_VATS);
#pragma unroll 2
    for (int i = gt; i < 262144; i += gn) {
      int f = i & 511, kg = (i >> 9) & 63, b = i >> 15;
      float v[8];
#pragma unroll
      for (int j = 0; j < 8; ++j) v[j] = p.cache_a_v[(size_t)(b * 512 + kg * 8 + j) * 512 + f];
      uint4 o; o.x = pk2(v[0], v[1]); o.y = pk2(v[2], v[3]); o.z = pk2(v[4], v[5]); o.w = pk2(v[6], v[7]);
      *(uint4*)(VATS + (size_t)(b * 512 + f) * 544 + kg * 8) = o;
      if (kg >= 4) {
#pragma unroll
        for (int j = 0; j < 8; ++j) p.out[O_AVS + (size_t)(b * 512 + kg * 8 + j - 32) * 512 + f] = v[j];
      }
    }
    u16* VBTS = (u16*)(p.ws + WS_VBTS);
#pragma unroll 2
    for (int i = gt; i < 524288; i += gn) {
      int f = i & 511, kg = (i >> 9) & 127, b = i >> 16;
      float v[8];
#pragma unroll
      for (int j = 0; j < 8; ++j) v[j] = p.cache_b_v[(size_t)(b * 1024 + kg * 8 + j) * 512 + f];
      uint4 o; o.x = pk2(v[0], v[1]); o.y = pk2(v[2], v[3]); o.z = pk2(v[4], v[5]); o.w = pk2(v[6], v[7]);
      *(uint4*)(VBTS + (size_t)(b * 512 + f) * 1056 + kg * 8) = o;
    }
  }
  {
    float2* RT = (float2*)(p.ws + WS_ROPE);
    for (int i = gt; i < 65536; i += gn) {
      int pos = i >> 3, m = i & 7;
      float inv = powf(500000.f, -(float)m * 0.125f);
      float ang = (float)pos * inv;
      RT[i] = make_float2(cosf(ang), sinf(ang));
    }
  }
}

template <int NJ>
DI void gemm_mainloop(const u16* __restrict__ A, const u16* __restrict__ Bt, int row0, int col0, char* lds, f32x16 (&acc)[2][NJ]) {
  constexpr int STAGE = 32768 + NJ * 8192;
  int tid = threadIdx.x;
  asm volatile("" : "+v"(tid));
  const int lane = tid & 63, w = tid >> 6, wm = w >> 1, wn = w & 1;
  const int r = lane & 31, h = lane >> 5;
  const u16* pa = A + (size_t)(row0 + (tid >> 3)) * 1024 + (tid & 7) * 8;
  const u16* pb = Bt + (size_t)(col0 + (tid >> 3)) * 1024 + (tid & 7) * 8;
  const int wofs = (tid >> 3) * 128 + ((((tid & 7) ^ ((tid >> 4) & 7))) << 4);
  const int swr = (r >> 1) & 7;
#pragma unroll
  for (int i = 0; i < 2; ++i)
#pragma unroll
    for (int j = 0; j < NJ; ++j)
#pragma unroll
      for (int e = 0; e < 16; ++e) acc[i][j][e] = 0.f;
  uint4 ra[4], rb[NJ];
#define GM_ISSUE(KB)                                                                          \
  { _Pragma("unroll") for (int it = 0; it < 4; ++it) gld16(ra[it], pa + (size_t)it * 65536 + (KB) * 64); \
    _Pragma("unroll") for (int it = 0; it < NJ; ++it) gld16(rb[it], pb + (size_t)it * 65536 + (KB) * 64); }
#define GM_PARK(ST)                                                                           \
  { char* bw_ = lds + (ST) * STAGE;                                                           \
    _Pragma("unroll") for (int it = 0; it < 4; ++it) *(uint4*)(bw_ + it * 8192 + wofs) = ra[it]; \
    _Pragma("unroll") for (int it = 0; it < NJ; ++it) *(uint4*)(bw_ + 32768 + it * 8192 + wofs) = rb[it]; }
  GM_ISSUE(0)
  WAIT_VM(0);
  GM_PARK(0)
  __syncthreads();
#pragma unroll 1
  for (int kt = 0; kt < 16; ++kt) {
    if (kt + 1 < 16) GM_ISSUE(kt + 1)
    __builtin_amdgcn_sched_barrier(0);
    const char* ba = lds + (kt & 1) * STAGE;
    const char* bb = ba + 32768;
    bf16x8 hf[2][2], wf[NJ];
    {
      const int co = ((h ^ swr) << 4);
#pragma unroll
      for (int i = 0; i < 2; ++i) hf[0][i] = *(const bf16x8*)(ba + (wm * 64 + i * 32 + r) * 128 + co);
#pragma unroll
      for (int j = 0; j < NJ; ++j) wf[j] = *(const bf16x8*)(bb + (wn * 32 * NJ + j * 32 + r) * 128 + co);
    }
#pragma unroll
    for (int s = 0; s < 4; ++s) {
      const int co = (((2 * (s + 1) + h) ^ swr) << 4);
      if (s < 3) {
#pragma unroll
        for (int i = 0; i < 2; ++i) hf[(s + 1) & 1][i] = *(const bf16x8*)(ba + (wm * 64 + i * 32 + r) * 128 + co);
      }
#pragma unroll
      for (int j = 0; j < NJ; ++j) {
        acc[0][j] = MFMA(hf[s & 1][0], wf[j], acc[0][j]);
        acc[1][j] = MFMA(hf[s & 1][1], wf[j], acc[1][j]);
        if (s < 3) wf[j] = *(const bf16x8*)(bb + (wn * 32 * NJ + j * 32 + r) * 128 + co);
      }
      __builtin_amdgcn_sched_barrier(0);
    }
    if (kt + 1 < 16) {
      WAIT_VM(0);
      GM_PARK((kt + 1) & 1)
    }
    __syncthreads();
  }
#undef GM_ISSUE
#undef GM_PARK
}

DI float silu(float x) { return x * __builtin_amdgcn_rcpf(1.f + __expf(-x)); }

DI float dpp_x1(float v) { return __int_as_float(__builtin_amdgcn_update_dpp(0, __float_as_int(v), 0xB1, 0xF, 0xF, true)); }
DI float dpp_x8(float v) { return __int_as_float(__builtin_amdgcn_update_dpp(0, __float_as_int(v), 0x128, 0xF, 0xF, true)); }
DI void store_bf16_tile(const f32x16& a, u16* base  , size_t ld, int h, int odd) {
#pragma unroll
  for (int g = 0; g < 4; ++g)
#pragma unroll
    for (int e = 0; e < 4; e += 2) {
      const float v0 = a[4 * g + e], v1 = a[4 * g + e + 1];
      const float n0 = dpp_x1(v0), n1 = dpp_x1(v1);
      const u32 o = odd ? pk2(n1, v1) : pk2(v0, n0);
      *(u32*)(base + (size_t)(8 * g + 4 * h + e + odd) * ld) = o;
      if (e == 2) __builtin_amdgcn_sched_barrier(0);
    }
}
template <int NJ, int sec>
DI void p1_tile(const Params& p, char* lds, int tm, int col0) {
  constexpr int WN = 32 * NJ;
  const u16* HN = (const u16*)(p.ws + WS_HN);
  const u16* WT = (const u16*)(p.ws + WS_WINT);
  const float2* RT = (const float2*)(p.ws + WS_ROPE);
  const int fbase = col0 & 511;
  const bool sample = (tm == 64);
  f32x16 acc[2][NJ];
  gemm_mainloop<NJ>(HN, WT, tm * 256, col0, lds, acc);
  int tid = threadIdx.x;
  asm volatile("" : "+v"(tid));
  const int lane = tid & 63, w = tid >> 6, wm = w >> 1, wn = w & 1;
  const int r = lane & 31, h = lane >> 5, odd = r & 1;
  const int tb = tm * 256 + wm * 64;
  const int fb = fbase + wn * WN;
  if (sec == 2 || sec == 6) {
#pragma unroll
    for (int i = 0; i < 2; ++i) {
      float* dbase = nullptr;
      {
        const int t0 = tb + i * 32;
        if (!sample) {
          const int b = t0 >> 13, s0 = t0 & 8191;
          if (sec == 6) dbase = p.out + O_BVP + (size_t)t0 * 512;
          else if (s0 >= 7680) dbase = p.out + O_AVP + ((size_t)(b * 512 + s0 - 7680)) * 512;
        } else {
          const int ts = t0 - NTOKP, b = ts >> 5;
          if (sec == 6) dbase = p.out + O_BVS + (size_t)ts * 512;
          else dbase = p.out + O_AVS + ((size_t)(b * 512 + 480)) * 512;
        }
      }
#pragma unroll
      for (int j = 0; j < NJ; ++j) {
        unsigned lo = (wn * WN + j * 32 + r) * 528 + (wm * 64 + i * 32 + 4 * h) * 2;
        asm volatile("" : "+v"(lo));
#pragma unroll
        for (int g = 0; g < 4; ++g) {
          const float v0 = acc[i][j][4 * g], v1 = acc[i][j][4 * g + 1], v2 = acc[i][j][4 * g + 2], v3 = acc[i][j][4 * g + 3];
          uint2 o; o.x = pk2(v0, v1); o.y = pk2(v2, v3);
          *(uint2*)(lds + lo + g * 16) = o;
          if (dbase) {
            unsigned off = (8 * g + 4 * h) * 512 + fb + j * 32 + r;
            asm volatile("" : "+v"(off));
            dbase[off] = v0; dbase[off + 512] = v1; dbase[off + 1024] = v2; dbase[off + 1536] = v3;
          }
          __builtin_amdgcn_sched_barrier(0);
        }
      }
    }
    __syncthreads();
    {
      u16* VT; size_t ldv;
      if (sec == 2) { VT = (u16*)(p.ws + (sample ? WS_VATS : WS_VAT)); ldv = sample ? 544 : 8192; }
      else { VT = (u16*)(p.ws + (sample ? WS_VBTS : WS_VBT)); ldv = sample ? 1056 : 8192; }
      const int sofs = sample ? (sec == 2 ? 512 : 1024) : 0;
#pragma unroll
      for (int it = 0; it < 4 * NJ; ++it) {
        const int id = it * 512 + tid, row = id >> 5, c = id & 31;
        const uint4 v = *(const uint4*)(lds + row * 528 + c * 16);
        const int fs = fbase + row;
        if (!sample) {
          const int t0 = tm * 256 + c * 8, b = t0 >> 13, s = t0 & 8191;
          *(uint4*)(VT + ((size_t)(b * 512 + fs)) * ldv + s) = v;
        } else {
          const int b = c >> 2, tt = (c & 3) * 8;
          *(uint4*)(VT + ((size_t)(b * 512 + fs)) * ldv + sofs + tt) = v;
        }
        if ((it & 3) == 3) __builtin_amdgcn_sched_barrier(0);
      }
    }
    __syncthreads();
  } else {
    if (sec == 4 || sec == 5) {
      const float sgn = (r & 8) ? 1.f : -1.f;
      const int pos0 = sample ? (1024 + 4 * h) : ((tb & 8191) + 4 * h);
      const float2* rt = RT + pos0 * 8 + (r & 7);
#pragma unroll
      for (int i = 0; i < 2; ++i)
#pragma unroll
        for (int g = 0; g < 4; ++g) {
          const int po = (sample ? 0 : i * 32) + 8 * g;
          float2 cs[4];
#pragma unroll
          for (int e = 0; e < 4; ++e) cs[e] = rt[(po + e) * 8];
          __builtin_amdgcn_sched_barrier(0);
#pragma unroll
          for (int j = 0; j < NJ; j += 2)
#pragma unroll
            for (int e = 0; e < 4; ++e) {
              const float x = acc[i][j][4 * g + e];
              const float xp = dpp_x8(x);
              if (r < 16) acc[i][j][4 * g + e] = x * cs[e].x + sgn * xp * cs[e].y;
            }
          __builtin_amdgcn_sched_barrier(0);
        }
    }
    if (sec == 3 || sec == 7) {
#pragma unroll
      for (int i = 0; i < 2; ++i)
#pragma unroll
        for (int j = 0; j < NJ; ++j)
#pragma unroll
          for (int e = 0; e < 16; ++e) acc[i][j][e] = silu(acc[i][j][e]);
    }
    u16* dst; size_t trow0;
    if (sec == 0) { dst = (u16*)(p.ws + WS_QA); trow0 = tb; }
    else if (sec == 3) { dst = (u16*)(p.ws + WS_GA); trow0 = tb; }
    else if (sec == 4) { dst = (u16*)(p.ws + WS_QB); trow0 = tb; }
    else if (sec == 7) { dst = (u16*)(p.ws + WS_GB); trow0 = tb; }
    else if (sec == 1) {
      if (!sample) { dst = (u16*)(p.ws + WS_KA); trow0 = tb; }
      else { dst = (u16*)(p.ws + WS_KAS); trow0 = (size_t)(wm * 2) * 544 + 512; }
    } else {
      if (!sample) { dst = (u16*)(p.ws + WS_KB); trow0 = tb; }
      else { dst = (u16*)(p.ws + WS_KBS); trow0 = (size_t)(wm * 2) * 1056 + 1024; }
    }
    const size_t istep = sample ? (sec == 1 ? 544 : (sec == 5 ? 1056 : 32)) : 32;
#pragma unroll
    for (int i = 0; i < 2; ++i)
#pragma unroll
      for (int j = 0; j < NJ; ++j)
        store_bf16_tile(acc[i][j], dst + (trow0 + i * istep) * 512 + fb + j * 32 + (r & ~1), 512, h, odd);
    if (sec == 1 || sec == 5) {
#pragma unroll
      for (int i = 0; i < 2; ++i) {
        float* d = nullptr;
        const int t0 = tb + i * 32;
        if (!sample) {
          const int b = t0 >> 13, s = t0 & 8191;
          if (sec == 5) d = p.out + O_BKP + (size_t)t0 * 512;
          else if (s >= 7680) d = p.out + O_AKP + ((size_t)(b * 512 + s - 7680)) * 512;
        } else {
          const int ts = t0 - NTOKP, b = ts >> 5;
          if (sec == 5) d = p.out + O_BKS + (size_t)ts * 512;
          else d = p.out + O_AKS + ((size_t)(b * 512 + 480)) * 512;
        }
        if (d) {
#pragma unroll
          for (int j = 0; j < NJ; ++j)
#pragma unroll
            for (int e = 0; e < 16; ++e) {
              d[(size_t)(8 * (e >> 2) + 4 * h + (e & 3)) * 512 + fb + j * 32 + r] = acc[i][j][e];
              if ((e & 3) == 3) __builtin_amdgcn_sched_barrier(0);
            }
        }
      }
    }
  }
}
template <int NJ>
DI void p1_dispatch(const Params& p, char* lds, int tm, int col0) {
  switch (col0 >> 9) {
    case 0: p1_tile<NJ, 0>(p, lds, tm, col0); break;
    case 1: p1_tile<NJ, 1>(p, lds, tm, col0); break;
    case 2: p1_tile<NJ, 2>(p, lds, tm, col0); break;
    case 3: p1_tile<NJ, 3>(p, lds, tm, col0); break;
    case 4: p1_tile<NJ, 4>(p, lds, tm, col0); break;
    case 5: p1_tile<NJ, 5>(p, lds, tm, col0); break;
    case 6: p1_tile<NJ, 6>(p, lds, tm, col0); break;
    default: p1_tile<NJ, 7>(p, lds, tm, col0); break;
  }
}
DI void phase1(const Params& p, char* lds) {
  for (int tile = blockIdx.x; tile < 1024; tile += gridDim.x) {
    const int k = tile >> 8, b = tile & 255, xcd = b & 7, idx = b >> 3;
    const int tm = 16 * k + (xcd >> 1) * 4 + (idx & 3), tn = (xcd & 1) * 8 + (idx >> 2);
    p1_dispatch<4>(p, lds, tm, tn * 256);
  }
  for (int tile = blockIdx.x; tile < 32; tile += gridDim.x) p1_dispatch<2>(p, lds, 64, tile * 128);
}

constexpr float SM_C = 0.125f * 1.4426950408889634f;
template <int NQT, int DVT, bool BIAS>
DI void attn_wave(const u16* __restrict__ Q, int ldq, const u16* __restrict__ K, int ldk,
                  const u16* __restrict__ Vt, int ldv, int nkt, const float* bias_l2, int rel0,
                  f32x16 (&O)[NQT][DVT], float (&Mx)[NQT], float (&L)[NQT]) {
  const int lane = threadIdx.x & 63, r = lane & 31, h = lane >> 5;
  bf16x8 qf[NQT][4];
#pragma unroll
  for (int u = 0; u < NQT; ++u)
#pragma unroll
    for (int s = 0; s < 4; ++s) qf[u][s] = *(const bf16x8*)(Q + (size_t)(32 * u + r) * ldq + 16 * s + 8 * h);
#pragma unroll
  for (int u = 0; u < NQT; ++u) {
    Mx[u] = -INFINITY; L[u] = 0.f;
#pragma unroll
    for (int dt = 0; dt < DVT; ++dt)
#pragma unroll
      for (int e = 0; e < 16; ++e) O[u][dt][e] = 0.f;
  }
  const u16* kp = K + (size_t)rho(r) * ldk + 8 * h;
  const u16* vp = Vt + (size_t)r * ldv + 8 * h;
  bf16x8 kf[4];
#pragma unroll
  for (int s = 0; s < 4; ++s) kf[s] = *(const bf16x8*)(kp + 16 * s);
  for (int kt = 0; kt < nkt; ++kt) {
    bf16x8 vf[DVT][2];
#pragma unroll
    for (int dt = 0; dt < DVT; ++dt)
#pragma unroll
      for (int s2 = 0; s2 < 2; ++s2) vf[dt][s2] = *(const bf16x8*)(vp + (size_t)(32 * dt) * ldv + 32 * kt + 16 * s2);
    bf16x8 kn[4];
    {
      const int ktn = (kt + 1 < nkt) ? kt + 1 : kt;
#pragma unroll
      for (int s = 0; s < 4; ++s) kn[s] = *(const bf16x8*)(kp + (size_t)(32 * ktn) * ldk + 16 * s);
    }
    bf16x8 pf[NQT][2];
#pragma unroll
    for (int u = 0; u < NQT; ++u) {
      f32x16 S;
#pragma unroll
      for (int e = 0; e < 16; ++e) S[e] = 0.f;
#pragma unroll
      for (int s = 0; s < 4; ++s) S = MFMA(kf[s], qf[u][s], S);
      float t[16];
      if (BIAS) {
        const int relb = rel0 + 32 * u + r - 32 * kt - 8 * h;
        if (rel0 - 32 * kt - 31 >= 128) {
          const float bv = bias_l2[256];
#pragma unroll
          for (int e = 0; e < 16; ++e) t[e] = S[e] * SM_C + bv;
        } else {
#pragma unroll
          for (int e = 0; e < 16; ++e) {
            int rel = relb - ((e & 7) + 16 * (e >> 3));
            rel = rel < -128 ? -128 : (rel > 128 ? 128 : rel);
            t[e] = S[e] * SM_C + bias_l2[rel + 128];
          }
        }
      } else {
#pragma unroll
        for (int e = 0; e < 16; ++e) t[e] = S[e] * SM_C;
      }
      float mx = t[0];
#pragma unroll
      for (int e = 1; e < 16; ++e) mx = fmaxf(mx, t[e]);
      mx = fmaxf(mx, __shfl_xor(mx, 32));
      if (__any(mx > Mx[u] + 8.f)) {
        const float mn = fmaxf(Mx[u], mx);
        const float al = __builtin_amdgcn_exp2f(Mx[u] - mn);
        Mx[u] = mn; L[u] *= al;
#pragma unroll
        for (int dt = 0; dt < DVT; ++dt)
#pragma unroll
          for (int e = 0; e < 16; ++e) O[u][dt][e] *= al;
      }
      float ps = 0.f;
#pragma unroll
      for (int e = 0; e < 16; ++e) { t[e] = __builtin_amdgcn_exp2f(t[e] - Mx[u]); ps += t[e]; }
      L[u] += ps;
#pragma unroll
      for (int s2 = 0; s2 < 2; ++s2) {
        uint4 pk;
        pk.x = pk2(t[8 * s2], t[8 * s2 + 1]); pk.y = pk2(t[8 * s2 + 2], t[8 * s2 + 3]);
        pk.z = pk2(t[8 * s2 + 4], t[8 * s2 + 5]); pk.w = pk2(t[8 * s2 + 6], t[8 * s2 + 7]);
        pf[u][s2] = __builtin_bit_cast(bf16x8, pk);
      }
    }
#pragma unroll
    for (int u = 0; u < NQT; ++u)
#pragma unroll
      for (int dt = 0; dt < DVT; ++dt)
#pragma unroll
        for (int s2 = 0; s2 < 2; ++s2) O[u][dt] = MFMA(vf[dt][s2], pf[u][s2], O[u][dt]);
#pragma unroll
    for (int s = 0; s < 4; ++s) kf[s] = kn[s];
  }
#pragma unroll
  for (int u = 0; u < NQT; ++u) L[u] += __shfl_xor(L[u], 32);
}

template <int NQT>
DI void attnA_item(const Params& p, const u16* Q, const u16* K, const u16* Vt, int ldv, int nkt, int rel0,
                   const float* bias_l2, int tok0, int head) {
  f32x16 O[NQT][2]; float Mx[NQT], L[NQT];
  attn_wave<NQT, 2, true>(Q, 512, K, 512, Vt, ldv, nkt, bias_l2, rel0, O, Mx, L);
  const int lane = threadIdx.x & 63, r = lane & 31, h = lane >> 5;
  const u16* GA = (const u16*)(p.ws + WS_GA);
  u16* OB = (u16*)(p.ws + WS_HN);
#pragma unroll
  for (int u = 0; u < NQT; ++u) {
    const float inv = 1.f / L[u];
    const size_t tok = (size_t)(tok0 + 32 * u + r);
#pragma unroll
    for (int dt = 0; dt < 2; ++dt)
#pragma unroll
      for (int g = 0; g < 4; ++g) {
        const int dv = 32 * dt + 8 * g + 4 * h;
        const uint2 gg = *(const uint2*)(GA + tok * 512 + head * 64 + dv);
        uint2 o;
        o.x = pk2(O[u][dt][4 * g] * inv * bflo(gg.x), O[u][dt][4 * g + 1] * inv * bfhi(gg.x));
        o.y = pk2(O[u][dt][4 * g + 2] * inv * bflo(gg.y), O[u][dt][4 * g + 3] * inv * bfhi(gg.y));
        *(uint2*)(OB + tok * 1024 + head * 64 + dv) = o;
      }
  }
}

DI void attnB_epilogue(const Params& p, f32x16 (&O)[4], float Lsum, int tok0, int hb, float lam, float* xch) {
  const int lane = threadIdx.x & 63, r = lane & 31, h = lane >> 5, w = threadIdx.x >> 6, m = w >> 2, wsub = w & 3;
  const float inv = 1.f / Lsum;
  float* xw = xch + wsub * 4096 + lane;
  if (m == 1) {
    const float sc = inv * lam;
#pragma unroll
    for (int dt = 0; dt < 4; ++dt)
#pragma unroll
      for (int e = 0; e < 16; ++e) xw[(dt * 16 + e) * 64] = O[dt][e] * sc;
  }
  __syncthreads();
  if (m == 0) {
    float ss = 0.f;
#pragma unroll
    for (int dt = 0; dt < 4; ++dt)
#pragma unroll
      for (int e = 0; e < 16; ++e) { float o = O[dt][e] * inv - xw[(dt * 16 + e) * 64]; O[dt][e] = o; ss += o * o; }
    ss += __shfl_xor(ss, 32);
    const float rn = rsqrtf(ss * (1.f / 128.f) + 1e-6f) * 0.8f;
    const u16* GB = (const u16*)(p.ws + WS_GB);
    u16* OB = (u16*)(p.ws + WS_HN);
    const size_t tok = (size_t)(tok0 + r);
#pragma unroll
    for (int dt = 0; dt < 4; ++dt)
#pragma unroll
      for (int g = 0; g < 4; ++g) {
        const int dv = 32 * dt + 8 * g + 4 * h;
        const uint2 gg = *(const uint2*)(GB + tok * 512 + hb * 128 + dv);
        const float4 sg = *(const float4*)(p.subln + dv);
        uint2 o;
        o.x = pk2(O[dt][4 * g] * rn * sg.x * bflo(gg.x), O[dt][4 * g + 1] * rn * sg.y * bfhi(gg.x));
        o.y = pk2(O[dt][4 * g + 2] * rn * sg.z * bflo(gg.y), O[dt][4 * g + 3] * rn * sg.w * bfhi(gg.y));
        *(uint2*)(OB + tok * 1024 + 512 + hb * 128 + dv) = o;
      }
  }
  __syncthreads();
}

DI void attnB_item(const Params& p, const u16* Q, const u16* K, const u16* Vt, int ldv, int nkt, int tok0, int hb,
                   float lam, float* xch) {
  f32x16 O[1][4]; float Mx[1], L[1];
  attn_wave<1, 4, false>(Q, 512, K, 512, Vt, ldv, nkt, nullptr, 0, O, Mx, L);
  attnB_epilogue(p, O[0], L[0], tok0, hb, lam, xch);
}

typedef float f2 __attribute__((ext_vector_type(2)));
constexpr int BLK_V = 0, BLK_K = 49152, BLK_XCH = 81920, LDS_BIAS = 147456;
DI float half_max(float v) {
  auto rr = __builtin_amdgcn_permlane32_swap(__float_as_uint(v), __float_as_uint(v), false, false);
  return fmaxf(__uint_as_float(rr[0]), __uint_as_float(rr[1]));
}
DI void attnB_block(const Params& p, int b, int hb, int qt, float lam, char* lds) {
  const int tid = threadIdx.x, lane = tid & 63, r = lane & 31, h = lane >> 5, w = tid >> 6, m = w >> 2, wsub = w & 3;
  const bool late = (m == 1);
  const int q0 = qt * 128 + wsub * 32;
  const int nt = 2 * qt + 2;
  const int my_nt = (q0 >> 6) + 1;
  uint4 qraw[4];
  {
    const u16* Q = (const u16*)(p.ws + WS_QB) + (size_t)(b * SEQ + q0 + r) * 512 + hb * 128 + m * 64 + 8 * h;
#pragma unroll
    for (int s = 0; s < 4; ++s) gld16(qraw[s], Q + 16 * s);
  }
  f32x16 O[4];
#pragma unroll
  for (int dt = 0; dt < 4; ++dt)
#pragma unroll
    for (int e = 0; e < 16; ++e) O[dt][e] = 0.f;
  float Mx = -INFINITY;
  f2 L2 = {0.f, 0.f};
  const u16* gk = (const u16*)(p.ws + WS_KB) + (size_t)(b * SEQ + (tid >> 4)) * 512 + hb * 128 + (tid & 15) * 8;
  const u16* gv = (const u16*)(p.ws + WS_VBT) + (size_t)(b * 512 + hb * 128 + (tid >> 3)) * SEQ + (tid & 7) * 8;
  const int lk = BLK_K + ((tid >> 3) & 1) * 8192 + (tid >> 4) * 128 + ((((tid & 7) ^ ((tid >> 5) & 7))) << 4);
  const int lv = BLK_V + (tid >> 3) * 128 + ((((tid & 7) ^ ((tid >> 4) & 7))) << 4);
  const int rr = rho(r);
  const int swk = (rr >> 1) & 7, swv = (r >> 1) & 7;
  uint4 sk0, sk1, sv0, sv1;
  gld16(sk0, gk); gld16(sk1, gk + (size_t)32 * 512);
  gld16(sv0, gv); gld16(sv1, gv + (size_t)64 * SEQ);
  wait_vm0();
  *(uint4*)(lds + lk) = sk0; *(uint4*)(lds + lk + 4096) = sk1;
  *(uint4*)(lds + lv) = sv0; *(uint4*)(lds + lv + 8192) = sv1;
  bf16x8 qf[4];
#pragma unroll
  for (int s = 0; s < 4; ++s) qf[s] = __builtin_bit_cast(bf16x8, qraw[s]);
  bf16x8 pf[4];
#pragma unroll
  for (int s = 0; s < 4; ++s) pf[s] = qf[s];
  __syncthreads();
  int vs = 0;
  for (int t = 0; t <= nt; ++t) {
    if (t + 1 < nt) {
      gld16(sk0, gk + (size_t)(64 * (t + 1)) * 512);
      gld16(sk1, gk + (size_t)(64 * (t + 1) + 32) * 512);
      gld16(sv0, gv + 64 * (t + 1));
      gld16(sv1, gv + (size_t)64 * SEQ + 64 * (t + 1));
    }
    __builtin_amdgcn_sched_barrier(0);
    if (late && t >= 1 && t - 1 < my_nt) {
      const char* vb = lds + BLK_V + (vs == 0 ? 2 : vs - 1) * 16384;
#pragma unroll
      for (int ks = 0; ks < 4; ++ks) {
        const int co = (((2 * ks + h) ^ swv) << 4);
#pragma unroll
        for (int dt = 0; dt < 4; ++dt) {
          bf16x8 v = *(const bf16x8*)(vb + (32 * dt + r) * 128 + co);
          O[dt] = MFMA(v, pf[ks], O[dt]);
        }
      }
    }
    if (t < my_nt && t < nt) {
      const char* kb = lds + BLK_K + (t & 1) * 16384 + m * 8192;
      f32x16 S0, S1;
#pragma unroll
      for (int e = 0; e < 16; ++e) { S0[e] = 0.f; S1[e] = 0.f; }
      bf16x8 ka[4], kc[4];
#pragma unroll
      for (int s = 0; s < 4; ++s) {
        const int co = (((2 * s + h) ^ swk) << 4);
        ka[s] = *(const bf16x8*)(kb + rr * 128 + co);
        kc[s] = *(const bf16x8*)(kb + (32 + rr) * 128 + co);
      }
#pragma unroll
      for (int s = 0; s < 4; ++s) {
        S0 = MFMA(ka[s], qf[s], S0);
        S1 = MFMA(kc[s], qf[s], S1);
      }
      f2 tv[16];
      const f2 cc = {SM_C, SM_C};
#pragma unroll
      for (int e = 0; e < 8; ++e) {
        f2 a = {S0[2 * e], S0[2 * e + 1]}; tv[e] = a * cc;
        f2 c = {S1[2 * e], S1[2 * e + 1]}; tv[8 + e] = c * cc;
      }
      float mx = fmaxf(tv[0].x, tv[0].y);
#pragma unroll
      for (int e = 1; e < 16; ++e) mx = fmaxf(mx, fmaxf(tv[e].x, tv[e].y));
      mx = half_max(mx);
      if (__any(mx > Mx + 8.f)) {
        const float mn = fmaxf(Mx, mx);
        const float al = __builtin_amdgcn_exp2f(Mx - mn);
        Mx = mn; L2 *= al;
#pragma unroll
        for (int dt = 0; dt < 4; ++dt)
#pragma unroll
          for (int e = 0; e < 16; ++e) O[dt][e] *= al;
      }
      const f2 nm = {-Mx, -Mx};
#pragma unroll
      for (int e = 0; e < 16; ++e) {
        f2 d = tv[e] + nm;
        d.x = __builtin_amdgcn_exp2f(d.x); d.y = __builtin_amdgcn_exp2f(d.y);
        L2 += d;
        tv[e] = d;
      }
#pragma unroll
      for (int s2 = 0; s2 < 4; ++s2) {
        uint4 pa;
        pa.x = pk2(tv[4 * s2].x, tv[4 * s2].y); pa.y = pk2(tv[4 * s2 + 1].x, tv[4 * s2 + 1].y);
        pa.z = pk2(tv[4 * s2 + 2].x, tv[4 * s2 + 2].y); pa.w = pk2(tv[4 * s2 + 3].x, tv[4 * s2 + 3].y);
        pf[s2] = __builtin_bit_cast(bf16x8, pa);
      }
      if (!late) {
        const char* vb = lds + BLK_V + vs * 16384;
#pragma unroll
        for (int ks = 0; ks < 4; ++ks) {
          const int co = (((2 * ks + h) ^ swv) << 4);
#pragma unroll
          for (int dt = 0; dt < 4; ++dt) {
            bf16x8 v = *(const bf16x8*)(vb + (32 * dt + r) * 128 + co);
            O[dt] = MFMA(v, pf[ks], O[dt]);
          }
        }
      }
    }
    if (t + 1 < nt) {
      const int vn = (vs == 2 ? 0 : vs + 1);
      wait_vm0();
      *(uint4*)(lds + lk + ((t + 1) & 1) * 16384) = sk0; *(uint4*)(lds + lk + ((t + 1) & 1) * 16384 + 4096) = sk1;
      *(uint4*)(lds + lv + vn * 16384) = sv0; *(uint4*)(lds + lv + vn * 16384 + 8192) = sv1;
    }
    vs = (vs == 2 ? 0 : vs + 1);
    __syncthreads();
  }
  float L = L2.x + L2.y;
  L += __shfl_xor(L, 32);
  attnB_epilogue(p, O, L, b * SEQ + q0, hb, lam, (float*)(lds + BLK_XCH));
}

DI float phase2_setup(const Params& p, char* lds) {
  const int tid = threadIdx.x, lane = tid & 63;
  float* bias = (float*)(lds + LDS_BIAS);
  for (int i = tid; i < 8 * 257; i += 512) { int hh = i / 257, k = i - hh * 257; bias[hh * 260 + k] = p.rel_bias[i] * 1.4426950408889634f; }
  float a = p.lq1[lane] * p.lk1[lane], b = p.lq2[lane] * p.lk2[lane];
  a = wave_sum(a); b = wave_sum(b);
  __syncthreads();
  return expf(a) - expf(b) + 0.2f;
}
DI void p3_tile(const Params& p, char* lds, int tok0) {
  int tid = threadIdx.x;
  asm volatile("" : "+v"(tid));
  const int lane = tid & 63, w = tid >> 6, r = lane & 31, h = lane >> 5;
  const u16* OB = (const u16*)(p.ws + WS_HN);
  float* red = (float*)(lds + 131072);
  __syncthreads();
#pragma unroll
  for (int half = 0; half < 2; ++half) {
    uint4 a[8];
#pragma unroll
    for (int it = 0; it < 8; ++it) a[it] = *(const uint4*)(OB + (size_t)(tok0 + half * 32 + it * 4 + (tid >> 7)) * 1024 + (tid & 127) * 8);
#pragma unroll
    for (int it = 0; it < 8; ++it) {
      const int row = half * 32 + it * 4 + (tid >> 7);
      *(uint4*)(lds + row * 2048 + ((((tid & 127) ^ (row & 15))) << 4)) = a[it];
    }
  }
  f32x16 acc[2][4];
#pragma unroll
  for (int i = 0; i < 2; ++i)
#pragma unroll
    for (int j = 0; j < 4; ++j)
#pragma unroll
      for (int e = 0; e < 16; ++e) acc[i][j][e] = 0.f;
  const char* wp = p.ws + WS_WOUTT + ((size_t)(w * 4) * 4096 + lane) * 16;
  const char* ap = lds + r * 2048;
  const int akey = r & 15;
  uint4 bq[3][4];
#pragma unroll
  for (int s = 0; s < 3; ++s)
#pragma unroll
    for (int j = 0; j < 4; ++j) gld16(bq[s][j], wp + (size_t)(j * 4096 + s * 64) * 16);
  __syncthreads();
#define P3_KSTEP(KS, SLOT, WAITN, REFILL)                                                        \
  {                                                                                              \
    const int co_ = ((((2 * (KS) + h) ^ akey)) << 4);                                            \
    const bf16x8 a0_ = *(const bf16x8*)(ap + co_);                                               \
    const bf16x8 a1_ = *(const bf16x8*)(ap + 65536 + co_);                                       \
    WAIT_VM(WAITN);                                                                              \
    __builtin_amdgcn_sched_barrier(0);                                                           \
    _Pragma("unroll") for (int j = 0; j < 4; ++j) {                                              \
      const bf16x8 bf_ = __builtin_bit_cast(bf16x8, bq[SLOT][j]);                                \
      acc[0][j] = MFMA(a0_, bf_, acc[0][j]);                                                     \
      acc[1][j] = MFMA(a1_, bf_, acc[1][j]);                                                     \
    }                                                                                            \
    __builtin_amdgcn_sched_barrier(0);                                                           \
    if (REFILL) {                                                                                \
      _Pragma("unroll") for (int j = 0; j < 4; ++j) gld16(bq[SLOT][j], wp + (size_t)(j * 4096 + ((KS) + 3) * 64) * 16); \
    }                                                                                            \
    __builtin_amdgcn_sched_barrier(0);                                                           \
  }
#pragma unroll 1
  for (int g = 0; g < 20; ++g) {
    P3_KSTEP(3 * g, 0, 8, true)
    P3_KSTEP(3 * g + 1, 1, 8, true)
    P3_KSTEP(3 * g + 2, 2, 8, true)
  }
  P3_KSTEP(60, 0, 8, true)
  P3_KSTEP(61, 1, 8, false)
  P3_KSTEP(62, 2, 4, false)
  P3_KSTEP(63, 0, 0, false)
  const float* xr = tok0 < NTOKP ? p.x_prompt + (size_t)tok0 * 1024 : p.x_sample + (size_t)(tok0 - NTOKP) * 1024;
  const unsigned cb = w * 128 + r;
#pragma unroll
  for (int i = 0; i < 2; ++i) {
#pragma unroll
    for (int e = 0; e < 16; ++e) {
      const int row = 32 * i + 8 * (e >> 2) + 4 * h + (e & 3);
      unsigned off = row * 1024 + cb;
      asm volatile("" : "+v"(off));
      float ssv = 0.f;
#pragma unroll
      for (int j = 0; j < 4; ++j) {
        const float y = acc[i][j][e] + xr[off + j * 32];
        acc[i][j][e] = y; ssv += y * y;
      }
      ssv += __shfl_xor(ssv, 1); ssv += __shfl_xor(ssv, 2); ssv += __shfl_xor(ssv, 4); ssv += __shfl_xor(ssv, 8); ssv += __shfl_xor(ssv, 16);
      if (r == 0) red[w * 64 + row] = ssv;
      if ((e & 3) == 3) __builtin_amdgcn_sched_barrier(0);
    }
  }
  __syncthreads();
  if (tid < 64) {
    float t = 0.f;
#pragma unroll
    for (int k = 0; k < 8; ++k) t += red[k * 64 + tid];
    red[512 + tid] = rsqrtf(t * (1.f / 1024.f) + 1e-6f);
  }
  __syncthreads();
  float* yr = p.out + O_YP + (size_t)tok0 * 1024;
  float gj[4];
#pragma unroll
  for (int j = 0; j < 4; ++j) gj[j] = p.final_gain[cb + j * 32];
#pragma unroll
  for (int i = 0; i < 2; ++i) {
#pragma unroll
    for (int e = 0; e < 16; ++e) {
      const int row = 32 * i + 8 * (e >> 2) + 4 * h + (e & 3);
      unsigned off = row * 1024 + cb;
      asm volatile("" : "+v"(off));
      const float ri = red[512 + row];
#pragma unroll
      for (int j = 0; j < 4; ++j) yr[off + j * 32] = acc[i][j][e] * ri * gj[j];
      if ((e & 3) == 3) __builtin_amdgcn_sched_barrier(0);
    }
  }
}

constexpr int NQUEUE = 12;
DI int q_pop(unsigned* ctr, int* slot) {
  __syncthreads();
  if (threadIdx.x == 0) *slot = (int)__hip_atomic_fetch_add(ctr, 1u, __ATOMIC_RELAXED, __HIP_MEMORY_SCOPE_AGENT);
  __syncthreads();
  return *slot;
}
DI void p2_all(const Params& p, char* lds, float lam) {
  const int w = threadIdx.x >> 6;
  unsigned* Q = (unsigned*)(p.ws + WS_QUEUE);
  int* slot = (int*)(lds + LDS_BIAS + 8320);
  float* xch = (float*)(lds + 65536);
  const float* bias = (const float*)(lds + LDS_BIAS);
  const u16* QA = (const u16*)(p.ws + WS_QA);
  const u16* QB = (const u16*)(p.ws + WS_QB);
  {
    const int it = q_pop(Q, slot);
    if (it < 8) {
      const int m = w >> 2, wsub = w & 3, id = it * 4 + wsub, b = id >> 2, hb = id & 3;
      attnB_item(p, QB + (size_t)(NTOKP + b * 32) * 512 + hb * 128 + m * 64,
                 (const u16*)(p.ws + WS_KBS) + (size_t)(b * 1056) * 512 + hb * 128 + m * 64,
                 (const u16*)(p.ws + WS_VBTS) + (size_t)(b * 512 + hb * 128) * 1056, 1056, 33, NTOKP + b * 32, hb, lam, xch);
    } else if (it < 16) {
      const int b = it - 8;
      attnA_item<1>(p, QA + (size_t)(NTOKP + b * 32) * 512 + w * 64,
                    (const u16*)(p.ws + WS_KAS) + (size_t)(b * 544) * 512 + w * 64,
                    (const u16*)(p.ws + WS_VATS) + (size_t)(b * 512 + w * 64) * 544, 544, 17, 512, bias + w * 260,
                    NTOKP + b * 32, w);
    }
    if (it < 16) {
      asm volatile("s_waitcnt vmcnt(0)" ::: "memory");
      __syncthreads();
      if (threadIdx.x == 0) {
        __builtin_amdgcn_fence(__ATOMIC_RELEASE, "agent");
        __hip_atomic_fetch_add(Q + 64 * 11, 1u, __ATOMIC_RELAXED, __HIP_MEMORY_SCOPE_AGENT);
      }
    }
  }
#pragma unroll 1
  for (int k = 0; k < 8; ++k) {
    const int x = (blockIdx.x + k) & 7;
#pragma unroll 1
    for (;;) {
      const int i = q_pop(Q + 64 * (1 + x), slot);
      if (i >= 64) break;
      attnB_block(p, x >> 2, x & 3, 63 - i, lam, lds);
    }
  }
#pragma unroll 1
  for (;;) {
    const int it = q_pop(Q + 64 * 9, slot);
    if (it >= 256) break;
    const int b = it >> 7, c = it & 127, cs = c > 8 ? c - 8 : 0;
    attnA_item<2>(p, QA + (size_t)(b * SEQ + c * 64) * 512 + w * 64,
                  (const u16*)(p.ws + WS_KA) + (size_t)(b * SEQ + cs * 64) * 512 + w * 64,
                  (const u16*)(p.ws + WS_VAT) + (size_t)(b * 512 + w * 64) * SEQ + cs * 64, SEQ,
                  (c + 1 - cs) * 2, 64 * (c - cs), bias + w * 260, b * SEQ + c * 64, w);
  }
#pragma unroll 1
  for (;;) {
    const int it = q_pop(Q + 64 * 10, slot);
    if (it >= 4) break;
    if (threadIdx.x == 0) {
      while (__hip_atomic_load(Q + 64 * 11, __ATOMIC_RELAXED, __HIP_MEMORY_SCOPE_AGENT) < 16u) __builtin_amdgcn_s_sleep(2);
      __builtin_amdgcn_fence(__ATOMIC_ACQUIRE, "agent");
    }
    __syncthreads();
    p3_tile(p, lds, NTOKP + it * 64);
  }
}

DI void phase4(const Params& p) {
  const int lane = threadIdx.x & 63, w = threadIdx.x >> 6;
  for (int row = blockIdx.x * 8 + w; row < NTOK; row += gridDim.x * 8) {
    float* y = p.out + O_YP + (size_t)row * 1024;
    float4 v[4]; float ss = 0.f;
#pragma unroll
    for (int it = 0; it < 4; ++it) { v[it] = *(const float4*)(y + it * 256 + lane * 4); ss += v[it].x * v[it].x + v[it].y * v[it].y + v[it].z * v[it].z + v[it].w * v[it].w; }
    ss = wave_sum(ss);
    const float inv = rsqrtf(ss * (1.f / 1024.f) + 1e-6f);
#pragma unroll
    for (int it = 0; it < 4; ++it) {
      float4 g = *(const float4*)(p.final_gain + it * 256 + lane * 4);
      *(float4*)(y + it * 256 + lane * 4) = make_float4(v[it].x * inv * g.x, v[it].y * inv * g.y, v[it].z * inv * g.z, v[it].w * inv * g.w);
    }
  }
}

__global__ void __launch_bounds__(512) fwd_megakernel(Params p) {
  __shared__ __attribute__((aligned(16))) char lds[155904];
  cg::grid_group grid = cg::this_grid();
  unsigned* ctr = (unsigned*)(p.ws + WS_BAR);
  const unsigned G = gridDim.x;
  if (p.out == nullptr) grid.sync();
  phase0(p, lds);
  ctr_barrier(ctr, G);
  phase1(p, lds);
  ctr_barrier(ctr, 2 * G);
  {
    const float lam = phase2_setup(p, lds);
    p2_all(p, lds, lam);
  }
  ctr_barrier(ctr, 3 * G);
  for (int t = blockIdx.x; t < 256; t += gridDim.x) p3_tile(p, lds, t * 64);
}

extern "C" void kernel_launch(void* const* d_in, const int* in_sizes, int n_in, void* d_out, int out_size, void* d_ws,
                              size_t ws_size, hipStream_t stream) {
  static int grid_blocks = 0;
  if (!grid_blocks) {
    int dev = 0, cus = 0, per_cu = 0;
    hipGetDevice(&dev);
    hipDeviceGetAttribute(&cus, hipDeviceAttributeMultiprocessorCount, dev);
    hipOccupancyMaxActiveBlocksPerMultiprocessor(&per_cu, fwd_megakernel, 512, 0);
    if (per_cu < 1) per_cu = 1;
    grid_blocks = cus;
  }
  Params p{};
  p.x_prompt = (const float*)d_in[0]; p.x_sample = (const float*)d_in[1];
  p.cache_a_k = (const float*)d_in[2]; p.cache_a_v = (const float*)d_in[3];
  p.cache_b_k = (const float*)d_in[4]; p.cache_b_v = (const float*)d_in[5];
  p.norm_gain = (const float*)d_in[6]; p.w_in = (const float*)d_in[7]; p.w_out = (const float*)d_in[8];
  p.rel_bias = (const float*)d_in[9];
  p.lq1 = (const float*)d_in[10]; p.lk1 = (const float*)d_in[11]; p.lq2 = (const float*)d_in[12]; p.lk2 = (const float*)d_in[13];
  p.subln = (const float*)d_in[14]; p.final_gain = (const float*)d_in[15];
  p.out = (float*)d_out; p.ws = (char*)d_ws;
  void* args[] = {&p};
  (void)hipMemsetAsync((char*)d_ws + WS_BAR, 0, 8192, stream);
  hipError_t e = hipLaunchCooperativeKernel((void*)fwd_megakernel, dim3(grid_blocks), dim3(512), args, 0, stream);
  if (e != hipSuccess) fprintf(stderr, "cooperative launch failed: %s (grid %d)\n", hipGetErrorString(e), grid_blocks);
}
```

```cpp
#include <hip/hip_runtime.h>
#include <hip/hip_cooperative_groups.h>
#include <cstdio>
namespace cg = cooperative_groups;

typedef short bf16x8 __attribute__((ext_vector_type(8)));
typedef float f32x16 __attribute__((ext_vector_type(16)));
typedef __bf16 bf2_t __attribute__((ext_vector_type(2)));
typedef float f2_t __attribute__((ext_vector_type(2)));
typedef unsigned u32;
typedef unsigned short u16;
#define DI __device__ __forceinline__
#define MFMA(a, b, c) __builtin_amdgcn_mfma_f32_32x32x16_bf16((a), (b), (c), 0, 0, 0)

constexpr int NTOKP = 16384;
constexpr int NTOK = 16640;
constexpr int SEQ = 8192;
constexpr size_t O_YP = 0;
constexpr size_t O_AKP = 17039360, O_AVP = 17563648, O_BKP = 18087936, O_BVP = 26476544;
constexpr size_t O_AKS = 34865152, O_AVS = 36962304, O_BKS = 39059456, O_BVS = 39190528;
constexpr size_t WS_WINT = 0;
constexpr size_t WS_WOUTT = WS_WINT + 8388608;
constexpr size_t WS_HN = WS_WOUTT + 2097152;
constexpr size_t WS_QA = WS_HN + 34078720;
constexpr size_t WS_KA = WS_QA + 17039360;
constexpr size_t WS_KAS = WS_KA + 16777216;
constexpr size_t WS_VAT = WS_KAS + 4456448;
constexpr size_t WS_VATS = WS_VAT + 16777216;
constexpr size_t WS_GA = WS_VATS + 4456448;
constexpr size_t WS_QB = WS_GA + 17039360;
constexpr size_t WS_KB = WS_QB + 17039360;
constexpr size_t WS_KBS = WS_KB + 16777216;
constexpr size_t WS_VBT = WS_KBS + 8650752;
constexpr size_t WS_VBTS = WS_VBT + 16777216;
constexpr size_t WS_GB = WS_VBTS + 8650752;
constexpr size_t WS_ROPE = WS_GB + 17039360;
constexpr size_t WS_BAR = WS_ROPE + 524288;
constexpr size_t WS_QUEUE = WS_BAR + 4096;
constexpr size_t WS_END = WS_QUEUE + 8192;

struct Params {
  const float* x_prompt; const float* x_sample;
  const float* cache_a_k; const float* cache_a_v; const float* cache_b_k; const float* cache_b_v;
  const float* norm_gain; const float* w_in; const float* w_out; const float* rel_bias;
  const float* lq1; const float* lk1; const float* lq2; const float* lk2;
  const float* subln; const float* final_gain;
  float* out; char* ws;
};

DI u32 pk2(float a, float b) { f2_t v = {a, b}; bf2_t r = __builtin_convertvector(v, bf2_t); return __builtin_bit_cast(u32, r); }
DI float bflo(u32 v) { return __uint_as_float(v << 16); }
DI float bfhi(u32 v) { return __uint_as_float(v & 0xffff0000u); }
DI int rho(int r) { return (r & ~12) | ((r & 4) << 1) | ((r & 8) >> 1); }
DI void gld16(uint4& dst, const void* p) { asm volatile("global_load_dwordx4 %0, %1, off" : "=v"(dst) : "v"(p) : "memory"); }
#define WAIT_VM(n) asm volatile("s_waitcnt vmcnt(" #n ")" ::: "memory")
DI void wait_vm0() { asm volatile("s_waitcnt vmcnt(0)" ::: "memory"); }
DI float wave_sum(float v) {
#pragma unroll
  for (int o = 32; o > 0; o >>= 1) v += __shfl_xor(v, o);
  return v;
}


DI void ctr_barrier(unsigned* ctr, unsigned target) {
  __syncthreads();
  if (threadIdx.x == 0) {
    __builtin_amdgcn_fence(__ATOMIC_RELEASE, "agent");
    __hip_atomic_fetch_add(ctr, 1u, __ATOMIC_RELAXED, __HIP_MEMORY_SCOPE_AGENT);
    while (__hip_atomic_load(ctr, __ATOMIC_RELAXED, __HIP_MEMORY_SCOPE_AGENT) < target) __builtin_amdgcn_s_sleep(1);
    __builtin_amdgcn_fence(__ATOMIC_ACQUIRE, "agent");
  }
  __syncthreads();
}

DI void phase0(const Params& p, char* lds) {
  const int tid = threadIdx.x, bid = blockIdx.x, nb = gridDim.x;
  const int lane = tid & 63, w = tid >> 6;
  float* tile = (float*)lds;
  for (int i = bid * 512 + tid; i < 131072; i += nb * 512) {
    const int ln = i & 63, s_ = (i >> 6) & 63, ct = i >> 12, r_ = ln & 31, h_ = ln >> 5;
    float v[8];
#pragma unroll
    for (int j = 0; j < 8; ++j) v[j] = p.w_out[(size_t)(16 * s_ + 8 * h_ + j) * 1024 + ct * 32 + r_];
    uint4 o; o.x = pk2(v[0], v[1]); o.y = pk2(v[2], v[3]); o.z = pk2(v[4], v[5]); o.w = pk2(v[6], v[7]);
    *(uint4*)(p.ws + WS_WOUTT + (size_t)i * 16) = o;
  }
  for (int t = bid; t < 1024; t += nb) {
    const float* W; u16* WT; int N, kt, nt;
    { W = p.w_in; WT = (u16*)(p.ws + WS_WINT); N = 4096; kt = t >> 6; nt = t & 63; }
#pragma unroll
    for (int it = 0; it < 8; ++it) {
      int idx = it * 512 + tid, kk = idx >> 6, nn = idx & 63;
      tile[kk * 65 + nn] = W[(size_t)(kt * 64 + kk) * N + nt * 64 + nn];
    }
    __syncthreads();
    {
      int n = tid >> 3, kg = tid & 7;
      float v[8];
#pragma unroll
      for (int j = 0; j < 8; ++j) v[j] = tile[(kg * 8 + j) * 65 + n];
      uint4 o; o.x = pk2(v[0], v[1]); o.y = pk2(v[2], v[3]); o.z = pk2(v[4], v[5]); o.w = pk2(v[6], v[7]);
      *(uint4*)(WT + (size_t)(nt * 64 + n) * 1024 + kt * 64 + kg * 8) = o;
    }
    __syncthreads();
  }
  {
    u16* HN = (u16*)(p.ws + WS_HN);
#pragma unroll 2
    for (int row = bid * 8 + w; row < NTOK; row += nb * 8) {
      const float* src = row < NTOKP ? p.x_prompt + (size_t)row * 1024 : p.x_sample + (size_t)(row - NTOKP) * 1024;
      float4 v[4]; float ss = 0.f;
#pragma unroll
      for (int it = 0; it < 4; ++it) { v[it] = *(const float4*)(src + it * 256 + lane * 4); ss += v[it].x * v[it].x + v[it].y * v[it].y + v[it].z * v[it].z + v[it].w * v[it].w; }
      ss = wave_sum(ss);
      float inv = rsqrtf(ss * (1.f / 1024.f) + 1e-6f);
#pragma unroll
      for (int it = 0; it < 4; ++it) {
        float4 g = *(const float4*)(p.norm_gain + it * 256 + lane * 4);
        uint2 o; o.x = pk2(v[it].x * inv * g.x, v[it].y * inv * g.y); o.y = pk2(v[it].z * inv * g.z, v[it].w * inv * g.w);
        *(uint2*)(HN + (size_t)row * 1024 + it * 256 + lane * 4) = o;
      }
    }
  }
  const int gt = bid * 512 + tid, gn = nb * 512;
  {
    u16* KAS = (u16*)(p.ws + WS_KAS);
#pragma unroll 4
    for (int i = gt; i < 524288; i += gn) {
      int e = i * 4, b = e >> 18, key = (e >> 9) & 511, f = e & 511;
      float4 v = *(const float4*)(p.cache_a_k + e);
      uint2 o; o.x = pk2(v.x, v.y); o.y = pk2(v.z, v.w);
      *(uint2*)(KAS + (size_t)(b * 544 + key) * 512 + f) = o;
      if (key >= 32) *(float4*)(p.out + O_AKS + (size_t)(b * 512 + key - 32) * 512 + f) = v;
    }
    u16* KBS = (u16*)(p.ws + WS_KBS);
#pragma unroll 4
    for (int i = gt; i < 1048576; i += gn) {
      int e = i * 4, b = e >> 19, key = (e >> 9) & 1023, f = e & 511;
      float4 v = *(const float4*)(p.cache_b_k + e);
      uint2 o; o.x = pk2(v.x, v.y); o.y = pk2(v.z, v.w);
      *(uint2*)(KBS + (size_t)(b * 1056 + key) * 512 + f) = o;
    }
    u16* VATS = (u16*)(p.ws + WS_VATS);
#pragma unroll 2
    for (int i = gt; i < 262144; i += gn) {
      int f = i & 511, kg = (i >> 9) & 63, b = i >> 15;
      float v[8];
#pragma unroll
      for (int j = 0; j < 8; ++j) v[j] = p.cache_a_v[(size_t)(b * 512 + kg * 8 + j) * 512 + f];
      uint4 o; o.x = pk2(v[0], v[1]); o.y = pk2(v[2], v[3]); o.z = pk2(v[4], v[5]); o.w = pk2(v[6], v[7]);
      *(uint4*)(VATS + (size_t)(b * 512 + f) * 544 + kg * 8) = o;
      if (kg >= 4) {
#pragma unroll
        for (int j = 0; j < 8; ++j) p.out[O_AVS + (size_t)(b * 512 + kg * 8 + j - 32) * 512 + f] = v[j];
      }
    }
    u16* VBTS = (u16*)(p.ws + WS_VBTS);
#pragma unroll 2
    for (int i = gt; i < 524288; i += gn) {
      int f = i & 511, kg = (i >> 9) & 127, b = i >> 16;
      float v[8];
#pragma unroll
      for (int j = 0; j < 8; ++j) v[j] = p.cache_b_v[(size_t)(b * 1024 + kg * 8 + j) * 512 + f];
      uint4 o; o.x = pk2(v[0], v[1]); o.y = pk2(v[2], v[3]); o.z = pk2(v[4], v[5]); o.w = pk2(v[6], v[7]);
      *(uint4*)(VBTS + (size_t)(b * 512 + f) * 1056 + kg * 8) = o;
    }
  }
  {
    float2* RT = (float2*)(p.ws + WS_ROPE);
    for (int i = gt; i < 65536; i += gn) {
      int pos = i >> 3, m = i & 7;
      float inv = powf(500000.f, -(float)m * 0.125f);
      float ang = (float)pos * inv;
      RT[i] = make_float2(cosf(ang), sinf(ang));
    }
  }
}

template <int NJ>
DI void gemm_mainloop(const u16* __restrict__ A, const u16* __restrict__ Bt, int row0, int col0, char* lds, f32x16 (&acc)[2][NJ]) {
  constexpr int STAGE = 32768 + NJ * 8192;
  int tid = threadIdx.x;
  asm volatile("" : "+v"(tid));
  const int lane = tid & 63, w = tid >> 6, wm = w >> 1, wn = w & 1;
  const int r = lane & 31, h = lane >> 5;
  const u16* pa = A + (size_t)(row0 + (tid >> 3)) * 1024 + (tid & 7) * 8;
  const u16* pb = Bt + (size_t)(col0 + (tid >> 3)) * 1024 + (tid & 7) * 8;
  const int wofs = (tid >> 3) * 128 + ((((tid & 7) ^ ((tid >> 4) & 7))) << 4);
  const int swr = (r >> 1) & 7;
#pragma unroll
  for (int i = 0; i < 2; ++i)
#pragma unroll
    for (int j = 0; j < NJ; ++j)
#pragma unroll
      for (int e = 0; e < 16; ++e) acc[i][j][e] = 0.f;
  uint4 ra[4], rb[NJ];
#define GM_ISSUE(KB)                                                                          \
  { _Pragma("unroll") for (int it = 0; it < 4; ++it) gld16(ra[it], pa + (size_t)it * 65536 + (KB) * 64); \
    _Pragma("unroll") for (int it = 0; it < NJ; ++it) gld16(rb[it], pb + (size_t)it * 65536 + (KB) * 64); }
#define GM_PARK(ST)                                                                           \
  { char* bw_ = lds + (ST) * STAGE;                                                           \
    _Pragma("unroll") for (int it = 0; it < 4; ++it) *(uint4*)(bw_ + it * 8192 + wofs) = ra[it]; \
    _Pragma("unroll") for (int it = 0; it < NJ; ++it) *(uint4*)(bw_ + 32768 + it * 8192 + wofs) = rb[it]; }
  GM_ISSUE(0)
  WAIT_VM(0);
  GM_PARK(0)
  __syncthreads();
#pragma unroll 1
  for (int kt = 0; kt < 16; ++kt) {
    if (kt + 1 < 16) GM_ISSUE(kt + 1)
    __builtin_amdgcn_sched_barrier(0);
    const char* ba = lds + (kt & 1) * STAGE;
    const char* bb = ba + 32768;
    bf16x8 hf[2][2], wf[NJ];
    {
      const int co = ((h ^ swr) << 4);
#pragma unroll
      for (int i = 0; i < 2; ++i) hf[0][i] = *(const bf16x8*)(ba + (wm * 64 + i * 32 + r) * 128 + co);
#pragma unroll
      for (int j = 0; j < NJ; ++j) wf[j] = *(const bf16x8*)(bb + (wn * 32 * NJ + j * 32 + r) * 128 + co);
    }
#pragma unroll
    for (int s = 0; s < 4; ++s) {
      const int co = (((2 * (s + 1) + h) ^ swr) << 4);
      if (s < 3) {
#pragma unroll
        for (int i = 0; i < 2; ++i) hf[(s + 1) & 1][i] = *(const bf16x8*)(ba + (wm * 64 + i * 32 + r) * 128 + co);
      }
#pragma unroll
      for (int j = 0; j < NJ; ++j) {
        acc[0][j] = MFMA(hf[s & 1][0], wf[j], acc[0][j]);
        acc[1][j] = MFMA(hf[s & 1][1], wf[j], acc[1][j]);
        if (s < 3) wf[j] = *(const bf16x8*)(bb + (wn * 32 * NJ + j * 32 + r) * 128 + co);
      }
      __builtin_amdgcn_sched_barrier(0);
    }
    if (kt + 1 < 16) {
      WAIT_VM(0);
      GM_PARK((kt + 1) & 1)
    }
    __syncthreads();
  }
#undef GM_ISSUE
#undef GM_PARK
}

DI float silu(float x) { return x * __builtin_amdgcn_rcpf(1.f + __expf(-x)); }

DI float dpp_x1(float v) { return __int_as_float(__builtin_amdgcn_update_dpp(0, __float_as_int(v), 0xB1, 0xF, 0xF, true)); }
DI float dpp_x8(float v) { return __int_as_float(__builtin_amdgcn_update_dpp(0, __float_as_int(v), 0x128, 0xF, 0xF, true)); }
DI void store_bf16_tile(const f32x16& a, u16* base  , size_t ld, int h, int odd) {
#pragma unroll
  for (int g = 0; g < 4; ++g)
#pragma unroll
    for (int e = 0; e < 4; e += 2) {
      const float v0 = a[4 * g + e], v1 = a[4 * g + e + 1];
      const float n0 = dpp_x1(v0), n1 = dpp_x1(v1);
      const u32 o = odd ? pk2(n1, v1) : pk2(v0, n0);
      *(u32*)(base + (size_t)(8 * g + 4 * h + e + odd) * ld) = o;
      if (e == 2) __builtin_amdgcn_sched_barrier(0);
    }
}
template <int NJ, int sec>
DI void p1_tile(const Params& p, char* lds, int tm, int col0) {
  constexpr int WN = 32 * NJ;
  const u16* HN = (const u16*)(p.ws + WS_HN);
  const u16* WT = (const u16*)(p.ws + WS_WINT);
  const float2* RT = (const float2*)(p.ws + WS_ROPE);
  const int fbase = col0 & 511;
  const bool sample = (tm == 64);
  f32x16 acc[2][NJ];
  gemm_mainloop<NJ>(HN, WT, tm * 256, col0, lds, acc);
  int tid = threadIdx.x;
  asm volatile("" : "+v"(tid));
  const int lane = tid & 63, w = tid >> 6, wm = w >> 1, wn = w & 1;
  const int r = lane & 31, h = lane >> 5, odd = r & 1;
  const int tb = tm * 256 + wm * 64;
  const int fb = fbase + wn * WN;
  if (sec == 2 || sec == 6) {
#pragma unroll
    for (int i = 0; i < 2; ++i) {
      float* dbase = nullptr;
      {
        const int t0 = tb + i * 32;
        if (!sample) {
          const int b = t0 >> 13, s0 = t0 & 8191;
          if (sec == 6) dbase = p.out + O_BVP + (size_t)t0 * 512;
          else if (s0 >= 7680) dbase = p.out + O_AVP + ((size_t)(b * 512 + s0 - 7680)) * 512;
        } else {
          const int ts = t0 - NTOKP, b = ts >> 5;
          if (sec == 6) dbase = p.out + O_BVS + (size_t)ts * 512;
          else dbase = p.out + O_AVS + ((size_t)(b * 512 + 480)) * 512;
        }
      }
#pragma unroll
      for (int j = 0; j < NJ; ++j) {
        unsigned lo = (wn * WN + j * 32 + r) * 528 + (wm * 64 + i * 32 + 4 * h) * 2;
        asm volatile("" : "+v"(lo));
#pragma unroll
        for (int g = 0; g < 4; ++g) {
          const float v0 = acc[i][j][4 * g], v1 = acc[i][j][4 * g + 1], v2 = acc[i][j][4 * g + 2], v3 = acc[i][j][4 * g + 3];
          uint2 o; o.x = pk2(v0, v1); o.y = pk2(v2, v3);
          *(uint2*)(lds + lo + g * 16) = o;
          if (dbase) {
            unsigned off = (8 * g + 4 * h) * 512 + fb + j * 32 + r;
            asm volatile("" : "+v"(off));
            dbase[off] = v0; dbase[off + 512] = v1; dbase[off + 1024] = v2; dbase[off + 1536] = v3;
          }
          __builtin_amdgcn_sched_barrier(0);
        }
      }
    }
    __syncthreads();
    {
      u16* VT; size_t ldv;
      if (sec == 2) { VT = (u16*)(p.ws + (sample ? WS_VATS : WS_VAT)); ldv = sample ? 544 : 8192; }
      else { VT = (u16*)(p.ws + (sample ? WS_VBTS : WS_VBT)); ldv = sample ? 1056 : 8192; }
      const int sofs = sample ? (sec == 2 ? 512 : 1024) : 0;
#pragma unroll
      for (int it = 0; it < 4 * NJ; ++it) {
        const int id = it * 512 + tid, row = id >> 5, c = id & 31;
        const uint4 v = *(const uint4*)(lds + row * 528 + c * 16);
        const int fs = fbase + row;
        if (!sample) {
          const int t0 = tm * 256 + c * 8, b = t0 >> 13, s = t0 & 8191;
          *(uint4*)(VT + ((size_t)(b * 512 + fs)) * ldv + s) = v;
        } else {
          const int b = c >> 2, tt = (c & 3) * 8;
          *(uint4*)(VT + ((size_t)(b * 512 + fs)) * ldv + sofs + tt) = v;
        }
        if ((it & 3) == 3) __builtin_amdgcn_sched_barrier(0);
      }
    }
    __syncthreads();
  } else {
    if (sec == 4 || sec == 5) {
      const float sgn = (r & 8) ? 1.f : -1.f;
      const int pos0 = sample ? (1024 + 4 * h) : ((tb & 8191) + 4 * h);
      const float2* rt = RT + pos0 * 8 + (r & 7);
#pragma unroll
      for (int i = 0; i < 2; ++i)
#pragma unroll
        for (int g = 0; g < 4; ++g) {
          const int po = (sample ? 0 : i * 32) + 8 * g;
          float2 cs[4];
#pragma unroll
          for (int e = 0; e < 4; ++e) cs[e] = rt[(po + e) * 8];
          __builtin_amdgcn_sched_barrier(0);
#pragma unroll
          for (int j = 0; j < NJ; j += 2)
#pragma unroll
            for (int e = 0; e < 4; ++e) {
              const float x = acc[i][j][4 * g + e];
              const float xp = dpp_x8(x);
              if (r < 16) acc[i][j][4 * g + e] = x * cs[e].x + sgn * xp * cs[e].y;
            }
          __builtin_amdgcn_sched_barrier(0);
        }
    }
    if (sec == 3 || sec == 7) {
#pragma unroll
      for (int i = 0; i < 2; ++i)
#pragma unroll
        for (int j = 0; j < NJ; ++j)
#pragma unroll
          for (int e = 0; e < 16; ++e) acc[i][j][e] = silu(acc[i][j][e]);
    }
    u16* dst; size_t trow0;
    if (sec == 0) { dst = (u16*)(p.ws + WS_QA); trow0 = tb; }
    else if (sec == 3) { dst = (u16*)(p.ws + WS_GA); trow0 = tb; }
    else if (sec == 4) { dst = (u16*)(p.ws + WS_QB); trow0 = tb; }
    else if (sec == 7) { dst = (u16*)(p.ws + WS_GB); trow0 = tb; }
    else if (sec == 1) {
      if (!sample) { dst = (u16*)(p.ws + WS_KA); trow0 = tb; }
      else { dst = (u16*)(p.ws + WS_KAS); trow0 = (size_t)(wm * 2) * 544 + 512; }
    } else {
      if (!sample) { dst = (u16*)(p.ws + WS_KB); trow0 = tb; }
      else { dst = (u16*)(p.ws + WS_KBS); trow0 = (size_t)(wm * 2) * 1056 + 1024; }
    }
    const size_t istep = sample ? (sec == 1 ? 544 : (sec == 5 ? 1056 : 32)) : 32;
#pragma unroll
    for (int i = 0; i < 2; ++i)
#pragma unroll
      for (int j = 0; j < NJ; ++j)
        store_bf16_tile(acc[i][j], dst + (trow0 + i * istep) * 512 + fb + j * 32 + (r & ~1), 512, h, odd);
    if (sec == 1 || sec == 5) {
#pragma unroll
      for (int i = 0; i < 2; ++i) {
        float* d = nullptr;
        const int t0 = tb + i * 32;
        if (!sample) {
          const int b = t0 >> 13, s = t0 & 8191;
          if (sec == 5) d = p.out + O_BKP + (size_t)t0 * 512;
          else if (s >= 7680) d = p.out + O_AKP + ((size_t)(b * 512 + s - 7680)) * 512;
        } else {
          const int ts = t0 - NTOKP, b = ts >> 5;
          if (sec == 5) d = p.out + O_BKS + (size_t)ts * 512;
          else d = p.out + O_AKS + ((size_t)(b * 512 + 480)) * 512;
        }
        if (d) {
#pragma unroll
          for (int j = 0; j < NJ; ++j)
#pragma unroll
            for (int e = 0; e < 16; ++e) {
              d[(size_t)(8 * (e >> 2) + 4 * h + (e & 3)) * 512 + fb + j * 32 + r] = acc[i][j][e];
              if ((e & 3) == 3) __builtin_amdgcn_sched_barrier(0);
            }
        }
      }
    }
  }
}
template <int NJ>
DI void p1_dispatch(const Params& p, char* lds, int tm, int col0) {
  switch (col0 >> 9) {
    case 0: p1_tile<NJ, 0>(p, lds, tm, col0); break;
    case 1: p1_tile<NJ, 1>(p, lds, tm, col0); break;
    case 2: p1_tile<NJ, 2>(p, lds, tm, col0); break;
    case 3: p1_tile<NJ, 3>(p, lds, tm, col0); break;
    case 4: p1_tile<NJ, 4>(p, lds, tm, col0); break;
    case 5: p1_tile<NJ, 5>(p, lds, tm, col0); break;
    case 6: p1_tile<NJ, 6>(p, lds, tm, col0); break;
    default: p1_tile<NJ, 7>(p, lds, tm, col0); break;
  }
}
DI void phase1(const Params& p, char* lds) {
  for (int tile = blockIdx.x; tile < 1024; tile += gridDim.x) {
    const int k = tile >> 8, b = tile & 255, xcd = b & 7, idx = b >> 3;
    const int tm = 16 * k + (xcd >> 1) * 4 + (idx & 3), tn = (xcd & 1) * 8 + (idx >> 2);
    p1_dispatch<4>(p, lds, tm, tn * 256);
  }
}

constexpr float SM_C = 0.125f * 1.4426950408889634f;
template <int NQT, int DVT, bool BIAS>
DI void attn_wave(const u16* __restrict__ Q, int ldq, const u16* __restrict__ K, int ldk,
                  const u16* __restrict__ Vt, int ldv, int nkt, const float* bias_l2, int rel0,
                  f32x16 (&O)[NQT][DVT], float (&Mx)[NQT], float (&L)[NQT]) {
  const int lane = threadIdx.x & 63, r = lane & 31, h = lane >> 5;
  bf16x8 qf[NQT][4];
#pragma unroll
  for (int u = 0; u < NQT; ++u)
#pragma unroll
    for (int s = 0; s < 4; ++s) qf[u][s] = *(const bf16x8*)(Q + (size_t)(32 * u + r) * ldq + 16 * s + 8 * h);
#pragma unroll
  for (int u = 0; u < NQT; ++u) {
    Mx[u] = -INFINITY; L[u] = 0.f;
#pragma unroll
    for (int dt = 0; dt < DVT; ++dt)
#pragma unroll
      for (int e = 0; e < 16; ++e) O[u][dt][e] = 0.f;
  }
  const u16* kp = K + (size_t)rho(r) * ldk + 8 * h;
  const u16* vp = Vt + (size_t)r * ldv + 8 * h;
  bf16x8 kf[4];
#pragma unroll
  for (int s = 0; s < 4; ++s) kf[s] = *(const bf16x8*)(kp + 16 * s);
  for (int kt = 0; kt < nkt; ++kt) {
    bf16x8 vf[DVT][2];
#pragma unroll
    for (int dt = 0; dt < DVT; ++dt)
#pragma unroll
      for (int s2 = 0; s2 < 2; ++s2) vf[dt][s2] = *(const bf16x8*)(vp + (size_t)(32 * dt) * ldv + 32 * kt + 16 * s2);
    bf16x8 kn[4];
    {
      const int ktn = (kt + 1 < nkt) ? kt + 1 : kt;
#pragma unroll
      for (int s = 0; s < 4; ++s) kn[s] = *(const bf16x8*)(kp + (size_t)(32 * ktn) * ldk + 16 * s);
    }
    bf16x8 pf[NQT][2];
#pragma unroll
    for (int u = 0; u < NQT; ++u) {
      f32x16 S;
#pragma unroll
      for (int e = 0; e < 16; ++e) S[e] = 0.f;
#pragma unroll
      for (int s = 0; s < 4; ++s) S = MFMA(kf[s], qf[u][s], S);
      float t[16];
      if (BIAS) {
        const int relb = rel0 + 32 * u + r - 32 * kt - 8 * h;
        if (rel0 - 32 * kt - 31 >= 128) {
          const float bv = bias_l2[256];
#pragma unroll
          for (int e = 0; e < 16; ++e) t[e] = S[e] * SM_C + bv;
        } else {
#pragma unroll
          for (int e = 0; e < 16; ++e) {
            int rel = relb - ((e & 7) + 16 * (e >> 3));
            rel = rel < -128 ? -128 : (rel > 128 ? 128 : rel);
            t[e] = S[e] * SM_C + bias_l2[rel + 128];
          }
        }
      } else {
#pragma unroll
        for (int e = 0; e < 16; ++e) t[e] = S[e] * SM_C;
      }
      float mx = t[0];
#pragma unroll
      for (int e = 1; e < 16; ++e) mx = fmaxf(mx, t[e]);
      mx = fmaxf(mx, __shfl_xor(mx, 32));
      if (__any(mx > Mx[u] + 8.f)) {
        const float mn = fmaxf(Mx[u], mx);
        const float al = __builtin_amdgcn_exp2f(Mx[u] - mn);
        Mx[u] = mn; L[u] *= al;
#pragma unroll
        for (int dt = 0; dt < DVT; ++dt)
#pragma unroll
          for (int e = 0; e < 16; ++e) O[u][dt][e] *= al;
      }
      float ps = 0.f;
#pragma unroll
      for (int e = 0; e < 16; ++e) { t[e] = __builtin_amdgcn_exp2f(t[e] - Mx[u]); ps += t[e]; }
      L[u] += ps;
#pragma unroll
      for (int s2 = 0; s2 < 2; ++s2) {
        uint4 pk;
        pk.x = pk2(t[8 * s2], t[8 * s2 + 1]); pk.y = pk2(t[8 * s2 + 2], t[8 * s2 + 3]);
        pk.z = pk2(t[8 * s2 + 4], t[8 * s2 + 5]); pk.w = pk2(t[8 * s2 + 6], t[8 * s2 + 7]);
        pf[u][s2] = __builtin_bit_cast(bf16x8, pk);
      }
    }
#pragma unroll
    for (int u = 0; u < NQT; ++u)
#pragma unroll
      for (int dt = 0; dt < DVT; ++dt)
#pragma unroll
        for (int s2 = 0; s2 < 2; ++s2) O[u][dt] = MFMA(vf[dt][s2], pf[u][s2], O[u][dt]);
#pragma unroll
    for (int s = 0; s < 4; ++s) kf[s] = kn[s];
  }
#pragma unroll
  for (int u = 0; u < NQT; ++u) L[u] += __shfl_xor(L[u], 32);
}

template <int NQT>
DI void attnA_item(const Params& p, const u16* Q, const u16* K, const u16* Vt, int ldv, int nkt, int rel0,
                   const float* bias_l2, int tok0, int head) {
  f32x16 O[NQT][2]; float Mx[NQT], L[NQT];
  attn_wave<NQT, 2, true>(Q, 512, K, 512, Vt, ldv, nkt, bias_l2, rel0, O, Mx, L);
  const int lane = threadIdx.x & 63, r = lane & 31, h = lane >> 5;
  const u16* GA = (const u16*)(p.ws + WS_GA);
  u16* OB = (u16*)(p.ws + WS_HN);
#pragma unroll
  for (int u = 0; u < NQT; ++u) {
    const float inv = 1.f / L[u];
    const size_t tok = (size_t)(tok0 + 32 * u + r);
#pragma unroll
    for (int dt = 0; dt < 2; ++dt)
#pragma unroll
      for (int g = 0; g < 4; ++g) {
        const int dv = 32 * dt + 8 * g + 4 * h;
        const uint2 gg = *(const uint2*)(GA + tok * 512 + head * 64 + dv);
        uint2 o;
        o.x = pk2(O[u][dt][4 * g] * inv * bflo(gg.x), O[u][dt][4 * g + 1] * inv * bfhi(gg.x));
        o.y = pk2(O[u][dt][4 * g + 2] * inv * bflo(gg.y), O[u][dt][4 * g + 3] * inv * bfhi(gg.y));
        *(uint2*)(OB + tok * 1024 + head * 64 + dv) = o;
      }
  }
}

DI void attnB_epilogue(const Params& p, f32x16 (&O)[4], float Lsum, int tok0, int hb, float lam, float* xch) {
  const int lane = threadIdx.x & 63, r = lane & 31, h = lane >> 5, w = threadIdx.x >> 6, m = w >> 2, wsub = w & 3;
  const float inv = 1.f / Lsum;
  float* xw = xch + wsub * 4096 + lane;
  if (m == 1) {
    const float sc = inv * lam;
#pragma unroll
    for (int dt = 0; dt < 4; ++dt)
#pragma unroll
      for (int e = 0; e < 16; ++e) xw[(dt * 16 + e) * 64] = O[dt][e] * sc;
  }
  __syncthreads();
  if (m == 0) {
    float ss = 0.f;
#pragma unroll
    for (int dt = 0; dt < 4; ++dt)
#pragma unroll
      for (int e = 0; e < 16; ++e) { float o = O[dt][e] * inv - xw[(dt * 16 + e) * 64]; O[dt][e] = o; ss += o * o; }
    ss += __shfl_xor(ss, 32);
    const float rn = rsqrtf(ss * (1.f / 128.f) + 1e-6f) * 0.8f;
    const u16* GB = (const u16*)(p.ws + WS_GB);
    u16* OB = (u16*)(p.ws + WS_HN);
    const size_t tok = (size_t)(tok0 + r);
#pragma unroll
    for (int dt = 0; dt < 4; ++dt)
#pragma unroll
      for (int g = 0; g < 4; ++g) {
        const int dv = 32 * dt + 8 * g + 4 * h;
        const uint2 gg = *(const uint2*)(GB + tok * 512 + hb * 128 + dv);
        const float4 sg = *(const float4*)(p.subln + dv);
        uint2 o;
        o.x = pk2(O[dt][4 * g] * rn * sg.x * bflo(gg.x), O[dt][4 * g + 1] * rn * sg.y * bfhi(gg.x));
        o.y = pk2(O[dt][4 * g + 2] * rn * sg.z * bflo(gg.y), O[dt][4 * g + 3] * rn * sg.w * bfhi(gg.y));
        *(uint2*)(OB + tok * 1024 + 512 + hb * 128 + dv) = o;
      }
  }
  __syncthreads();
}

DI void attnB_item(const Params& p, const u16* Q, const u16* K, const u16* Vt, int ldv, int nkt, int tok0, int hb,
                   float lam, float* xch) {
  f32x16 O[1][4]; float Mx[1], L[1];
  attn_wave<1, 4, false>(Q, 512, K, 512, Vt, ldv, nkt, nullptr, 0, O, Mx, L);
  attnB_epilogue(p, O[0], L[0], tok0, hb, lam, xch);
}

typedef float f2 __attribute__((ext_vector_type(2)));
constexpr int BLK_V = 0, BLK_K = 49152, BLK_XCH = 81920, LDS_BIAS = 147456;
DI float half_max(float v) {
  auto rr = __builtin_amdgcn_permlane32_swap(__float_as_uint(v), __float_as_uint(v), false, false);
  return fmaxf(__uint_as_float(rr[0]), __uint_as_float(rr[1]));
}
DI void attnB_block(const Params& p, int b, int hb, int qt, float lam, char* lds) {
  int tid = threadIdx.x;
  asm volatile("" : "+v"(tid));
  const int lane = tid & 63, r = lane & 31, h = lane >> 5, w = tid >> 6, m = w >> 2, wsub = w & 3;
  constexpr bool late = false;
  const int q0 = qt * 128 + wsub * 32;
  const int nt = 2 * qt + 2;
  const int my_nt = (q0 >> 6) + 1;
  uint4 qraw[4];
  {
    const u16* Q = (const u16*)(p.ws + WS_QB) + (size_t)(b * SEQ + q0 + r) * 512 + hb * 128 + m * 64 + 8 * h;
#pragma unroll
    for (int s = 0; s < 4; ++s) gld16(qraw[s], Q + 16 * s);
  }
  f32x16 O[4];
#pragma unroll
  for (int dt = 0; dt < 4; ++dt)
#pragma unroll
    for (int e = 0; e < 16; ++e) O[dt][e] = 0.f;
  float Mx = -INFINITY;
  f2 L2 = {0.f, 0.f};
  const u16* gk = (const u16*)(p.ws + WS_KB) + (size_t)(b * SEQ + (tid >> 4)) * 512 + hb * 128 + (tid & 15) * 8;
  const u16* gv = (const u16*)(p.ws + WS_VBT) + (size_t)(b * 512 + hb * 128 + (tid >> 3)) * SEQ + (tid & 7) * 8;
  const int lk = BLK_K + ((tid >> 3) & 1) * 8192 + (tid >> 4) * 128 + ((((tid & 7) ^ ((tid >> 5) & 7))) << 4);
  const int lv = BLK_V + (tid >> 3) * 128 + ((((tid & 7) ^ ((tid >> 4) & 7))) << 4);
  const int rr = rho(r);
  const int swk = (rr >> 1) & 7, swv = (r >> 1) & 7;
  uint4 sk0, sk1, sv0, sv1;
  gld16(sk0, gk); gld16(sk1, gk + (size_t)32 * 512);
  gld16(sv0, gv); gld16(sv1, gv + (size_t)64 * SEQ);
  wait_vm0();
  *(uint4*)(lds + lk) = sk0; *(uint4*)(lds + lk + 4096) = sk1;
  *(uint4*)(lds + lv) = sv0; *(uint4*)(lds + lv + 8192) = sv1;
  bf16x8 qf[4];
#pragma unroll
  for (int s = 0; s < 4; ++s) qf[s] = __builtin_bit_cast(bf16x8, qraw[s]);
  bf16x8 pf[4];
#pragma unroll
  for (int s = 0; s < 4; ++s) pf[s] = qf[s];
  __syncthreads();
  int vs = 0;
  for (int t = 0; t < nt; ++t) {
    if (t + 1 < nt) {
      gld16(sk0, gk + (size_t)(64 * (t + 1)) * 512);
      gld16(sk1, gk + (size_t)(64 * (t + 1) + 32) * 512);
      gld16(sv0, gv + 64 * (t + 1));
      gld16(sv1, gv + (size_t)64 * SEQ + 64 * (t + 1));
    }
    __builtin_amdgcn_sched_barrier(0);
    if (late && t >= 1 && t - 1 < my_nt) {
      const char* vb = lds + BLK_V + (vs == 0 ? 2 : vs - 1) * 16384;
#pragma unroll
      for (int ks = 0; ks < 4; ++ks) {
        const int co = (((2 * ks + h) ^ swv) << 4);
#pragma unroll
        for (int dt = 0; dt < 4; ++dt) {
          bf16x8 v = *(const bf16x8*)(vb + (32 * dt + r) * 128 + co);
          O[dt] = MFMA(v, pf[ks], O[dt]);
        }
      }
    }
    if (t < my_nt && t < nt) {
      const char* kb = lds + BLK_K + (t & 1) * 16384 + m * 8192;
      f32x16 S0, S1;
#pragma unroll
      for (int e = 0; e < 16; ++e) { S0[e] = 0.f; S1[e] = 0.f; }
      bf16x8 ka[4], kc[4];
#pragma unroll
      for (int s = 0; s < 4; ++s) {
        const int co = (((2 * s + h) ^ swk) << 4);
        ka[s] = *(const bf16x8*)(kb + rr * 128 + co);
        kc[s] = *(const bf16x8*)(kb + (32 + rr) * 128 + co);
      }
#pragma unroll
      for (int s = 0; s < 4; ++s) {
        S0 = MFMA(ka[s], qf[s], S0);
        S1 = MFMA(kc[s], qf[s], S1);
      }
      f2 tv[16];
      const f2 cc = {SM_C, SM_C};
#pragma unroll
      for (int e = 0; e < 8; ++e) {
        f2 a = {S0[2 * e], S0[2 * e + 1]}; tv[e] = a * cc;
        f2 c = {S1[2 * e], S1[2 * e + 1]}; tv[8 + e] = c * cc;
      }
      float mx = fmaxf(tv[0].x, tv[0].y);
#pragma unroll
      for (int e = 1; e < 16; ++e) mx = fmaxf(mx, fmaxf(tv[e].x, tv[e].y));
      mx = half_max(mx);
      if (__any(mx > Mx + 8.f)) {
        const float mn = fmaxf(Mx, mx);
        const float al = __builtin_amdgcn_exp2f(Mx - mn);
        Mx = mn; L2 *= al;
#pragma unroll
        for (int dt = 0; dt < 4; ++dt)
#pragma unroll
          for (int e = 0; e < 16; ++e) O[dt][e] *= al;
      }
      const f2 nm = {-Mx, -Mx};
#pragma unroll
      for (int e = 0; e < 16; ++e) {
        f2 d = tv[e] + nm;
        d.x = __builtin_amdgcn_exp2f(d.x); d.y = __builtin_amdgcn_exp2f(d.y);
        L2 += d;
        tv[e] = d;
      }
#pragma unroll
      for (int s2 = 0; s2 < 4; ++s2) {
        uint4 pa;
        pa.x = pk2(tv[4 * s2].x, tv[4 * s2].y); pa.y = pk2(tv[4 * s2 + 1].x, tv[4 * s2 + 1].y);
        pa.z = pk2(tv[4 * s2 + 2].x, tv[4 * s2 + 2].y); pa.w = pk2(tv[4 * s2 + 3].x, tv[4 * s2 + 3].y);
        pf[s2] = __builtin_bit_cast(bf16x8, pa);
      }
      if (!late) {
        const char* vb = lds + BLK_V + vs * 16384;
#pragma unroll
        for (int ks = 0; ks < 4; ++ks) {
          const int co = (((2 * ks + h) ^ swv) << 4);
#pragma unroll
          for (int dt = 0; dt < 4; ++dt) {
            bf16x8 v = *(const bf16x8*)(vb + (32 * dt + r) * 128 + co);
            O[dt] = MFMA(v, pf[ks], O[dt]);
          }
        }
      }
    }
    if (t + 1 < nt) {
      const int vn = (vs == 2 ? 0 : vs + 1);
      wait_vm0();
      *(uint4*)(lds + lk + ((t + 1) & 1) * 16384) = sk0; *(uint4*)(lds + lk + ((t + 1) & 1) * 16384 + 4096) = sk1;
      *(uint4*)(lds + lv + vn * 16384) = sv0; *(uint4*)(lds + lv + vn * 16384 + 8192) = sv1;
    }
    vs = (vs == 2 ? 0 : vs + 1);
    __syncthreads();
  }
  float L = L2.x + L2.y;
  L += __shfl_xor(L, 32);
  attnB_epilogue(p, O, L, b * SEQ + q0, hb, lam, (float*)(lds + BLK_XCH));
}

DI float phase2_setup(const Params& p, char* lds) {
  const int tid = threadIdx.x, lane = tid & 63;
  float* bias = (float*)(lds + LDS_BIAS);
  for (int i = tid; i < 8 * 257; i += 512) { int hh = i / 257, k = i - hh * 257; bias[hh * 260 + k] = p.rel_bias[i] * 1.4426950408889634f; }
  float a = p.lq1[lane] * p.lk1[lane], b = p.lq2[lane] * p.lk2[lane];
  a = wave_sum(a); b = wave_sum(b);
  __syncthreads();
  return expf(a) - expf(b) + 0.2f;
}
DI void p3_tile(const Params& p, char* lds, int tok0) {
  int tid = threadIdx.x;
  asm volatile("" : "+v"(tid));
  const int lane = tid & 63, w = tid >> 6, r = lane & 31, h = lane >> 5;
  const u16* OB = (const u16*)(p.ws + WS_HN);
  float* red = (float*)(lds + 131072);
  __syncthreads();
#pragma unroll
  for (int half = 0; half < 2; ++half) {
    uint4 a[8];
#pragma unroll
    for (int it = 0; it < 8; ++it) a[it] = *(const uint4*)(OB + (size_t)(tok0 + half * 32 + it * 4 + (tid >> 7)) * 1024 + (tid & 127) * 8);
#pragma unroll
    for (int it = 0; it < 8; ++it) {
      const int row = half * 32 + it * 4 + (tid >> 7);
      *(uint4*)(lds + row * 2048 + ((((tid & 127) ^ (row & 15))) << 4)) = a[it];
    }
  }
  f32x16 acc[2][4];
#pragma unroll
  for (int i = 0; i < 2; ++i)
#pragma unroll
    for (int j = 0; j < 4; ++j)
#pragma unroll
      for (int e = 0; e < 16; ++e) acc[i][j][e] = 0.f;
  const char* wp = p.ws + WS_WOUTT + ((size_t)(w * 4) * 4096 + lane) * 16;
  const char* ap = lds + r * 2048;
  const int akey = r & 15;
  uint4 bq[2][4];
#pragma unroll
  for (int s = 0; s < 2; ++s)
#pragma unroll
    for (int j = 0; j < 4; ++j) gld16(bq[s][j], wp + (size_t)(j * 4096 + s * 64) * 16);
  __syncthreads();
#define P3_KSTEP(KS, SLOT, WAITN, REFILL)                                                        \
  {                                                                                              \
    const int co_ = ((((2 * (KS) + h) ^ akey)) << 4);                                            \
    const bf16x8 a0_ = *(const bf16x8*)(ap + co_);                                               \
    const bf16x8 a1_ = *(const bf16x8*)(ap + 65536 + co_);                                       \
    WAIT_VM(WAITN);                                                                              \
    __builtin_amdgcn_sched_barrier(0);                                                           \
    _Pragma("unroll") for (int j = 0; j < 4; ++j) {                                              \
      const bf16x8 bf_ = __builtin_bit_cast(bf16x8, bq[SLOT][j]);                                \
      acc[0][j] = MFMA(a0_, bf_, acc[0][j]);                                                     \
      acc[1][j] = MFMA(a1_, bf_, acc[1][j]);                                                     \
    }                                                                                            \
    __builtin_amdgcn_sched_barrier(0);                                                           \
    if (REFILL) {                                                                                \
      _Pragma("unroll") for (int j = 0; j < 4; ++j) gld16(bq[SLOT][j], wp + (size_t)(j * 4096 + ((KS) + 2) * 64) * 16); \
    }                                                                                            \
    __builtin_amdgcn_sched_barrier(0);                                                           \
  }
#pragma unroll 1
  for (int g = 0; g < 31; ++g) {
    P3_KSTEP(2 * g, 0, 4, true)
    P3_KSTEP(2 * g + 1, 1, 4, true)
  }
  P3_KSTEP(62, 0, 4, false)
  P3_KSTEP(63, 1, 0, false)
  WAIT_VM(0);
  const float* xr = tok0 < NTOKP ? p.x_prompt + (size_t)tok0 * 1024 : p.x_sample + (size_t)(tok0 - NTOKP) * 1024;
  const unsigned cb = w * 128 + r;
#pragma unroll
  for (int i = 0; i < 2; ++i) {
#pragma unroll
    for (int e = 0; e < 16; ++e) {
      const int row = 32 * i + 8 * (e >> 2) + 4 * h + (e & 3);
      unsigned off = row * 1024 + cb;
      asm volatile("" : "+v"(off));
      float ssv = 0.f;
#pragma unroll
      for (int j = 0; j < 4; ++j) {
        const float y = acc[i][j][e] + xr[off + j * 32];
        acc[i][j][e] = y; ssv += y * y;
      }
      ssv += __shfl_xor(ssv, 1); ssv += __shfl_xor(ssv, 2); ssv += __shfl_xor(ssv, 4); ssv += __shfl_xor(ssv, 8); ssv += __shfl_xor(ssv, 16);
      if (r == 0) red[w * 64 + row] = ssv;
      if ((e & 3) == 3) __builtin_amdgcn_sched_barrier(0);
    }
  }
  __syncthreads();
  if (tid < 64) {
    float t = 0.f;
#pragma unroll
    for (int k = 0; k < 8; ++k) t += red[k * 64 + tid];
    red[512 + tid] = rsqrtf(t * (1.f / 1024.f) + 1e-6f);
  }
  __syncthreads();
  float* yr = p.out + O_YP + (size_t)tok0 * 1024;
  float gj[4];
#pragma unroll
  for (int j = 0; j < 4; ++j) gj[j] = p.final_gain[cb + j * 32];
#pragma unroll
  for (int i = 0; i < 2; ++i) {
#pragma unroll
    for (int e = 0; e < 16; ++e) {
      const int row = 32 * i + 8 * (e >> 2) + 4 * h + (e & 3);
      unsigned off = row * 1024 + cb;
      asm volatile("" : "+v"(off));
      const float ri = red[512 + row];
#pragma unroll
      for (int j = 0; j < 4; ++j) yr[off + j * 32] = acc[i][j][e] * ri * gj[j];
      if ((e & 3) == 3) __builtin_amdgcn_sched_barrier(0);
    }
  }
}

constexpr int NQUEUE = 14;
DI int q_pop(unsigned* ctr, int* slot) {
  __syncthreads();
  if (threadIdx.x == 0) *slot = (int)__hip_atomic_fetch_add(ctr, 1u, __ATOMIC_RELAXED, __HIP_MEMORY_SCOPE_AGENT);
  __syncthreads();
  return *slot;
}
DI void p2_all(const Params& p, char* lds, float lam) {
  const int w = threadIdx.x >> 6;
  unsigned* Q = (unsigned*)(p.ws + WS_QUEUE);
  int* slot = (int*)(lds + LDS_BIAS + 8320);
  float* xch = (float*)(lds + 65536);
  const float* bias = (const float*)(lds + LDS_BIAS);
  const u16* QA = (const u16*)(p.ws + WS_QA);
  const u16* QB = (const u16*)(p.ws + WS_QB);
#pragma unroll 1
  for (;;) {
    const int i = q_pop(Q + 64 * 12, slot);
    if (i >= 32) break;
    p1_dispatch<2>(p, lds, 64, i * 128);
    asm volatile("s_waitcnt vmcnt(0)" ::: "memory");
    __syncthreads();
    if (threadIdx.x == 0) {
      __builtin_amdgcn_fence(__ATOMIC_RELEASE, "agent");
      __hip_atomic_fetch_add(Q + 64 * 13, 1u, __ATOMIC_RELAXED, __HIP_MEMORY_SCOPE_AGENT);
    }
  }
  {
    const int it = q_pop(Q, slot);
    if (it < 16) {
      if (threadIdx.x == 0) {
        while (__hip_atomic_load(Q + 64 * 13, __ATOMIC_RELAXED, __HIP_MEMORY_SCOPE_AGENT) < 32u) __builtin_amdgcn_s_sleep(2);
        __builtin_amdgcn_fence(__ATOMIC_ACQUIRE, "agent");
      }
      __syncthreads();
    }
    if (it < 8) {
      const int m = w >> 2, wsub = w & 3, id = it * 4 + wsub, b = id >> 2, hb = id & 3;
      attnB_item(p, QB + (size_t)(NTOKP + b * 32) * 512 + hb * 128 + m * 64,
                 (const u16*)(p.ws + WS_KBS) + (size_t)(b * 1056) * 512 + hb * 128 + m * 64,
                 (const u16*)(p.ws + WS_VBTS) + (size_t)(b * 512 + hb * 128) * 1056, 1056, 33, NTOKP + b * 32, hb, lam, xch);
    } else if (it < 16) {
      const int b = it - 8;
      attnA_item<1>(p, QA + (size_t)(NTOKP + b * 32) * 512 + w * 64,
                    (const u16*)(p.ws + WS_KAS) + (size_t)(b * 544) * 512 + w * 64,
                    (const u16*)(p.ws + WS_VATS) + (size_t)(b * 512 + w * 64) * 544, 544, 17, 512, bias + w * 260,
                    NTOKP + b * 32, w);
    }
    if (it < 16) {
      asm volatile("s_waitcnt vmcnt(0)" ::: "memory");
      __syncthreads();
      if (threadIdx.x == 0) {
        __builtin_amdgcn_fence(__ATOMIC_RELEASE, "agent");
        __hip_atomic_fetch_add(Q + 64 * 11, 1u, __ATOMIC_RELAXED, __HIP_MEMORY_SCOPE_AGENT);
      }
    }
  }
  bool didA = false;
  int k = 0;
#pragma unroll 1
  for (;;) {
    int i = q_pop(Q + 64 * (1 + ((blockIdx.x + k) & 7)), slot);
    if (i >= 64) { if (++k < 8) continue; i = -1; }
    if ((i < 0 || i >= 40) && !didA) {
      didA = true;
#pragma unroll 1
      for (;;) {
        const int it = q_pop(Q + 64 * 10, slot);
        if (it >= 4) break;
        if (threadIdx.x == 0) {
          while (__hip_atomic_load(Q + 64 * 11, __ATOMIC_RELAXED, __HIP_MEMORY_SCOPE_AGENT) < 16u) __builtin_amdgcn_s_sleep(2);
          __builtin_amdgcn_fence(__ATOMIC_ACQUIRE, "agent");
        }
        __syncthreads();
        p3_tile(p, lds, NTOKP + it * 64);
      }
#pragma unroll 1
      for (;;) {
        const int it = q_pop(Q + 64 * 9, slot);
        if (it >= 256) break;
        const int b = it >> 7, c = it & 127, cs = c > 8 ? c - 8 : 0;
        int tl = threadIdx.x;
        asm volatile("" : "+v"(tl));
        const int ww = tl >> 6;
        attnA_item<2>(p, (const u16*)(p.ws + WS_QA) + (size_t)(b * SEQ + c * 64) * 512 + ww * 64,
                      (const u16*)(p.ws + WS_KA) + (size_t)(b * SEQ + cs * 64) * 512 + ww * 64,
                      (const u16*)(p.ws + WS_VAT) + (size_t)(b * 512 + ww * 64) * SEQ + cs * 64, SEQ,
                      (c + 1 - cs) * 2, 64 * (c - cs), (const float*)(lds + LDS_BIAS) + ww * 260, b * SEQ + c * 64, ww);
      }
    }
    if (i < 0) break;
    const int x = (blockIdx.x + k) & 7;
    attnB_block(p, x >> 2, x & 3, 63 - i, lam, lds);
  }
}

DI void phase4(const Params& p) {
  const int lane = threadIdx.x & 63, w = threadIdx.x >> 6;
  for (int row = blockIdx.x * 8 + w; row < NTOK; row += gridDim.x * 8) {
    float* y = p.out + O_YP + (size_t)row * 1024;
    float4 v[4]; float ss = 0.f;
#pragma unroll
    for (int it = 0; it < 4; ++it) { v[it] = *(const float4*)(y + it * 256 + lane * 4); ss += v[it].x * v[it].x + v[it].y * v[it].y + v[it].z * v[it].z + v[it].w * v[it].w; }
    ss = wave_sum(ss);
    const float inv = rsqrtf(ss * (1.f / 1024.f) + 1e-6f);
#pragma unroll
    for (int it = 0; it < 4; ++it) {
      float4 g = *(const float4*)(p.final_gain + it * 256 + lane * 4);
      *(float4*)(y + it * 256 + lane * 4) = make_float4(v[it].x * inv * g.x, v[it].y * inv * g.y, v[it].z * inv * g.z, v[it].w * inv * g.w);
    }
  }
}

__global__ void __launch_bounds__(512) fwd_megakernel(Params p) {
  __shared__ __attribute__((aligned(16))) char lds[155904];
  cg::grid_group grid = cg::this_grid();
  unsigned* ctr = (unsigned*)(p.ws + WS_BAR);
  const unsigned G = gridDim.x;
  if (p.out == nullptr) grid.sync();
  phase0(p, lds);
  ctr_barrier(ctr, G);
  phase1(p, lds);
  ctr_barrier(ctr, 2 * G);
  {
    const float lam = phase2_setup(p, lds);
    p2_all(p, lds, lam);
  }
  ctr_barrier(ctr, 3 * G);
  for (int t = blockIdx.x; t < 256; t += gridDim.x) p3_tile(p, lds, t * 64);
}

extern "C" void kernel_launch(void* const* d_in, const int* in_sizes, int n_in, void* d_out, int out_size, void* d_ws,
                              size_t ws_size, hipStream_t stream) {
  static int grid_blocks = 0;
  if (!grid_blocks) {
    int dev = 0, cus = 0, per_cu = 0;
    hipGetDevice(&dev);
    hipDeviceGetAttribute(&cus, hipDeviceAttributeMultiprocessorCount, dev);
    hipOccupancyMaxActiveBlocksPerMultiprocessor(&per_cu, fwd_megakernel, 512, 0);
    if (per_cu < 1) per_cu = 1;
    grid_blocks = cus;
  }
  Params p{};
  p.x_prompt = (const float*)d_in[0]; p.x_sample = (const float*)d_in[1];
  p.cache_a_k = (const float*)d_in[2]; p.cache_a_v = (const float*)d_in[3];
  p.cache_b_k = (const float*)d_in[4]; p.cache_b_v = (const float*)d_in[5];
  p.norm_gain = (const float*)d_in[6]; p.w_in = (const float*)d_in[7]; p.w_out = (const float*)d_in[8];
  p.rel_bias = (const float*)d_in[9];
  p.lq1 = (const float*)d_in[10]; p.lk1 = (const float*)d_in[11]; p.lq2 = (const float*)d_in[12]; p.lk2 = (const float*)d_in[13];
  p.subln = (const float*)d_in[14]; p.final_gain = (const float*)d_in[15];
  p.out = (float*)d_out; p.ws = (char*)d_ws;
  void* args[] = {&p};
  (void)hipMemsetAsync((char*)d_ws + WS_BAR, 0, 12288, stream);
  hipError_t e = hipLaunchCooperativeKernel((void*)fwd_megakernel, dim3(grid_blocks), dim3(512), args, 0, stream);
  if (e != hipSuccess) fprintf(stderr, "cooperative launch failed: %s (grid %d)\n", hipGetErrorString(e), grid_blocks);
}
```

```cpp
#include <hip/hip_runtime.h>
#include <hip/hip_cooperative_groups.h>
#include <cstdio>
namespace cg = cooperative_groups;

typedef short bf16x8 __attribute__((ext_vector_type(8)));
typedef float f32x16 __attribute__((ext_vector_type(16)));
typedef __bf16 bf2_t __attribute__((ext_vector_type(2)));
typedef float f2_t __attribute__((ext_vector_type(2)));
typedef unsigned u32;
typedef unsigned short u16;
#define DI __device__ __forceinline__
#define MFMA(a, b, c) __builtin_amdgcn_mfma_f32_32x32x16_bf16((a), (b), (c), 0, 0, 0)

constexpr int NTOKP = 16384;
constexpr int NTOK = 16640;
constexpr int SEQ = 8192;
constexpr size_t O_YP = 0;
constexpr size_t O_AKP = 17039360, O_AVP = 17563648, O_BKP = 18087936, O_BVP = 26476544;
constexpr size_t O_AKS = 34865152, O_AVS = 36962304, O_BKS = 39059456, O_BVS = 39190528;
constexpr size_t WS_WINT = 0;
constexpr size_t WS_WOUTT = WS_WINT + 8388608;
constexpr size_t WS_HN = WS_WOUTT + 2097152;
constexpr size_t WS_QA = WS_HN + 34078720;
constexpr size_t WS_KA = WS_QA + 17039360;
constexpr size_t WS_KAS = WS_KA + 16777216;
constexpr size_t WS_VAT = WS_KAS + 4456448;
constexpr size_t WS_VATS = WS_VAT + 16777216;
constexpr size_t WS_GA = WS_VATS + 4456448;
constexpr size_t WS_QB = WS_GA + 17039360;
constexpr size_t WS_KB = WS_QB + 17039360;
constexpr size_t WS_KBS = WS_KB + 16777216;
constexpr size_t WS_VBT = WS_KBS + 8650752;
constexpr size_t WS_VBTS = WS_VBT + 16777216;
constexpr size_t WS_GB = WS_VBTS + 8650752;
constexpr size_t WS_ROPE = WS_GB + 17039360;
constexpr size_t WS_BAR = WS_ROPE + 524288;
constexpr size_t WS_QUEUE = WS_BAR + 4096;
constexpr size_t WS_END = WS_QUEUE + 8192;

struct Params {
  const float* x_prompt; const float* x_sample;
  const float* cache_a_k; const float* cache_a_v; const float* cache_b_k; const float* cache_b_v;
  const float* norm_gain; const float* w_in; const float* w_out; const float* rel_bias;
  const float* lq1; const float* lk1; const float* lq2; const float* lk2;
  const float* subln; const float* final_gain;
  float* out; char* ws;
};

DI u32 pk2(float a, float b) { f2_t v = {a, b}; bf2_t r = __builtin_convertvector(v, bf2_t); return __builtin_bit_cast(u32, r); }
DI float bflo(u32 v) { return __uint_as_float(v << 16); }
DI float bfhi(u32 v) { return __uint_as_float(v & 0xffff0000u); }
DI int rho(int r) { return (r & ~12) | ((r & 4) << 1) | ((r & 8) >> 1); }
DI void gld16(uint4& dst, const void* p) { asm volatile("global_load_dwordx4 %0, %1, off" : "=v"(dst) : "v"(p) : "memory"); }
#define WAIT_VM(n) asm volatile("s_waitcnt vmcnt(" #n ")" ::: "memory")
DI void wait_vm0() { asm volatile("s_waitcnt vmcnt(0)" ::: "memory"); }
DI float wave_sum(float v) {
#pragma unroll
  for (int o = 32; o > 0; o >>= 1) v += __shfl_xor(v, o);
  return v;
}


DI void ctr_barrier(unsigned* ctr, unsigned target) {
  __syncthreads();
  if (threadIdx.x == 0) {
    __builtin_amdgcn_fence(__ATOMIC_RELEASE, "agent");
    __hip_atomic_fetch_add(ctr, 1u, __ATOMIC_RELAXED, __HIP_MEMORY_SCOPE_AGENT);
    while (__hip_atomic_load(ctr, __ATOMIC_RELAXED, __HIP_MEMORY_SCOPE_AGENT) < target) __builtin_amdgcn_s_sleep(1);
    __builtin_amdgcn_fence(__ATOMIC_ACQUIRE, "agent");
  }
  __syncthreads();
}

DI void phase0(const Params& p, char* lds) {
  const int tid = threadIdx.x, bid = blockIdx.x, nb = gridDim.x;
  const int lane = tid & 63, w = tid >> 6;
  float* tile = (float*)lds;
  for (int i = bid * 512 + tid; i < 131072; i += nb * 512) {
    const int ln = i & 63, s_ = (i >> 6) & 63, ct = i >> 12, r_ = ln & 31, h_ = ln >> 5;
    float v[8];
#pragma unroll
    for (int j = 0; j < 8; ++j) v[j] = p.w_out[(size_t)(16 * s_ + 8 * h_ + j) * 1024 + ct * 32 + r_];
    uint4 o; o.x = pk2(v[0], v[1]); o.y = pk2(v[2], v[3]); o.z = pk2(v[4], v[5]); o.w = pk2(v[6], v[7]);
    *(uint4*)(p.ws + WS_WOUTT + (size_t)i * 16) = o;
  }
  for (int t = bid; t < 1024; t += nb) {
    const float* W; u16* WT; int N, kt, nt;
    { W = p.w_in; WT = (u16*)(p.ws + WS_WINT); N = 4096; kt = t >> 6; nt = t & 63; }
#pragma unroll
    for (int it = 0; it < 8; ++it) {
      int idx = it * 512 + tid, kk = idx >> 6, nn = idx & 63;
      tile[kk * 65 + nn] = W[(size_t)(kt * 64 + kk) * N + nt * 64 + nn];
    }
    __syncthreads();
    {
      int n = tid >> 3, kg = tid & 7;
      float v[8];
#pragma unroll
      for (int j = 0; j < 8; ++j) v[j] = tile[(kg * 8 + j) * 65 + n];
      uint4 o; o.x = pk2(v[0], v[1]); o.y = pk2(v[2], v[3]); o.z = pk2(v[4], v[5]); o.w = pk2(v[6], v[7]);
      *(uint4*)(WT + (size_t)(nt * 64 + n) * 1024 + kt * 64 + kg * 8) = o;
    }
    __syncthreads();
  }
  {
    u16* HN = (u16*)(p.ws + WS_HN);
    for (int row = bid * 8 + w; row < NTOK; row += nb * 16) {
      const int row1 = row + nb * 8 < NTOK ? row + nb * 8 : row;
      const float* s0 = row < NTOKP ? p.x_prompt + (size_t)row * 1024 : p.x_sample + (size_t)(row - NTOKP) * 1024;
      const float* s1 = row1 < NTOKP ? p.x_prompt + (size_t)row1 * 1024 : p.x_sample + (size_t)(row1 - NTOKP) * 1024;
      float4 v[4], u[4]; float ss = 0.f, st = 0.f;
#pragma unroll
      for (int it = 0; it < 4; ++it) { v[it] = *(const float4*)(s0 + it * 256 + lane * 4); u[it] = *(const float4*)(s1 + it * 256 + lane * 4); }
#pragma unroll
      for (int it = 0; it < 4; ++it) {
        ss += v[it].x * v[it].x + v[it].y * v[it].y + v[it].z * v[it].z + v[it].w * v[it].w;
        st += u[it].x * u[it].x + u[it].y * u[it].y + u[it].z * u[it].z + u[it].w * u[it].w;
      }
      ss = wave_sum(ss); st = wave_sum(st);
      const float inv = rsqrtf(ss * (1.f / 1024.f) + 1e-6f), inu = rsqrtf(st * (1.f / 1024.f) + 1e-6f);
#pragma unroll
      for (int it = 0; it < 4; ++it) {
        float4 g = *(const float4*)(p.norm_gain + it * 256 + lane * 4);
        uint2 o; o.x = pk2(v[it].x * inv * g.x, v[it].y * inv * g.y); o.y = pk2(v[it].z * inv * g.z, v[it].w * inv * g.w);
        *(uint2*)(HN + (size_t)row * 1024 + it * 256 + lane * 4) = o;
        o.x = pk2(u[it].x * inu * g.x, u[it].y * inu * g.y); o.y = pk2(u[it].z * inu * g.z, u[it].w * inu * g.w);
        *(uint2*)(HN + (size_t)row1 * 1024 + it * 256 + lane * 4) = o;
      }
    }
  }
  const int gt = bid * 512 + tid, gn = nb * 512;
  {
    u16* KAS = (u16*)(p.ws + WS_KAS);
#pragma unroll 4
    for (int i = gt; i < 524288; i += gn) {
      int e = i * 4, b = e >> 18, key = (e >> 9) & 511, f = e & 511;
      float4 v = *(const float4*)(p.cache_a_k + e);
      uint2 o; o.x = pk2(v.x, v.y); o.y = pk2(v.z, v.w);
      *(uint2*)(KAS + (size_t)(b * 544 + key) * 512 + f) = o;
      if (key >= 32) *(float4*)(p.out + O_AKS + (size_t)(b * 512 + key - 32) * 512 + f) = v;
    }
    u16* KBS = (u16*)(p.ws + WS_KBS);
#pragma unroll 4
    for (int i = gt; i < 1048576; i += gn) {
      int e = i * 4, b = e >> 19, key = (e >> 9) & 1023, f = e & 511;
      float4 v = *(const float4*)(p.cache_b_k + e);
      uint2 o; o.x = pk2(v.x, v.y); o.y = pk2(v.z, v.w);
      *(uint2*)(KBS + (size_t)(b * 1056 + key) * 512 + f) = o;
    }
    u16* VATS = (u16*)(p.ws + WS_VATS);
#pragma unroll 2
    for (int i = gt; i < 262144; i += gn) {
      int f = i & 511, kg = (i >> 9) & 63, b = i >> 15;
      float v[8];
#pragma unroll
      for (int j = 0; j < 8; ++j) v[j] = p.cache_a_v[(size_t)(b * 512 + kg * 8 + j) * 512 + f];
      uint4 o; o.x = pk2(v[0], v[1]); o.y = pk2(v[2], v[3]); o.z = pk2(v[4], v[5]); o.w = pk2(v[6], v[7]);
      *(uint4*)(VATS + (size_t)(b * 512 + f) * 544 + kg * 8) = o;
      if (kg >= 4) {
#pragma unroll
        for (int j = 0; j < 8; ++j) p.out[O_AVS + (size_t)(b * 512 + kg * 8 + j - 32) * 512 + f] = v[j];
      }
    }
    u16* VBTS = (u16*)(p.ws + WS_VBTS);
#pragma unroll 2
    for (int i = gt; i < 524288; i += gn) {
      int f = i & 511, kg = (i >> 9) & 127, b = i >> 16;
      float v[8];
#pragma unroll
      for (int j = 0; j < 8; ++j) v[j] = p.cache_b_v[(size_t)(b * 1024 + kg * 8 + j) * 512 + f];
      uint4 o; o.x = pk2(v[0], v[1]); o.y = pk2(v[2], v[3]); o.z = pk2(v[4], v[5]); o.w = pk2(v[6], v[7]);
      *(uint4*)(VBTS + (size_t)(b * 512 + f) * 1056 + kg * 8) = o;
    }
  }
  {
    float2* RT = (float2*)(p.ws + WS_ROPE);
    for (int i = gt; i < 65536; i += gn) {
      int pos = i >> 3, m = i & 7;
      float inv = powf(500000.f, -(float)m * 0.125f);
      float ang = (float)pos * inv;
      RT[i] = make_float2(cosf(ang), sinf(ang));
    }
  }
}

template <int NJ>
DI void gemm_mainloop(const u16* __restrict__ A, const u16* __restrict__ Bt, int row0, int col0, char* lds, f32x16 (&acc)[2][NJ]) {
  constexpr int STAGE = 32768 + NJ * 8192;
  int tid = threadIdx.x;
  asm volatile("" : "+v"(tid));
  const int lane = tid & 63, w = tid >> 6, wm = w >> 1, wn = w & 1;
  const int r = lane & 31, h = lane >> 5;
  const u16* pa = A + (size_t)(row0 + (tid >> 3)) * 1024 + (tid & 7) * 8;
  const u16* pb = Bt + (size_t)(col0 + (tid >> 3)) * 1024 + (tid & 7) * 8;
  const int wofs = (tid >> 3) * 128 + ((((tid & 7) ^ ((tid >> 4) & 7))) << 4);
  const int swr = (r >> 1) & 7;
#pragma unroll
  for (int i = 0; i < 2; ++i)
#pragma unroll
    for (int j = 0; j < NJ; ++j)
#pragma unroll
      for (int e = 0; e < 16; ++e) acc[i][j][e] = 0.f;
  uint4 ra[4], rb[NJ];
#define GM_ISSUE(KB)                                                                          \
  { _Pragma("unroll") for (int it = 0; it < 4; ++it) gld16(ra[it], pa + (size_t)it * 65536 + (KB) * 64); \
    _Pragma("unroll") for (int it = 0; it < NJ; ++it) gld16(rb[it], pb + (size_t)it * 65536 + (KB) * 64); }
#define GM_PARK(ST)                                                                           \
  { char* bw_ = lds + (ST) * STAGE;                                                           \
    _Pragma("unroll") for (int it = 0; it < 4; ++it) *(uint4*)(bw_ + it * 8192 + wofs) = ra[it]; \
    _Pragma("unroll") for (int it = 0; it < NJ; ++it) *(uint4*)(bw_ + 32768 + it * 8192 + wofs) = rb[it]; }
  GM_ISSUE(0)
  WAIT_VM(0);
  GM_PARK(0)
  __syncthreads();
#pragma unroll 1
  for (int kt = 0; kt < 16; ++kt) {
    if (kt + 1 < 16) GM_ISSUE(kt + 1)
    __builtin_amdgcn_sched_barrier(0);
    const char* ba = lds + (kt & 1) * STAGE;
    const char* bb = ba + 32768;
    bf16x8 hf[2][2], wf[NJ];
    {
      const int co = ((h ^ swr) << 4);
#pragma unroll
      for (int i = 0; i < 2; ++i) hf[0][i] = *(const bf16x8*)(ba + (wm * 64 + i * 32 + r) * 128 + co);
#pragma unroll
      for (int j = 0; j < NJ; ++j) wf[j] = *(const bf16x8*)(bb + (wn * 32 * NJ + j * 32 + r) * 128 + co);
    }
#pragma unroll
    for (int s = 0; s < 4; ++s) {
      const int co = (((2 * (s + 1) + h) ^ swr) << 4);
      if (s < 3) {
#pragma unroll
        for (int i = 0; i < 2; ++i) hf[(s + 1) & 1][i] = *(const bf16x8*)(ba + (wm * 64 + i * 32 + r) * 128 + co);
      }
      __builtin_amdgcn_s_setprio(1);
#pragma unroll
      for (int j = 0; j < NJ; ++j) {
        acc[0][j] = MFMA(hf[s & 1][0], wf[j], acc[0][j]);
        acc[1][j] = MFMA(hf[s & 1][1], wf[j], acc[1][j]);
        if (s < 3) wf[j] = *(const bf16x8*)(bb + (wn * 32 * NJ + j * 32 + r) * 128 + co);
      }
      __builtin_amdgcn_s_setprio(0);
      __builtin_amdgcn_sched_barrier(0);
      if (kt + 1 < 16 && s == 1) {
        asm volatile("s_waitcnt vmcnt(%0)" :: "n"(NJ) : "memory");
        char* bw_ = lds + ((kt + 1) & 1) * STAGE;
#pragma unroll
        for (int it = 0; it < 4; ++it) *(uint4*)(bw_ + it * 8192 + wofs) = ra[it];
        __builtin_amdgcn_sched_barrier(0);
      }
      if (kt + 1 < 16 && s == 2) {
        WAIT_VM(0);
        char* bw_ = lds + ((kt + 1) & 1) * STAGE;
#pragma unroll
        for (int it = 0; it < NJ; ++it) *(uint4*)(bw_ + 32768 + it * 8192 + wofs) = rb[it];
        __builtin_amdgcn_sched_barrier(0);
      }
    }
    __syncthreads();
  }
#undef GM_ISSUE
#undef GM_PARK
}

DI float silu(float x) { return x * __builtin_amdgcn_rcpf(1.f + __expf(-x)); }

DI float dpp_x1(float v) { return __int_as_float(__builtin_amdgcn_update_dpp(0, __float_as_int(v), 0xB1, 0xF, 0xF, true)); }
DI float dpp_x8(float v) { return __int_as_float(__builtin_amdgcn_update_dpp(0, __float_as_int(v), 0x128, 0xF, 0xF, true)); }
DI void store_bf16_tile(const f32x16& a, u16* base  , size_t ld, int h, int odd) {
#pragma unroll
  for (int g = 0; g < 4; ++g)
#pragma unroll
    for (int e = 0; e < 4; e += 2) {
      const float v0 = a[4 * g + e], v1 = a[4 * g + e + 1];
      const float n0 = dpp_x1(v0), n1 = dpp_x1(v1);
      const u32 o = odd ? pk2(n1, v1) : pk2(v0, n0);
      *(u32*)(base + (size_t)(8 * g + 4 * h + e + odd) * ld) = o;
      if (e == 2) __builtin_amdgcn_sched_barrier(0);
    }
}
template <int NJ, int sec>
DI void p1_tile(const Params& p, char* lds, int tm, int col0) {
  constexpr int WN = 32 * NJ;
  const u16* HN = (const u16*)(p.ws + WS_HN);
  const u16* WT = (const u16*)(p.ws + WS_WINT);
  const float2* RT = (const float2*)(p.ws + WS_ROPE);
  const int fbase = col0 & 511;
  const bool sample = (tm == 64);
  f32x16 acc[2][NJ];
  gemm_mainloop<NJ>(HN, WT, tm * 256, col0, lds, acc);
  int tid = threadIdx.x;
  asm volatile("" : "+v"(tid));
  const int lane = tid & 63, w = tid >> 6, wm = w >> 1, wn = w & 1;
  const int r = lane & 31, h = lane >> 5, odd = r & 1;
  const int tb = tm * 256 + wm * 64;
  const int fb = fbase + wn * WN;
  if (sec == 2 || sec == 6) {
#pragma unroll
    for (int i = 0; i < 2; ++i) {
      float* dbase = nullptr;
      {
        const int t0 = tb + i * 32;
        if (!sample) {
          const int b = t0 >> 13, s0 = t0 & 8191;
          if (sec == 6) dbase = p.out + O_BVP + (size_t)t0 * 512;
          else if (s0 >= 7680) dbase = p.out + O_AVP + ((size_t)(b * 512 + s0 - 7680)) * 512;
        } else {
          const int ts = t0 - NTOKP, b = ts >> 5;
          if (sec == 6) dbase = p.out + O_BVS + (size_t)ts * 512;
          else dbase = p.out + O_AVS + ((size_t)(b * 512 + 480)) * 512;
        }
      }
#pragma unroll
      for (int j = 0; j < NJ; ++j) {
        unsigned lo = (wn * WN + j * 32 + r) * 528 + (wm * 64 + i * 32 + 4 * h) * 2;
        asm volatile("" : "+v"(lo));
#pragma unroll
        for (int g = 0; g < 4; ++g) {
          const float v0 = acc[i][j][4 * g], v1 = acc[i][j][4 * g + 1], v2 = acc[i][j][4 * g + 2], v3 = acc[i][j][4 * g + 3];
          uint2 o; o.x = pk2(v0, v1); o.y = pk2(v2, v3);
          *(uint2*)(lds + lo + g * 16) = o;
          if (dbase) {
            unsigned off = (8 * g + 4 * h) * 512 + fb + j * 32 + r;
            asm volatile("" : "+v"(off));
            dbase[off] = v0; dbase[off + 512] = v1; dbase[off + 1024] = v2; dbase[off + 1536] = v3;
          }
          __builtin_amdgcn_sched_barrier(0);
        }
      }
    }
    __syncthreads();
    {
      u16* VT; size_t ldv;
      if (sec == 2) { VT = (u16*)(p.ws + (sample ? WS_VATS : WS_VAT)); ldv = sample ? 544 : 8192; }
      else { VT = (u16*)(p.ws + (sample ? WS_VBTS : WS_VBT)); ldv = sample ? 1056 : 8192; }
      const int sofs = sample ? (sec == 2 ? 512 : 1024) : 0;
#pragma unroll
      for (int it = 0; it < 4 * NJ; ++it) {
        const int id = it * 512 + tid, row = id >> 5, c = id & 31;
        const uint4 v = *(const uint4*)(lds + row * 528 + c * 16);
        const int fs = fbase + row;
        if (!sample) {
          const int t0 = tm * 256 + c * 8, b = t0 >> 13, s = t0 & 8191;
          *(uint4*)(VT + ((size_t)(b * 512 + fs)) * ldv + s) = v;
        } else {
          const int b = c >> 2, tt = (c & 3) * 8;
          *(uint4*)(VT + ((size_t)(b * 512 + fs)) * ldv + sofs + tt) = v;
        }
        if ((it & 3) == 3) __builtin_amdgcn_sched_barrier(0);
      }
    }
    __syncthreads();
  } else {
    if (sec == 4 || sec == 5) {
      const float sgn = (r & 8) ? 1.f : -1.f;
      const int pos0 = sample ? (1024 + 4 * h) : ((tb & 8191) + 4 * h);
      const float2* rt = RT + pos0 * 8 + (r & 7);
#pragma unroll
      for (int i = 0; i < 2; ++i)
#pragma unroll
        for (int g = 0; g < 4; ++g) {
          const int po = (sample ? 0 : i * 32) + 8 * g;
          float2 cs[4];
#pragma unroll
          for (int e = 0; e < 4; ++e) cs[e] = rt[(po + e) * 8];
          __builtin_amdgcn_sched_barrier(0);
#pragma unroll
          for (int j = 0; j < NJ; j += 2)
#pragma unroll
            for (int e = 0; e < 4; ++e) {
              const float x = acc[i][j][4 * g + e];
              const float xp = dpp_x8(x);
              if (r < 16) acc[i][j][4 * g + e] = x * cs[e].x + sgn * xp * cs[e].y;
            }
          __builtin_amdgcn_sched_barrier(0);
        }
    }
    if (sec == 3 || sec == 7) {
#pragma unroll
      for (int i = 0; i < 2; ++i)
#pragma unroll
        for (int j = 0; j < NJ; ++j)
#pragma unroll
          for (int e = 0; e < 16; ++e) acc[i][j][e] = silu(acc[i][j][e]);
    }
    u16* dst; size_t trow0;
    if (sec == 0) { dst = (u16*)(p.ws + WS_QA); trow0 = tb; }
    else if (sec == 3) { dst = (u16*)(p.ws + WS_GA); trow0 = tb; }
    else if (sec == 4) { dst = (u16*)(p.ws + WS_QB); trow0 = tb; }
    else if (sec == 7) { dst = (u16*)(p.ws + WS_GB); trow0 = tb; }
    else if (sec == 1) {
      if (!sample) { dst = (u16*)(p.ws + WS_KA); trow0 = tb; }
      else { dst = (u16*)(p.ws + WS_KAS); trow0 = (size_t)(wm * 2) * 544 + 512; }
    } else {
      if (!sample) { dst = (u16*)(p.ws + WS_KB); trow0 = tb; }
      else { dst = (u16*)(p.ws + WS_KBS); trow0 = (size_t)(wm * 2) * 1056 + 1024; }
    }
    const size_t istep = sample ? (sec == 1 ? 544 : (sec == 5 ? 1056 : 32)) : 32;
#pragma unroll
    for (int i = 0; i < 2; ++i)
#pragma unroll
      for (int j = 0; j < NJ; ++j)
        store_bf16_tile(acc[i][j], dst + (trow0 + i * istep) * 512 + fb + j * 32 + (r & ~1), 512, h, odd);
    if (sec == 1 || sec == 5) {
#pragma unroll
      for (int i = 0; i < 2; ++i) {
        float* d = nullptr;
        const int t0 = tb + i * 32;
        if (!sample) {
          const int b = t0 >> 13, s = t0 & 8191;
          if (sec == 5) d = p.out + O_BKP + (size_t)t0 * 512;
          else if (s >= 7680) d = p.out + O_AKP + ((size_t)(b * 512 + s - 7680)) * 512;
        } else {
          const int ts = t0 - NTOKP, b = ts >> 5;
          if (sec == 5) d = p.out + O_BKS + (size_t)ts * 512;
          else d = p.out + O_AKS + ((size_t)(b * 512 + 480)) * 512;
        }
        if (d) {
#pragma unroll
          for (int j = 0; j < NJ; ++j)
#pragma unroll
            for (int e = 0; e < 16; ++e) {
              d[(size_t)(8 * (e >> 2) + 4 * h + (e & 3)) * 512 + fb + j * 32 + r] = acc[i][j][e];
              if ((e & 3) == 3) __builtin_amdgcn_sched_barrier(0);
            }
        }
      }
    }
  }
}
template <int NJ>
DI void p1_dispatch(const Params& p, char* lds, int tm, int col0) {
  switch (col0 >> 9) {
    case 0: p1_tile<NJ, 0>(p, lds, tm, col0); break;
    case 1: p1_tile<NJ, 1>(p, lds, tm, col0); break;
    case 2: p1_tile<NJ, 2>(p, lds, tm, col0); break;
    case 3: p1_tile<NJ, 3>(p, lds, tm, col0); break;
    case 4: p1_tile<NJ, 4>(p, lds, tm, col0); break;
    case 5: p1_tile<NJ, 5>(p, lds, tm, col0); break;
    case 6: p1_tile<NJ, 6>(p, lds, tm, col0); break;
    default: p1_tile<NJ, 7>(p, lds, tm, col0); break;
  }
}
DI void phase1(const Params& p, char* lds) {
  for (int tile = blockIdx.x; tile < 1024; tile += gridDim.x) {
    const int k = tile >> 8, b = tile & 255, xcd = b & 7, idx = b >> 3;
    const int tm = 16 * k + (xcd >> 1) * 4 + (idx & 3), tn = (xcd & 1) * 8 + (idx >> 2);
    p1_dispatch<4>(p, lds, tm, tn * 256);
  }
}

constexpr float SM_C = 0.125f * 1.4426950408889634f;
template <int NQT, int DVT, bool BIAS>
DI void attn_wave(const u16* __restrict__ Q, int ldq, const u16* __restrict__ K, int ldk,
                  const u16* __restrict__ Vt, int ldv, int nkt, const float* bias_l2, int rel0,
                  f32x16 (&O)[NQT][DVT], float (&Mx)[NQT], float (&L)[NQT]) {
  const int lane = threadIdx.x & 63, r = lane & 31, h = lane >> 5;
  bf16x8 qf[NQT][4];
#pragma unroll
  for (int u = 0; u < NQT; ++u)
#pragma unroll
    for (int s = 0; s < 4; ++s) qf[u][s] = *(const bf16x8*)(Q + (size_t)(32 * u + r) * ldq + 16 * s + 8 * h);
#pragma unroll
  for (int u = 0; u < NQT; ++u) {
    Mx[u] = -INFINITY; L[u] = 0.f;
#pragma unroll
    for (int dt = 0; dt < DVT; ++dt)
#pragma unroll
      for (int e = 0; e < 16; ++e) O[u][dt][e] = 0.f;
  }
  const u16* kp = K + (size_t)rho(r) * ldk + 8 * h;
  const u16* vp = Vt + (size_t)r * ldv + 8 * h;
  bf16x8 kf[4];
#pragma unroll
  for (int s = 0; s < 4; ++s) kf[s] = *(const bf16x8*)(kp + 16 * s);
  for (int kt = 0; kt < nkt; ++kt) {
    bf16x8 vf[DVT][2];
#pragma unroll
    for (int dt = 0; dt < DVT; ++dt)
#pragma unroll
      for (int s2 = 0; s2 < 2; ++s2) vf[dt][s2] = *(const bf16x8*)(vp + (size_t)(32 * dt) * ldv + 32 * kt + 16 * s2);
    bf16x8 kn[4];
    {
      const int ktn = (kt + 1 < nkt) ? kt + 1 : kt;
#pragma unroll
      for (int s = 0; s < 4; ++s) kn[s] = *(const bf16x8*)(kp + (size_t)(32 * ktn) * ldk + 16 * s);
    }
    bf16x8 pf[NQT][2];
#pragma unroll
    for (int u = 0; u < NQT; ++u) {
      f32x16 S;
#pragma unroll
      for (int e = 0; e < 16; ++e) S[e] = 0.f;
#pragma unroll
      for (int s = 0; s < 4; ++s) S = MFMA(kf[s], qf[u][s], S);
      float t[16];
      if (BIAS) {
        const int relb = rel0 + 32 * u + r - 32 * kt - 8 * h;
        if (rel0 - 32 * kt - 31 >= 128) {
          const float bv = bias_l2[256];
#pragma unroll
          for (int e = 0; e < 16; ++e) t[e] = S[e] * SM_C + bv;
        } else {
#pragma unroll
          for (int e = 0; e < 16; ++e) {
            int rel = relb - ((e & 7) + 16 * (e >> 3));
            rel = rel < -128 ? -128 : (rel > 128 ? 128 : rel);
            t[e] = S[e] * SM_C + bias_l2[rel + 128];
          }
        }
      } else {
#pragma unroll
        for (int e = 0; e < 16; ++e) t[e] = S[e] * SM_C;
      }
      float mx = t[0];
#pragma unroll
      for (int e = 1; e < 16; ++e) mx = fmaxf(mx, t[e]);
      mx = fmaxf(mx, __shfl_xor(mx, 32));
      if (__any(mx > Mx[u] + 8.f)) {
        const float mn = fmaxf(Mx[u], mx);
        const float al = __builtin_amdgcn_exp2f(Mx[u] - mn);
        Mx[u] = mn; L[u] *= al;
#pragma unroll
        for (int dt = 0; dt < DVT; ++dt)
#pragma unroll
          for (int e = 0; e < 16; ++e) O[u][dt][e] *= al;
      }
      float ps = 0.f;
#pragma unroll
      for (int e = 0; e < 16; ++e) { t[e] = __builtin_amdgcn_exp2f(t[e] - Mx[u]); ps += t[e]; }
      L[u] += ps;
#pragma unroll
      for (int s2 = 0; s2 < 2; ++s2) {
        uint4 pk;
        pk.x = pk2(t[8 * s2], t[8 * s2 + 1]); pk.y = pk2(t[8 * s2 + 2], t[8 * s2 + 3]);
        pk.z = pk2(t[8 * s2 + 4], t[8 * s2 + 5]); pk.w = pk2(t[8 * s2 + 6], t[8 * s2 + 7]);
        pf[u][s2] = __builtin_bit_cast(bf16x8, pk);
      }
    }
#pragma unroll
    for (int u = 0; u < NQT; ++u)
#pragma unroll
      for (int dt = 0; dt < DVT; ++dt)
#pragma unroll
        for (int s2 = 0; s2 < 2; ++s2) O[u][dt] = MFMA(vf[dt][s2], pf[u][s2], O[u][dt]);
#pragma unroll
    for (int s = 0; s < 4; ++s) kf[s] = kn[s];
  }
#pragma unroll
  for (int u = 0; u < NQT; ++u) L[u] += __shfl_xor(L[u], 32);
}

template <int NQT>
DI void attnA_item(const Params& p, const u16* Q, const u16* K, const u16* Vt, int ldv, int nkt, int rel0,
                   const float* bias_l2, int tok0, int head) {
  f32x16 O[NQT][2]; float Mx[NQT], L[NQT];
  attn_wave<NQT, 2, true>(Q, 512, K, 512, Vt, ldv, nkt, bias_l2, rel0, O, Mx, L);
  const int lane = threadIdx.x & 63, r = lane & 31, h = lane >> 5;
  const u16* GA = (const u16*)(p.ws + WS_GA);
  u16* OB = (u16*)(p.ws + WS_HN);
#pragma unroll
  for (int u = 0; u < NQT; ++u) {
    const float inv = 1.f / L[u];
    const size_t tok = (size_t)(tok0 + 32 * u + r);
#pragma unroll
    for (int dt = 0; dt < 2; ++dt)
#pragma unroll
      for (int g = 0; g < 4; ++g) {
        const int dv = 32 * dt + 8 * g + 4 * h;
        const uint2 gg = *(const uint2*)(GA + tok * 512 + head * 64 + dv);
        uint2 o;
        o.x = pk2(O[u][dt][4 * g] * inv * bflo(gg.x), O[u][dt][4 * g + 1] * inv * bfhi(gg.x));
        o.y = pk2(O[u][dt][4 * g + 2] * inv * bflo(gg.y), O[u][dt][4 * g + 3] * inv * bfhi(gg.y));
        *(uint2*)(OB + tok * 1024 + head * 64 + dv) = o;
      }
  }
}

DI void attnB_epilogue(const Params& p, f32x16 (&O)[4], float Lsum, int tok0, int hb, float lam, float* xch) {
  const int lane = threadIdx.x & 63, r = lane & 31, h = lane >> 5, w = threadIdx.x >> 6, m = w >> 2, wsub = w & 3;
  const float inv = 1.f / Lsum;
  float* xw = xch + wsub * 4096 + lane;
  if (m == 1) {
    const float sc = inv * lam;
#pragma unroll
    for (int dt = 0; dt < 4; ++dt)
#pragma unroll
      for (int e = 0; e < 16; ++e) xw[(dt * 16 + e) * 64] = O[dt][e] * sc;
  }
  __syncthreads();
  if (m == 0) {
    float ss = 0.f;
#pragma unroll
    for (int dt = 0; dt < 4; ++dt)
#pragma unroll
      for (int e = 0; e < 16; ++e) { float o = O[dt][e] * inv - xw[(dt * 16 + e) * 64]; O[dt][e] = o; ss += o * o; }
    ss += __shfl_xor(ss, 32);
    const float rn = rsqrtf(ss * (1.f / 128.f) + 1e-6f) * 0.8f;
    const u16* GB = (const u16*)(p.ws + WS_GB);
    u16* OB = (u16*)(p.ws + WS_HN);
    const size_t tok = (size_t)(tok0 + r);
#pragma unroll
    for (int dt = 0; dt < 4; ++dt)
#pragma unroll
      for (int g = 0; g < 4; ++g) {
        const int dv = 32 * dt + 8 * g + 4 * h;
        const uint2 gg = *(const uint2*)(GB + tok * 512 + hb * 128 + dv);
        const float4 sg = *(const float4*)(p.subln + dv);
        uint2 o;
        o.x = pk2(O[dt][4 * g] * rn * sg.x * bflo(gg.x), O[dt][4 * g + 1] * rn * sg.y * bfhi(gg.x));
        o.y = pk2(O[dt][4 * g + 2] * rn * sg.z * bflo(gg.y), O[dt][4 * g + 3] * rn * sg.w * bfhi(gg.y));
        *(uint2*)(OB + tok * 1024 + 512 + hb * 128 + dv) = o;
      }
  }
  __syncthreads();
}

DI void attnB_item(const Params& p, const u16* Q, const u16* K, const u16* Vt, int ldv, int nkt, int tok0, int hb,
                   float lam, float* xch) {
  f32x16 O[1][4]; float Mx[1], L[1];
  attn_wave<1, 4, false>(Q, 512, K, 512, Vt, ldv, nkt, nullptr, 0, O, Mx, L);
  attnB_epilogue(p, O[0], L[0], tok0, hb, lam, xch);
}

typedef float f2 __attribute__((ext_vector_type(2)));
constexpr int BLK_V = 0, BLK_K = 49152, BLK_XCH = 81920, LDS_BIAS = 147456;
DI float half_max(float v) {
  auto rr = __builtin_amdgcn_permlane32_swap(__float_as_uint(v), __float_as_uint(v), false, false);
  return fmaxf(__uint_as_float(rr[0]), __uint_as_float(rr[1]));
}
DI void attnB_block(const Params& p, int b, int hb, int qt, float lam, char* lds) {
  int tid = threadIdx.x;
  asm volatile("" : "+v"(tid));
  const int lane = tid & 63, r = lane & 31, h = lane >> 5, w = tid >> 6, m = w >> 2, wsub = w & 3;
  constexpr bool late = false;
  const int q0 = qt * 128 + wsub * 32;
  const int nt = 2 * qt + 2;
  const int my_nt = (q0 >> 6) + 1;
  uint4 qraw[4];
  {
    const u16* Q = (const u16*)(p.ws + WS_QB) + (size_t)(b * SEQ + q0 + r) * 512 + hb * 128 + m * 64 + 8 * h;
#pragma unroll
    for (int s = 0; s < 4; ++s) gld16(qraw[s], Q + 16 * s);
  }
  f32x16 O[4];
#pragma unroll
  for (int dt = 0; dt < 4; ++dt)
#pragma unroll
    for (int e = 0; e < 16; ++e) O[dt][e] = 0.f;
  float Mx = -INFINITY;
  f2 L2 = {0.f, 0.f};
  const u16* gk = (const u16*)(p.ws + WS_KB) + (size_t)(b * SEQ + (tid >> 4)) * 512 + hb * 128 + (tid & 15) * 8;
  const u16* gv = (const u16*)(p.ws + WS_VBT) + (size_t)(b * 512 + hb * 128 + (tid >> 3)) * SEQ + (tid & 7) * 8;
  const int lk = BLK_K + ((tid >> 3) & 1) * 8192 + (tid >> 4) * 128 + ((((tid & 7) ^ ((tid >> 5) & 7))) << 4);
  const int lv = BLK_V + (tid >> 3) * 128 + ((((tid & 7) ^ ((tid >> 4) & 7))) << 4);
  const int rr = rho(r);
  const int swk = (rr >> 1) & 7, swv = (r >> 1) & 7;
  uint4 sk0, sk1, sv0, sv1;
  gld16(sk0, gk); gld16(sk1, gk + (size_t)32 * 512);
  gld16(sv0, gv); gld16(sv1, gv + (size_t)64 * SEQ);
  wait_vm0();
  *(uint4*)(lds + lk) = sk0; *(uint4*)(lds + lk + 4096) = sk1;
  *(uint4*)(lds + lv) = sv0; *(uint4*)(lds + lv + 8192) = sv1;
  bf16x8 qf[4];
#pragma unroll
  for (int s = 0; s < 4; ++s) qf[s] = __builtin_bit_cast(bf16x8, qraw[s]);
  bf16x8 pf[4];
#pragma unroll
  for (int s = 0; s < 4; ++s) pf[s] = qf[s];
  __syncthreads();
  int vs = 0;
  for (int t = 0; t < nt; ++t) {
    if (t + 1 < nt) {
      gld16(sk0, gk + (size_t)(64 * (t + 1)) * 512);
      gld16(sk1, gk + (size_t)(64 * (t + 1) + 32) * 512);
      gld16(sv0, gv + 64 * (t + 1));
      gld16(sv1, gv + (size_t)64 * SEQ + 64 * (t + 1));
    }
    __builtin_amdgcn_sched_barrier(0);
    if (late && t >= 1 && t - 1 < my_nt) {
      const char* vb = lds + BLK_V + (vs == 0 ? 2 : vs - 1) * 16384;
#pragma unroll
      for (int ks = 0; ks < 4; ++ks) {
        const int co = (((2 * ks + h) ^ swv) << 4);
#pragma unroll
        for (int dt = 0; dt < 4; ++dt) {
          bf16x8 v = *(const bf16x8*)(vb + (32 * dt + r) * 128 + co);
          O[dt] = MFMA(v, pf[ks], O[dt]);
        }
      }
    }
    if (t < my_nt && t < nt) {
      const char* kb = lds + BLK_K + (t & 1) * 16384 + m * 8192;
      f32x16 S0, S1;
#pragma unroll
      for (int e = 0; e < 16; ++e) { S0[e] = 0.f; S1[e] = 0.f; }
      bf16x8 ka[4], kc[4];
#pragma unroll
      for (int s = 0; s < 4; ++s) {
        const int co = (((2 * s + h) ^ swk) << 4);
        ka[s] = *(const bf16x8*)(kb + rr * 128 + co);
        kc[s] = *(const bf16x8*)(kb + (32 + rr) * 128 + co);
      }
#pragma unroll
      for (int s = 0; s < 4; ++s) {
        S0 = MFMA(ka[s], qf[s], S0);
        S1 = MFMA(kc[s], qf[s], S1);
      }
      f2 tv[16];
      const f2 cc = {SM_C, SM_C};
#pragma unroll
      for (int e = 0; e < 8; ++e) {
        f2 a = {S0[2 * e], S0[2 * e + 1]}; tv[e] = a * cc;
        f2 c = {S1[2 * e], S1[2 * e + 1]}; tv[8 + e] = c * cc;
      }
      float mx = fmaxf(tv[0].x, tv[0].y);
#pragma unroll
      for (int e = 1; e < 16; ++e) mx = fmaxf(mx, fmaxf(tv[e].x, tv[e].y));
      mx = half_max(mx);
      if (__any(mx > Mx + 8.f)) {
        const float mn = fmaxf(Mx, mx);
        const float al = __builtin_amdgcn_exp2f(Mx - mn);
        Mx = mn; L2 *= al;
#pragma unroll
        for (int dt = 0; dt < 4; ++dt)
#pragma unroll
          for (int e = 0; e < 16; ++e) O[dt][e] *= al;
      }
      const f2 nm = {-Mx, -Mx};
#pragma unroll
      for (int e = 0; e < 16; ++e) {
        f2 d = tv[e] + nm;
        d.x = __builtin_amdgcn_exp2f(d.x); d.y = __builtin_amdgcn_exp2f(d.y);
        L2 += d;
        tv[e] = d;
      }
#pragma unroll
      for (int s2 = 0; s2 < 4; ++s2) {
        uint4 pa;
        pa.x = pk2(tv[4 * s2].x, tv[4 * s2].y); pa.y = pk2(tv[4 * s2 + 1].x, tv[4 * s2 + 1].y);
        pa.z = pk2(tv[4 * s2 + 2].x, tv[4 * s2 + 2].y); pa.w = pk2(tv[4 * s2 + 3].x, tv[4 * s2 + 3].y);
        pf[s2] = __builtin_bit_cast(bf16x8, pa);
      }
      if (!late) {
        const char* vb = lds + BLK_V + vs * 16384;
#pragma unroll
        for (int ks = 0; ks < 4; ++ks) {
          const int co = (((2 * ks + h) ^ swv) << 4);
#pragma unroll
          for (int dt = 0; dt < 4; ++dt) {
            bf16x8 v = *(const bf16x8*)(vb + (32 * dt + r) * 128 + co);
            O[dt] = MFMA(v, pf[ks], O[dt]);
          }
        }
      }
    }
    if (t + 1 < nt) {
      const int vn = (vs == 2 ? 0 : vs + 1);
      wait_vm0();
      *(uint4*)(lds + lk + ((t + 1) & 1) * 16384) = sk0; *(uint4*)(lds + lk + ((t + 1) & 1) * 16384 + 4096) = sk1;
      *(uint4*)(lds + lv + vn * 16384) = sv0; *(uint4*)(lds + lv + vn * 16384 + 8192) = sv1;
    }
    vs = (vs == 2 ? 0 : vs + 1);
    __syncthreads();
  }
  float L = L2.x + L2.y;
  L += __shfl_xor(L, 32);
  attnB_epilogue(p, O, L, b * SEQ + q0, hb, lam, (float*)(lds + BLK_XCH));
}

DI float phase2_setup(const Params& p, char* lds) {
  const int tid = threadIdx.x, lane = tid & 63;
  float* bias = (float*)(lds + LDS_BIAS);
  for (int i = tid; i < 8 * 257; i += 512) { int hh = i / 257, k = i - hh * 257; bias[hh * 260 + k] = p.rel_bias[i] * 1.4426950408889634f; }
  float a = p.lq1[lane] * p.lk1[lane], b = p.lq2[lane] * p.lk2[lane];
  a = wave_sum(a); b = wave_sum(b);
  __syncthreads();
  return expf(a) - expf(b) + 0.2f;
}
DI void p3_tile(const Params& p, char* lds, int tok0) {
  int tid = threadIdx.x;
  asm volatile("" : "+v"(tid));
  const int lane = tid & 63, w = tid >> 6, r = lane & 31, h = lane >> 5;
  const u16* OB = (const u16*)(p.ws + WS_HN);
  float* red = (float*)(lds + 131072);
  __syncthreads();
#pragma unroll
  for (int half = 0; half < 2; ++half) {
    uint4 a[8];
#pragma unroll
    for (int it = 0; it < 8; ++it) a[it] = *(const uint4*)(OB + (size_t)(tok0 + half * 32 + it * 4 + (tid >> 7)) * 1024 + (tid & 127) * 8);
#pragma unroll
    for (int it = 0; it < 8; ++it) {
      const int row = half * 32 + it * 4 + (tid >> 7);
      *(uint4*)(lds + row * 2048 + ((((tid & 127) ^ (row & 15))) << 4)) = a[it];
    }
  }
  f32x16 acc[2][4];
#pragma unroll
  for (int i = 0; i < 2; ++i)
#pragma unroll
    for (int j = 0; j < 4; ++j)
#pragma unroll
      for (int e = 0; e < 16; ++e) acc[i][j][e] = 0.f;
  const char* wp = p.ws + WS_WOUTT + ((size_t)(w * 4) * 4096 + lane) * 16;
  const char* ap = lds + r * 2048;
  const int akey = r & 15;
  uint4 bq[4][4];
#pragma unroll
  for (int s = 0; s < 4; ++s)
#pragma unroll
    for (int j = 0; j < 4; ++j) gld16(bq[s][j], wp + (size_t)(j * 4096 + s * 64) * 16);
  __syncthreads();
#define P3_KSTEP(KS, SLOT, WAITN, REFILL)                                                        \
  {                                                                                              \
    const int co_ = ((((2 * (KS) + h) ^ akey)) << 4);                                            \
    const bf16x8 a0_ = *(const bf16x8*)(ap + co_);                                               \
    const bf16x8 a1_ = *(const bf16x8*)(ap + 65536 + co_);                                       \
    WAIT_VM(WAITN);                                                                              \
    __builtin_amdgcn_sched_barrier(0);                                                           \
    __builtin_amdgcn_s_setprio(1);                                                               \
    _Pragma("unroll") for (int j = 0; j < 4; ++j) {                                              \
      const bf16x8 bf_ = __builtin_bit_cast(bf16x8, bq[SLOT][j]);                                \
      acc[0][j] = MFMA(a0_, bf_, acc[0][j]);                                                     \
      acc[1][j] = MFMA(a1_, bf_, acc[1][j]);                                                     \
    }                                                                                            \
    __builtin_amdgcn_s_setprio(0);                                                               \
    __builtin_amdgcn_sched_barrier(0);                                                           \
    if (REFILL) {                                                                                \
      _Pragma("unroll") for (int j = 0; j < 4; ++j) gld16(bq[SLOT][j], wp + (size_t)(j * 4096 + ((KS) + 4) * 64) * 16); \
    }                                                                                            \
    __builtin_amdgcn_sched_barrier(0);                                                           \
  }
#pragma unroll 1
  for (int g = 0; g < 15; ++g) {
    P3_KSTEP(4 * g, 0, 12, true)
    P3_KSTEP(4 * g + 1, 1, 12, true)
    P3_KSTEP(4 * g + 2, 2, 12, true)
    P3_KSTEP(4 * g + 3, 3, 12, true)
  }
  P3_KSTEP(60, 0, 12, false)
  P3_KSTEP(61, 1, 8, false)
  P3_KSTEP(62, 2, 4, false)
  P3_KSTEP(63, 3, 0, false)
  WAIT_VM(0);
  const float* xr = tok0 < NTOKP ? p.x_prompt + (size_t)tok0 * 1024 : p.x_sample + (size_t)(tok0 - NTOKP) * 1024;
  const unsigned cb = w * 128 + r;
#pragma unroll
  for (int i = 0; i < 2; ++i) {
#pragma unroll
    for (int e = 0; e < 16; ++e) {
      const int row = 32 * i + 8 * (e >> 2) + 4 * h + (e & 3);
      unsigned off = row * 1024 + cb;
      asm volatile("" : "+v"(off));
      float ssv = 0.f;
#pragma unroll
      for (int j = 0; j < 4; ++j) {
        const float y = acc[i][j][e] + xr[off + j * 32];
        acc[i][j][e] = y; ssv += y * y;
      }
      ssv += __shfl_xor(ssv, 1); ssv += __shfl_xor(ssv, 2); ssv += __shfl_xor(ssv, 4); ssv += __shfl_xor(ssv, 8); ssv += __shfl_xor(ssv, 16);
      if (r == 0) red[w * 64 + row] = ssv;
      if ((e & 3) == 3) __builtin_amdgcn_sched_barrier(0);
    }
  }
  __syncthreads();
  if (tid < 64) {
    float t = 0.f;
#pragma unroll
    for (int k = 0; k < 8; ++k) t += red[k * 64 + tid];
    red[512 + tid] = rsqrtf(t * (1.f / 1024.f) + 1e-6f);
  }
  __syncthreads();
  float* yr = p.out + O_YP + (size_t)tok0 * 1024;
  float gj[4];
#pragma unroll
  for (int j = 0; j < 4; ++j) gj[j] = p.final_gain[cb + j * 32];
#pragma unroll
  for (int i = 0; i < 2; ++i) {
#pragma unroll
    for (int e = 0; e < 16; ++e) {
      const int row = 32 * i + 8 * (e >> 2) + 4 * h + (e & 3);
      unsigned off = row * 1024 + cb;
      asm volatile("" : "+v"(off));
      const float ri = red[512 + row];
#pragma unroll
      for (int j = 0; j < 4; ++j) yr[off + j * 32] = acc[i][j][e] * ri * gj[j];
      if ((e & 3) == 3) __builtin_amdgcn_sched_barrier(0);
    }
  }
}

constexpr int NQUEUE = 14;
DI int q_pop(unsigned* ctr, int* slot) {
  __syncthreads();
  if (threadIdx.x == 0) *slot = (int)__hip_atomic_fetch_add(ctr, 1u, __ATOMIC_RELAXED, __HIP_MEMORY_SCOPE_AGENT);
  __syncthreads();
  return *slot;
}
DI void p2_all(const Params& p, char* lds, float lam) {
  const int w = threadIdx.x >> 6;
  unsigned* Q = (unsigned*)(p.ws + WS_QUEUE);
  int* slot = (int*)(lds + LDS_BIAS + 8320);
  float* xch = (float*)(lds + 65536);
  const float* bias = (const float*)(lds + LDS_BIAS);
  const u16* QA = (const u16*)(p.ws + WS_QA);
  const u16* QB = (const u16*)(p.ws + WS_QB);
#pragma unroll 1
  for (;;) {
    const int i = q_pop(Q + 64 * 12, slot);
    if (i >= 32) break;
    p1_dispatch<2>(p, lds, 64, i * 128);
    asm volatile("s_waitcnt vmcnt(0)" ::: "memory");
    __syncthreads();
    if (threadIdx.x == 0) {
      __builtin_amdgcn_fence(__ATOMIC_RELEASE, "agent");
      __hip_atomic_fetch_add(Q + 64 * 13, 1u, __ATOMIC_RELAXED, __HIP_MEMORY_SCOPE_AGENT);
    }
  }
  {
    const int it = q_pop(Q, slot);
    if (it < 16) {
      if (threadIdx.x == 0) {
        while (__hip_atomic_load(Q + 64 * 13, __ATOMIC_RELAXED, __HIP_MEMORY_SCOPE_AGENT) < 32u) __builtin_amdgcn_s_sleep(2);
        __builtin_amdgcn_fence(__ATOMIC_ACQUIRE, "agent");
      }
      __syncthreads();
    }
    if (it < 8) {
      const int m = w >> 2, wsub = w & 3, id = it * 4 + wsub, b = id >> 2, hb = id & 3;
      attnB_item(p, QB + (size_t)(NTOKP + b * 32) * 512 + hb * 128 + m * 64,
                 (const u16*)(p.ws + WS_KBS) + (size_t)(b * 1056) * 512 + hb * 128 + m * 64,
                 (const u16*)(p.ws + WS_VBTS) + (size_t)(b * 512 + hb * 128) * 1056, 1056, 33, NTOKP + b * 32, hb, lam, xch);
    } else if (it < 16) {
      const int b = it - 8;
      attnA_item<1>(p, QA + (size_t)(NTOKP + b * 32) * 512 + w * 64,
                    (const u16*)(p.ws + WS_KAS) + (size_t)(b * 544) * 512 + w * 64,
                    (const u16*)(p.ws + WS_VATS) + (size_t)(b * 512 + w * 64) * 544, 544, 17, 512, bias + w * 260,
                    NTOKP + b * 32, w);
    }
    if (it < 16) {
      asm volatile("s_waitcnt vmcnt(0)" ::: "memory");
      __syncthreads();
      if (threadIdx.x == 0) {
        __builtin_amdgcn_fence(__ATOMIC_RELEASE, "agent");
        __hip_atomic_fetch_add(Q + 64 * 11, 1u, __ATOMIC_RELAXED, __HIP_MEMORY_SCOPE_AGENT);
      }
    }
  }
  bool didA = false;
  int k = 0;
#pragma unroll 1
  for (;;) {
    int i = q_pop(Q + 64 * (1 + ((blockIdx.x + k) & 7)), slot);
    if (i >= 64) { if (++k < 8) continue; i = -1; }
    if ((i < 0 || i >= 40) && !didA) {
      didA = true;
#pragma unroll 1
      for (;;) {
        const int it = q_pop(Q + 64 * 10, slot);
        if (it >= 4) break;
        if (threadIdx.x == 0) {
          while (__hip_atomic_load(Q + 64 * 11, __ATOMIC_RELAXED, __HIP_MEMORY_SCOPE_AGENT) < 16u) __builtin_amdgcn_s_sleep(2);
          __builtin_amdgcn_fence(__ATOMIC_ACQUIRE, "agent");
        }
        __syncthreads();
        p3_tile(p, lds, NTOKP + it * 64);
      }
#pragma unroll 1
      for (;;) {
        const int it = q_pop(Q + 64 * 9, slot);
        if (it >= 256) break;
        const int b = it >> 7, c = it & 127, cs = c > 8 ? c - 8 : 0;
        int tl = threadIdx.x;
        asm volatile("" : "+v"(tl));
        const int ww = tl >> 6;
        attnA_item<2>(p, (const u16*)(p.ws + WS_QA) + (size_t)(b * SEQ + c * 64) * 512 + ww * 64,
                      (const u16*)(p.ws + WS_KA) + (size_t)(b * SEQ + cs * 64) * 512 + ww * 64,
                      (const u16*)(p.ws + WS_VAT) + (size_t)(b * 512 + ww * 64) * SEQ + cs * 64, SEQ,
                      (c + 1 - cs) * 2, 64 * (c - cs), (const float*)(lds + LDS_BIAS) + ww * 260, b * SEQ + c * 64, ww);
      }
    }
    if (i < 0) break;
    const int x = (blockIdx.x + k) & 7;
    attnB_block(p, x >> 2, x & 3, 63 - i, lam, lds);
  }
}

DI void phase4(const Params& p) {
  const int lane = threadIdx.x & 63, w = threadIdx.x >> 6;
  for (int row = blockIdx.x * 8 + w; row < NTOK; row += gridDim.x * 8) {
    float* y = p.out + O_YP + (size_t)row * 1024;
    float4 v[4]; float ss = 0.f;
#pragma unroll
    for (int it = 0; it < 4; ++it) { v[it] = *(const float4*)(y + it * 256 + lane * 4); ss += v[it].x * v[it].x + v[it].y * v[it].y + v[it].z * v[it].z + v[it].w * v[it].w; }
    ss = wave_sum(ss);
    const float inv = rsqrtf(ss * (1.f / 1024.f) + 1e-6f);
#pragma unroll
    for (int it = 0; it < 4; ++it) {
      float4 g = *(const float4*)(p.final_gain + it * 256 + lane * 4);
      *(float4*)(y + it * 256 + lane * 4) = make_float4(v[it].x * inv * g.x, v[it].y * inv * g.y, v[it].z * inv * g.z, v[it].w * inv * g.w);
    }
  }
}

__global__ void __launch_bounds__(512) fwd_megakernel(Params p) {
  __shared__ __attribute__((aligned(16))) char lds[155904];
  cg::grid_group grid = cg::this_grid();
  unsigned* ctr = (unsigned*)(p.ws + WS_BAR);
  const unsigned G = gridDim.x;
  if (p.out == nullptr) grid.sync();
  phase0(p, lds);
  ctr_barrier(ctr, G);
  phase1(p, lds);
  ctr_barrier(ctr, 2 * G);
  {
    const float lam = phase2_setup(p, lds);
    p2_all(p, lds, lam);
  }
  ctr_barrier(ctr, 3 * G);
  for (int t = blockIdx.x; t < 256; t += gridDim.x) p3_tile(p, lds, t * 64);
}

extern "C" void kernel_launch(void* const* d_in, const int* in_sizes, int n_in, void* d_out, int out_size, void* d_ws,
                              size_t ws_size, hipStream_t stream) {
  static int grid_blocks = 0;
  if (!grid_blocks) {
    int dev = 0, cus = 0, per_cu = 0;
    hipGetDevice(&dev);
    hipDeviceGetAttribute(&cus, hipDeviceAttributeMultiprocessorCount, dev);
    hipOccupancyMaxActiveBlocksPerMultiprocessor(&per_cu, fwd_megakernel, 512, 0);
    if (per_cu < 1) per_cu = 1;
    grid_blocks = cus;
  }
  Params p{};
  p.x_prompt = (const float*)d_in[0]; p.x_sample = (const float*)d_in[1];
  p.cache_a_k = (const float*)d_in[2]; p.cache_a_v = (const float*)d_in[3];
  p.cache_b_k = (const float*)d_in[4]; p.cache_b_v = (const float*)d_in[5];
  p.norm_gain = (const float*)d_in[6]; p.w_in = (const float*)d_in[7]; p.w_out = (const float*)d_in[8];
  p.rel_bias = (const float*)d_in[9];
  p.lq1 = (const float*)d_in[10]; p.lk1 = (const float*)d_in[11]; p.lq2 = (const float*)d_in[12]; p.lk2 = (const float*)d_in[13];
  p.subln = (const float*)d_in[14]; p.final_gain = (const float*)d_in[15];
  p.out = (float*)d_out; p.ws = (char*)d_ws;
  void* args[] = {&p};
  (void)hipMemsetAsync((char*)d_ws + WS_BAR, 0, 12288, stream);
  hipError_t e = hipLaunchCooperativeKernel((void*)fwd_megakernel, dim3(grid_blocks), dim3(512), args, 0, stream);
  if (e != hipSuccess) fprintf(stderr, "cooperative launch failed: %s (grid %d)\n", hipGetErrorString(e), grid_blocks);
}
```

```cpp
#include <hip/hip_runtime.h>
#include <hip/hip_cooperative_groups.h>
#include <cstdio>
namespace cg = cooperative_groups;

typedef short bf16x8 __attribute__((ext_vector_type(8)));
typedef float f32x16 __attribute__((ext_vector_type(16)));
typedef __bf16 bf2_t __attribute__((ext_vector_type(2)));
typedef float f2_t __attribute__((ext_vector_type(2)));
typedef unsigned u32;
typedef unsigned short u16;
#define DI __device__ __forceinline__
#define MFMA(a, b, c) __builtin_amdgcn_mfma_f32_32x32x16_bf16((a), (b), (c), 0, 0, 0)

constexpr int NTOKP = 16384;
constexpr int NTOK = 16640;
constexpr int SEQ = 8192;
constexpr size_t O_YP = 0;
constexpr size_t O_AKP = 17039360, O_AVP = 17563648, O_BKP = 18087936, O_BVP = 26476544;
constexpr size_t O_AKS = 34865152, O_AVS = 36962304, O_BKS = 39059456, O_BVS = 39190528;
constexpr size_t WS_WINT = 0;
constexpr size_t WS_WOUTT = WS_WINT + 8388608;
constexpr size_t WS_HN = WS_WOUTT + 2097152;
constexpr size_t WS_QA = WS_HN + 34078720;
constexpr size_t WS_KA = WS_QA + 17039360;
constexpr size_t WS_KAS = WS_KA + 16777216;
constexpr size_t WS_VAT = WS_KAS + 4456448;
constexpr size_t WS_VATS = WS_VAT + 16777216;
constexpr size_t WS_GA = WS_VATS + 4456448;
constexpr size_t WS_QB = WS_GA + 17039360;
constexpr size_t WS_KB = WS_QB + 17039360;
constexpr size_t WS_KBS = WS_KB + 16777216;
constexpr size_t WS_VBT = WS_KBS + 8650752;
constexpr size_t WS_VBTS = WS_VBT + 16777216;
constexpr size_t WS_GB = WS_VBTS + 8650752;
constexpr size_t WS_ROPE = WS_GB + 17039360;
constexpr size_t WS_BAR = WS_ROPE + 524288;
constexpr size_t WS_QUEUE = WS_BAR + 4096;
constexpr size_t WS_END = WS_QUEUE + 8192;

struct Params {
  const float* x_prompt; const float* x_sample;
  const float* cache_a_k; const float* cache_a_v; const float* cache_b_k; const float* cache_b_v;
  const float* norm_gain; const float* w_in; const float* w_out; const float* rel_bias;
  const float* lq1; const float* lk1; const float* lq2; const float* lk2;
  const float* subln; const float* final_gain;
  float* out; char* ws;
};

DI u32 pk2(float a, float b) { f2_t v = {a, b}; bf2_t r = __builtin_convertvector(v, bf2_t); return __builtin_bit_cast(u32, r); }
DI float bflo(u32 v) { return __uint_as_float(v << 16); }
DI float bfhi(u32 v) { return __uint_as_float(v & 0xffff0000u); }
DI int rho(int r) { return (r & ~12) | ((r & 4) << 1) | ((r & 8) >> 1); }
DI void gld16(uint4& dst, const void* p) { asm volatile("global_load_dwordx4 %0, %1, off" : "=v"(dst) : "v"(p) : "memory"); }
#define WAIT_VM(n) asm volatile("s_waitcnt vmcnt(" #n ")" ::: "memory")
DI void wait_vm0() { asm volatile("s_waitcnt vmcnt(0)" ::: "memory"); }
DI float wave_sum(float v) {
#pragma unroll
  for (int o = 32; o > 0; o >>= 1) v += __shfl_xor(v, o);
  return v;
}


DI void ctr_barrier(unsigned* ctr, unsigned target) {
  __syncthreads();
  if (threadIdx.x == 0) {
    __builtin_amdgcn_fence(__ATOMIC_RELEASE, "agent");
    __hip_atomic_fetch_add(ctr, 1u, __ATOMIC_RELAXED, __HIP_MEMORY_SCOPE_AGENT);
    while (__hip_atomic_load(ctr, __ATOMIC_RELAXED, __HIP_MEMORY_SCOPE_AGENT) < target) __builtin_amdgcn_s_sleep(1);
    __builtin_amdgcn_fence(__ATOMIC_ACQUIRE, "agent");
  }
  __syncthreads();
}

DI void phase0(const Params& p, char* lds) {
  const int tid = threadIdx.x, bid = blockIdx.x, nb = gridDim.x;
  const int lane = tid & 63, w = tid >> 6;
  float* tile = (float*)lds;
  for (int i = bid * 512 + tid; i < 131072; i += nb * 512) {
    const int ln = i & 63, s_ = (i >> 6) & 63, ct = i >> 12, r_ = ln & 31, h_ = ln >> 5;
    float v[8];
#pragma unroll
    for (int j = 0; j < 8; ++j) v[j] = p.w_out[(size_t)(16 * s_ + 8 * h_ + j) * 1024 + ct * 32 + r_];
    uint4 o; o.x = pk2(v[0], v[1]); o.y = pk2(v[2], v[3]); o.z = pk2(v[4], v[5]); o.w = pk2(v[6], v[7]);
    *(uint4*)(p.ws + WS_WOUTT + (size_t)i * 16) = o;
  }
  for (int t = bid; t < 1024; t += nb) {
    const float* W; u16* WT; int N, kt, nt;
    { W = p.w_in; WT = (u16*)(p.ws + WS_WINT); N = 4096; kt = t >> 6; nt = t & 63; }
#pragma unroll
    for (int it = 0; it < 8; ++it) {
      int idx = it * 512 + tid, kk = idx >> 6, nn = idx & 63;
      tile[kk * 65 + nn] = W[(size_t)(kt * 64 + kk) * N + nt * 64 + nn];
    }
    __syncthreads();
    {
      int n = tid >> 3, kg = tid & 7;
      float v[8];
#pragma unroll
      for (int j = 0; j < 8; ++j) v[j] = tile[(kg * 8 + j) * 65 + n];
      uint4 o; o.x = pk2(v[0], v[1]); o.y = pk2(v[2], v[3]); o.z = pk2(v[4], v[5]); o.w = pk2(v[6], v[7]);
      *(uint4*)(WT + (size_t)(nt * 64 + n) * 1024 + kt * 64 + kg * 8) = o;
    }
    __syncthreads();
  }
  {
    u16* HN = (u16*)(p.ws + WS_HN);
    for (int row = bid * 8 + w; row < NTOK; row += nb * 16) {
      const int row1 = row + nb * 8 < NTOK ? row + nb * 8 : row;
      const float* s0 = row < NTOKP ? p.x_prompt + (size_t)row * 1024 : p.x_sample + (size_t)(row - NTOKP) * 1024;
      const float* s1 = row1 < NTOKP ? p.x_prompt + (size_t)row1 * 1024 : p.x_sample + (size_t)(row1 - NTOKP) * 1024;
      float4 v[4], u[4]; float ss = 0.f, st = 0.f;
#pragma unroll
      for (int it = 0; it < 4; ++it) { v[it] = *(const float4*)(s0 + it * 256 + lane * 4); u[it] = *(const float4*)(s1 + it * 256 + lane * 4); }
#pragma unroll
      for (int it = 0; it < 4; ++it) {
        ss += v[it].x * v[it].x + v[it].y * v[it].y + v[it].z * v[it].z + v[it].w * v[it].w;
        st += u[it].x * u[it].x + u[it].y * u[it].y + u[it].z * u[it].z + u[it].w * u[it].w;
      }
      ss = wave_sum(ss); st = wave_sum(st);
      const float inv = rsqrtf(ss * (1.f / 1024.f) + 1e-6f), inu = rsqrtf(st * (1.f / 1024.f) + 1e-6f);
#pragma unroll
      for (int it = 0; it < 4; ++it) {
        float4 g = *(const float4*)(p.norm_gain + it * 256 + lane * 4);
        uint2 o; o.x = pk2(v[it].x * inv * g.x, v[it].y * inv * g.y); o.y = pk2(v[it].z * inv * g.z, v[it].w * inv * g.w);
        *(uint2*)(HN + (size_t)row * 1024 + it * 256 + lane * 4) = o;
        o.x = pk2(u[it].x * inu * g.x, u[it].y * inu * g.y); o.y = pk2(u[it].z * inu * g.z, u[it].w * inu * g.w);
        *(uint2*)(HN + (size_t)row1 * 1024 + it * 256 + lane * 4) = o;
      }
    }
  }
  const int gt = bid * 512 + tid, gn = nb * 512;
  {
    u16* KAS = (u16*)(p.ws + WS_KAS);
#pragma unroll 4
    for (int i = gt; i < 524288; i += gn) {
      int e = i * 4, b = e >> 18, key = (e >> 9) & 511, f = e & 511;
      float4 v = *(const float4*)(p.cache_a_k + e);
      uint2 o; o.x = pk2(v.x, v.y); o.y = pk2(v.z, v.w);
      *(uint2*)(KAS + (size_t)(b * 544 + key) * 512 + f) = o;
      if (key >= 32) *(float4*)(p.out + O_AKS + (size_t)(b * 512 + key - 32) * 512 + f) = v;
    }
    u16* KBS = (u16*)(p.ws + WS_KBS);
#pragma unroll 4
    for (int i = gt; i < 1048576; i += gn) {
      int e = i * 4, b = e >> 19, key = (e >> 9) & 1023, f = e & 511;
      float4 v = *(const float4*)(p.cache_b_k + e);
      uint2 o; o.x = pk2(v.x, v.y); o.y = pk2(v.z, v.w);
      *(uint2*)(KBS + (size_t)(b * 1056 + key) * 512 + f) = o;
    }
    u16* VATS = (u16*)(p.ws + WS_VATS);
#pragma unroll 2
    for (int i = gt; i < 262144; i += gn) {
      int f = i & 511, kg = (i >> 9) & 63, b = i >> 15;
      float v[8];
#pragma unroll
      for (int j = 0; j < 8; ++j) v[j] = p.cache_a_v[(size_t)(b * 512 + kg * 8 + j) * 512 + f];
      uint4 o; o.x = pk2(v[0], v[1]); o.y = pk2(v[2], v[3]); o.z = pk2(v[4], v[5]); o.w = pk2(v[6], v[7]);
      *(uint4*)(VATS + (size_t)(b * 512 + f) * 544 + kg * 8) = o;
      if (kg >= 4) {
#pragma unroll
        for (int j = 0; j < 8; ++j) p.out[O_AVS + (size_t)(b * 512 + kg * 8 + j - 32) * 512 + f] = v[j];
      }
    }
    u16* VBTS = (u16*)(p.ws + WS_VBTS);
#pragma unroll 2
    for (int i = gt; i < 524288; i += gn) {
      int f = i & 511, kg = (i >> 9) & 127, b = i >> 16;
      float v[8];
#pragma unroll
      for (int j = 0; j < 8; ++j) v[j] = p.cache_b_v[(size_t)(b * 1024 + kg * 8 + j) * 512 + f];
      uint4 o; o.x = pk2(v[0], v[1]); o.y = pk2(v[2], v[3]); o.z = pk2(v[4], v[5]); o.w = pk2(v[6], v[7]);
      *(uint4*)(VBTS + (size_t)(b * 512 + f) * 1056 + kg * 8) = o;
    }
  }
  {
    float2* RT = (float2*)(p.ws + WS_ROPE);
    for (int i = gt; i < 65536; i += gn) {
      int pos = i >> 3, m = i & 7;
      float inv = powf(500000.f, -(float)m * 0.125f);
      float ang = (float)pos * inv;
      RT[i] = make_float2(cosf(ang), sinf(ang));
    }
  }
}

template <int NJ>
DI void gemm_mainloop(const u16* __restrict__ A, const u16* __restrict__ Bt, int row0, int col0, char* lds, f32x16 (&acc)[2][NJ]) {
  constexpr int STAGE = 32768 + NJ * 8192;
  int tid = threadIdx.x;
  asm volatile("" : "+v"(tid));
  const int lane = tid & 63, w = tid >> 6, wm = w >> 1, wn = w & 1;
  const int r = lane & 31, h = lane >> 5;
  const u16* pa = A + (size_t)(row0 + (tid >> 3)) * 1024 + (tid & 7) * 8;
  const u16* pb = Bt + (size_t)(col0 + (tid >> 3)) * 1024 + (tid & 7) * 8;
  const int wofs = (tid >> 3) * 128 + ((((tid & 7) ^ ((tid >> 4) & 7))) << 4);
  const int swr = (r >> 1) & 7;
#pragma unroll
  for (int i = 0; i < 2; ++i)
#pragma unroll
    for (int j = 0; j < NJ; ++j)
#pragma unroll
      for (int e = 0; e < 16; ++e) acc[i][j][e] = 0.f;
  uint4 ra[4], rb[NJ];
#define GM_ISSUE(KB)                                                                          \
  { _Pragma("unroll") for (int it = 0; it < 4; ++it) gld16(ra[it], pa + (size_t)it * 65536 + (KB) * 64); \
    _Pragma("unroll") for (int it = 0; it < NJ; ++it) gld16(rb[it], pb + (size_t)it * 65536 + (KB) * 64); }
#define GM_PARK(ST)                                                                           \
  { char* bw_ = lds + (ST) * STAGE;                                                           \
    _Pragma("unroll") for (int it = 0; it < 4; ++it) *(uint4*)(bw_ + it * 8192 + wofs) = ra[it]; \
    _Pragma("unroll") for (int it = 0; it < NJ; ++it) *(uint4*)(bw_ + 32768 + it * 8192 + wofs) = rb[it]; }
  GM_ISSUE(0)
  WAIT_VM(0);
  GM_PARK(0)
  __syncthreads();
#pragma unroll 1
  for (int kt = 0; kt < 16; ++kt) {
    if (kt + 1 < 16) GM_ISSUE(kt + 1)
    __builtin_amdgcn_sched_barrier(0);
    const char* ba = lds + (kt & 1) * STAGE;
    const char* bb = ba + 32768;
    bf16x8 hf[2][2], wf[NJ];
    {
      const int co = ((h ^ swr) << 4);
#pragma unroll
      for (int i = 0; i < 2; ++i) hf[0][i] = *(const bf16x8*)(ba + (wm * 64 + i * 32 + r) * 128 + co);
#pragma unroll
      for (int j = 0; j < NJ; ++j) wf[j] = *(const bf16x8*)(bb + (wn * 32 * NJ + j * 32 + r) * 128 + co);
    }
#pragma unroll
    for (int s = 0; s < 4; ++s) {
      const int co = (((2 * (s + 1) + h) ^ swr) << 4);
      if (s < 3) {
#pragma unroll
        for (int i = 0; i < 2; ++i) hf[(s + 1) & 1][i] = *(const bf16x8*)(ba + (wm * 64 + i * 32 + r) * 128 + co);
      }
      __builtin_amdgcn_s_setprio(1);
#pragma unroll
      for (int j = 0; j < NJ; ++j) {
        acc[0][j] = MFMA(hf[s & 1][0], wf[j], acc[0][j]);
        acc[1][j] = MFMA(hf[s & 1][1], wf[j], acc[1][j]);
        if (s < 3) wf[j] = *(const bf16x8*)(bb + (wn * 32 * NJ + j * 32 + r) * 128 + co);
      }
      __builtin_amdgcn_s_setprio(0);
      __builtin_amdgcn_sched_barrier(0);
      if (kt + 1 < 16 && s == 1) {
        asm volatile("s_waitcnt vmcnt(%0)" :: "n"(NJ) : "memory");
        char* bw_ = lds + ((kt + 1) & 1) * STAGE;
#pragma unroll
        for (int it = 0; it < 4; ++it) *(uint4*)(bw_ + it * 8192 + wofs) = ra[it];
        __builtin_amdgcn_sched_barrier(0);
      }
      if (kt + 1 < 16 && s == 2) {
        WAIT_VM(0);
        char* bw_ = lds + ((kt + 1) & 1) * STAGE;
#pragma unroll
        for (int it = 0; it < NJ; ++it) *(uint4*)(bw_ + 32768 + it * 8192 + wofs) = rb[it];
        __builtin_amdgcn_sched_barrier(0);
      }
    }
    __syncthreads();
  }
#undef GM_ISSUE
#undef GM_PARK
}

DI float silu(float x) { return x * __builtin_amdgcn_rcpf(1.f + __expf(-x)); }

DI float dpp_x1(float v) { return __int_as_float(__builtin_amdgcn_update_dpp(0, __float_as_int(v), 0xB1, 0xF, 0xF, true)); }
DI float dpp_x8(float v) { return __int_as_float(__builtin_amdgcn_update_dpp(0, __float_as_int(v), 0x128, 0xF, 0xF, true)); }
DI void store_bf16_tile(const f32x16& a, u16* base  , size_t ld, int h, int odd) {
#pragma unroll
  for (int g = 0; g < 4; ++g)
#pragma unroll
    for (int e = 0; e < 4; e += 2) {
      const float v0 = a[4 * g + e], v1 = a[4 * g + e + 1];
      const float n0 = dpp_x1(v0), n1 = dpp_x1(v1);
      const u32 o = odd ? pk2(n1, v1) : pk2(v0, n0);
      *(u32*)(base + (size_t)(8 * g + 4 * h + e + odd) * ld) = o;
      if (e == 2) __builtin_amdgcn_sched_barrier(0);
    }
}
template <int NJ, int sec>
DI void p1_tile(const Params& p, char* lds, int tm, int col0) {
  constexpr int WN = 32 * NJ;
  const u16* HN = (const u16*)(p.ws + WS_HN);
  const u16* WT = (const u16*)(p.ws + WS_WINT);
  const float2* RT = (const float2*)(p.ws + WS_ROPE);
  const int fbase = col0 & 511;
  const bool sample = (tm == 64);
  f32x16 acc[2][NJ];
  gemm_mainloop<NJ>(HN, WT, tm * 256, col0, lds, acc);
  int tid = threadIdx.x;
  asm volatile("" : "+v"(tid));
  const int lane = tid & 63, w = tid >> 6, wm = w >> 1, wn = w & 1;
  const int r = lane & 31, h = lane >> 5, odd = r & 1;
  const int tb = tm * 256 + wm * 64;
  const int fb = fbase + wn * WN;
  if (sec == 2 || sec == 6) {
#pragma unroll
    for (int i = 0; i < 2; ++i) {
      float* dbase = nullptr;
      {
        const int t0 = tb + i * 32;
        if (!sample) {
          const int b = t0 >> 13, s0 = t0 & 8191;
          if (sec == 6) dbase = p.out + O_BVP + (size_t)t0 * 512;
          else if (s0 >= 7680) dbase = p.out + O_AVP + ((size_t)(b * 512 + s0 - 7680)) * 512;
        } else {
          const int ts = t0 - NTOKP, b = ts >> 5;
          if (sec == 6) dbase = p.out + O_BVS + (size_t)ts * 512;
          else dbase = p.out + O_AVS + ((size_t)(b * 512 + 480)) * 512;
        }
      }
#pragma unroll
      for (int j = 0; j < NJ; ++j) {
        unsigned lo = (wn * WN + j * 32 + r) * 528 + (wm * 64 + i * 32 + 4 * h) * 2;
        asm volatile("" : "+v"(lo));
#pragma unroll
        for (int g = 0; g < 4; ++g) {
          const float v0 = acc[i][j][4 * g], v1 = acc[i][j][4 * g + 1], v2 = acc[i][j][4 * g + 2], v3 = acc[i][j][4 * g + 3];
          uint2 o; o.x = pk2(v0, v1); o.y = pk2(v2, v3);
          *(uint2*)(lds + lo + g * 16) = o;
          if (dbase) {
            unsigned off = (8 * g + 4 * h) * 512 + fb + j * 32 + r;
            asm volatile("" : "+v"(off));
            dbase[off] = v0; dbase[off + 512] = v1; dbase[off + 1024] = v2; dbase[off + 1536] = v3;
          }
          __builtin_amdgcn_sched_barrier(0);
        }
      }
    }
    __syncthreads();
    {
      u16* VT; size_t ldv;
      if (sec == 2) { VT = (u16*)(p.ws + (sample ? WS_VATS : WS_VAT)); ldv = sample ? 544 : 8192; }
      else { VT = (u16*)(p.ws + (sample ? WS_VBTS : WS_VBT)); ldv = sample ? 1056 : 8192; }
      const int sofs = sample ? (sec == 2 ? 512 : 1024) : 0;
#pragma unroll
      for (int it = 0; it < 4 * NJ; ++it) {
        const int id = it * 512 + tid, row = id >> 5, c = id & 31;
        const uint4 v = *(const uint4*)(lds + row * 528 + c * 16);
        const int fs = fbase + row;
        if (!sample) {
          const int t0 = tm * 256 + c * 8, b = t0 >> 13, s = t0 & 8191;
          *(uint4*)(VT + ((size_t)(b * 512 + fs)) * ldv + s) = v;
        } else {
          const int b = c >> 2, tt = (c & 3) * 8;
          *(uint4*)(VT + ((size_t)(b * 512 + fs)) * ldv + sofs + tt) = v;
        }
        if ((it & 3) == 3) __builtin_amdgcn_sched_barrier(0);
      }
    }
    __syncthreads();
  } else {
    if (sec == 4 || sec == 5) {
      const float sgn = (r & 8) ? 1.f : -1.f;
      const int pos0 = sample ? (1024 + 4 * h) : ((tb & 8191) + 4 * h);
      const float2* rt = RT + pos0 * 8 + (r & 7);
#pragma unroll
      for (int i = 0; i < 2; ++i)
#pragma unroll
        for (int g = 0; g < 4; ++g) {
          const int po = (sample ? 0 : i * 32) + 8 * g;
          float2 cs[4];
#pragma unroll
          for (int e = 0; e < 4; ++e) cs[e] = rt[(po + e) * 8];
          __builtin_amdgcn_sched_barrier(0);
#pragma unroll
          for (int j = 0; j < NJ; j += 2)
#pragma unroll
            for (int e = 0; e < 4; ++e) {
              const float x = acc[i][j][4 * g + e];
              const float xp = dpp_x8(x);
              if (r < 16) acc[i][j][4 * g + e] = x * cs[e].x + sgn * xp * cs[e].y;
            }
          __builtin_amdgcn_sched_barrier(0);
        }
    }
    if (sec == 3 || sec == 7) {
#pragma unroll
      for (int i = 0; i < 2; ++i)
#pragma unroll
        for (int j = 0; j < NJ; ++j)
#pragma unroll
          for (int e = 0; e < 16; ++e) acc[i][j][e] = silu(acc[i][j][e]);
    }
    u16* dst; size_t trow0;
    if (sec == 0) { dst = (u16*)(p.ws + WS_QA); trow0 = tb; }
    else if (sec == 3) { dst = (u16*)(p.ws + WS_GA); trow0 = tb; }
    else if (sec == 4) { dst = (u16*)(p.ws + WS_QB); trow0 = tb; }
    else if (sec == 7) { dst = (u16*)(p.ws + WS_GB); trow0 = tb; }
    else if (sec == 1) {
      if (!sample) { dst = (u16*)(p.ws + WS_KA); trow0 = tb; }
      else { dst = (u16*)(p.ws + WS_KAS); trow0 = (size_t)(wm * 2) * 544 + 512; }
    } else {
      if (!sample) { dst = (u16*)(p.ws + WS_KB); trow0 = tb; }
      else { dst = (u16*)(p.ws + WS_KBS); trow0 = (size_t)(wm * 2) * 1056 + 1024; }
    }
    const size_t istep = sample ? (sec == 1 ? 544 : (sec == 5 ? 1056 : 32)) : 32;
#pragma unroll
    for (int i = 0; i < 2; ++i)
#pragma unroll
      for (int j = 0; j < NJ; ++j)
        store_bf16_tile(acc[i][j], dst + (trow0 + i * istep) * 512 + fb + j * 32 + (r & ~1), 512, h, odd);
    if (sec == 1 || sec == 5) {
#pragma unroll
      for (int i = 0; i < 2; ++i) {
        float* d = nullptr;
        const int t0 = tb + i * 32;
        if (!sample) {
          const int b = t0 >> 13, s = t0 & 8191;
          if (sec == 5) d = p.out + O_BKP + (size_t)t0 * 512;
          else if (s >= 7680) d = p.out + O_AKP + ((size_t)(b * 512 + s - 7680)) * 512;
        } else {
          const int ts = t0 - NTOKP, b = ts >> 5;
          if (sec == 5) d = p.out + O_BKS + (size_t)ts * 512;
          else d = p.out + O_AKS + ((size_t)(b * 512 + 480)) * 512;
        }
        if (d) {
#pragma unroll
          for (int j = 0; j < NJ; ++j)
#pragma unroll
            for (int e = 0; e < 16; ++e) {
              d[(size_t)(8 * (e >> 2) + 4 * h + (e & 3)) * 512 + fb + j * 32 + r] = acc[i][j][e];
              if ((e & 3) == 3) __builtin_amdgcn_sched_barrier(0);
            }
        }
      }
    }
  }
}
template <int NJ>
DI void p1_dispatch(const Params& p, char* lds, int tm, int col0) {
  switch (col0 >> 9) {
    case 0: p1_tile<NJ, 0>(p, lds, tm, col0); break;
    case 1: p1_tile<NJ, 1>(p, lds, tm, col0); break;
    case 2: p1_tile<NJ, 2>(p, lds, tm, col0); break;
    case 3: p1_tile<NJ, 3>(p, lds, tm, col0); break;
    case 4: p1_tile<NJ, 4>(p, lds, tm, col0); break;
    case 5: p1_tile<NJ, 5>(p, lds, tm, col0); break;
    case 6: p1_tile<NJ, 6>(p, lds, tm, col0); break;
    default: p1_tile<NJ, 7>(p, lds, tm, col0); break;
  }
}
DI void phase1(const Params& p, char* lds) {
  for (int tile = blockIdx.x; tile < 1024; tile += gridDim.x) {
    const int k = tile >> 8, b = tile & 255, xcd = b & 7, idx = b >> 3;
    const int tm = 16 * k + (xcd >> 1) * 4 + (idx & 3), tn = (xcd & 1) * 8 + (idx >> 2);
    p1_dispatch<4>(p, lds, tm, tn * 256);
  }
}

constexpr float SM_C = 0.125f * 1.4426950408889634f;
template <int NQT, int DVT, bool BIAS>
DI void attn_wave(const u16* __restrict__ Q, int ldq, const u16* __restrict__ K, int ldk,
                  const u16* __restrict__ Vt, int ldv, int nkt, const float* bias_l2, int rel0,
                  f32x16 (&O)[NQT][DVT], float (&Mx)[NQT], float (&L)[NQT]) {
  const int lane = threadIdx.x & 63, r = lane & 31, h = lane >> 5;
  bf16x8 qf[NQT][4];
#pragma unroll
  for (int u = 0; u < NQT; ++u)
#pragma unroll
    for (int s = 0; s < 4; ++s) qf[u][s] = *(const bf16x8*)(Q + (size_t)(32 * u + r) * ldq + 16 * s + 8 * h);
#pragma unroll
  for (int u = 0; u < NQT; ++u) {
    Mx[u] = -INFINITY; L[u] = 0.f;
#pragma unroll
    for (int dt = 0; dt < DVT; ++dt)
#pragma unroll
      for (int e = 0; e < 16; ++e) O[u][dt][e] = 0.f;
  }
  const u16* kp = K + (size_t)rho(r) * ldk + 8 * h;
  const u16* vp = Vt + (size_t)r * ldv + 8 * h;
  bf16x8 kf[4];
#pragma unroll
  for (int s = 0; s < 4; ++s) kf[s] = *(const bf16x8*)(kp + 16 * s);
  for (int kt = 0; kt < nkt; ++kt) {
    bf16x8 vf[DVT][2];
#pragma unroll
    for (int dt = 0; dt < DVT; ++dt)
#pragma unroll
      for (int s2 = 0; s2 < 2; ++s2) vf[dt][s2] = *(const bf16x8*)(vp + (size_t)(32 * dt) * ldv + 32 * kt + 16 * s2);
    bf16x8 kn[4];
    {
      const int ktn = (kt + 1 < nkt) ? kt + 1 : kt;
#pragma unroll
      for (int s = 0; s < 4; ++s) kn[s] = *(const bf16x8*)(kp + (size_t)(32 * ktn) * ldk + 16 * s);
    }
    bf16x8 pf[NQT][2];
#pragma unroll
    for (int u = 0; u < NQT; ++u) {
      f32x16 S;
#pragma unroll
      for (int e = 0; e < 16; ++e) S[e] = 0.f;
#pragma unroll
      for (int s = 0; s < 4; ++s) S = MFMA(kf[s], qf[u][s], S);
      float t[16];
      if (BIAS) {
        const int relb = rel0 + 32 * u + r - 32 * kt - 8 * h;
        if (rel0 - 32 * kt - 31 >= 128) {
          const float bv = bias_l2[256];
#pragma unroll
          for (int e = 0; e < 16; ++e) t[e] = S[e] * SM_C + bv;
        } else {
#pragma unroll
          for (int e = 0; e < 16; ++e) {
            int rel = relb - ((e & 7) + 16 * (e >> 3));
            rel = rel < -128 ? -128 : (rel > 128 ? 128 : rel);
            t[e] = S[e] * SM_C + bias_l2[rel + 128];
          }
        }
      } else {
#pragma unroll
        for (int e = 0; e < 16; ++e) t[e] = S[e] * SM_C;
      }
      float mx = t[0];
#pragma unroll
      for (int e = 1; e < 16; ++e) mx = fmaxf(mx, t[e]);
      mx = fmaxf(mx, __shfl_xor(mx, 32));
      if (__any(mx > Mx[u] + 8.f)) {
        const float mn = fmaxf(Mx[u], mx);
        const float al = __builtin_amdgcn_exp2f(Mx[u] - mn);
        Mx[u] = mn; L[u] *= al;
#pragma unroll
        for (int dt = 0; dt < DVT; ++dt)
#pragma unroll
          for (int e = 0; e < 16; ++e) O[u][dt][e] *= al;
      }
      float ps = 0.f;
#pragma unroll
      for (int e = 0; e < 16; ++e) { t[e] = __builtin_amdgcn_exp2f(t[e] - Mx[u]); ps += t[e]; }
      L[u] += ps;
#pragma unroll
      for (int s2 = 0; s2 < 2; ++s2) {
        uint4 pk;
        pk.x = pk2(t[8 * s2], t[8 * s2 + 1]); pk.y = pk2(t[8 * s2 + 2], t[8 * s2 + 3]);
        pk.z = pk2(t[8 * s2 + 4], t[8 * s2 + 5]); pk.w = pk2(t[8 * s2 + 6], t[8 * s2 + 7]);
        pf[u][s2] = __builtin_bit_cast(bf16x8, pk);
      }
    }
#pragma unroll
    for (int u = 0; u < NQT; ++u)
#pragma unroll
      for (int dt = 0; dt < DVT; ++dt)
#pragma unroll
        for (int s2 = 0; s2 < 2; ++s2) O[u][dt] = MFMA(vf[dt][s2], pf[u][s2], O[u][dt]);
#pragma unroll
    for (int s = 0; s < 4; ++s) kf[s] = kn[s];
  }
#pragma unroll
  for (int u = 0; u < NQT; ++u) L[u] += __shfl_xor(L[u], 32);
}

template <int NQT>
DI void attnA_item(const Params& p, const u16* Q, const u16* K, const u16* Vt, int ldv, int nkt, int rel0,
                   const float* bias_l2, int tok0, int head) {
  f32x16 O[NQT][2]; float Mx[NQT], L[NQT];
  attn_wave<NQT, 2, true>(Q, 512, K, 512, Vt, ldv, nkt, bias_l2, rel0, O, Mx, L);
  const int lane = threadIdx.x & 63, r = lane & 31, h = lane >> 5;
  const u16* GA = (const u16*)(p.ws + WS_GA);
  u16* OB = (u16*)(p.ws + WS_HN);
#pragma unroll
  for (int u = 0; u < NQT; ++u) {
    const float inv = 1.f / L[u];
    const size_t tok = (size_t)(tok0 + 32 * u + r);
#pragma unroll
    for (int dt = 0; dt < 2; ++dt)
#pragma unroll
      for (int g = 0; g < 4; ++g) {
        const int dv = 32 * dt + 8 * g + 4 * h;
        const uint2 gg = *(const uint2*)(GA + tok * 512 + head * 64 + dv);
        uint2 o;
        o.x = pk2(O[u][dt][4 * g] * inv * bflo(gg.x), O[u][dt][4 * g + 1] * inv * bfhi(gg.x));
        o.y = pk2(O[u][dt][4 * g + 2] * inv * bflo(gg.y), O[u][dt][4 * g + 3] * inv * bfhi(gg.y));
        *(uint2*)(OB + tok * 1024 + head * 64 + dv) = o;
      }
  }
}

DI void attnB_epilogue(const Params& p, f32x16 (&O)[4], float Lsum, int tok0, int hb, float lam, float* xch) {
  const int lane = threadIdx.x & 63, r = lane & 31, h = lane >> 5, w = threadIdx.x >> 6, m = w >> 2, wsub = w & 3;
  const float inv = 1.f / Lsum;
  float* xw = xch + wsub * 4096 + lane;
  if (m == 1) {
    const float sc = inv * lam;
#pragma unroll
    for (int dt = 0; dt < 4; ++dt)
#pragma unroll
      for (int e = 0; e < 16; ++e) xw[(dt * 16 + e) * 64] = O[dt][e] * sc;
  }
  __syncthreads();
  if (m == 0) {
    float ss = 0.f;
#pragma unroll
    for (int dt = 0; dt < 4; ++dt)
#pragma unroll
      for (int e = 0; e < 16; ++e) { float o = O[dt][e] * inv - xw[(dt * 16 + e) * 64]; O[dt][e] = o; ss += o * o; }
    ss += __shfl_xor(ss, 32);
    const float rn = rsqrtf(ss * (1.f / 128.f) + 1e-6f) * 0.8f;
    const u16* GB = (const u16*)(p.ws + WS_GB);
    u16* OB = (u16*)(p.ws + WS_HN);
    const size_t tok = (size_t)(tok0 + r);
#pragma unroll
    for (int dt = 0; dt < 4; ++dt)
#pragma unroll
      for (int g = 0; g < 4; ++g) {
        const int dv = 32 * dt + 8 * g + 4 * h;
        const uint2 gg = *(const uint2*)(GB + tok * 512 + hb * 128 + dv);
        const float4 sg = *(const float4*)(p.subln + dv);
        uint2 o;
        o.x = pk2(O[dt][4 * g] * rn * sg.x * bflo(gg.x), O[dt][4 * g + 1] * rn * sg.y * bfhi(gg.x));
        o.y = pk2(O[dt][4 * g + 2] * rn * sg.z * bflo(gg.y), O[dt][4 * g + 3] * rn * sg.w * bfhi(gg.y));
        *(uint2*)(OB + tok * 1024 + 512 + hb * 128 + dv) = o;
      }
  }
  __syncthreads();
}

DI void attnB_item(const Params& p, const u16* Q, const u16* K, const u16* Vt, int ldv, int nkt, int tok0, int hb,
                   float lam, float* xch) {
  f32x16 O[1][4]; float Mx[1], L[1];
  attn_wave<1, 4, false>(Q, 512, K, 512, Vt, ldv, nkt, nullptr, 0, O, Mx, L);
  attnB_epilogue(p, O[0], L[0], tok0, hb, lam, xch);
}

typedef float f2 __attribute__((ext_vector_type(2)));
constexpr int BLK_V = 0, BLK_K = 65536, BLK_XCH = 0, LDS_BIAS = 147456;
DI float half_max(float v) {
  auto rr = __builtin_amdgcn_permlane32_swap(__float_as_uint(v), __float_as_uint(v), false, false);
  return fmaxf(__uint_as_float(rr[0]), __uint_as_float(rr[1]));
}
DI void attnB_block(const Params& p, int b, int hb, int qt, float lam, char* lds) {
  int tid = threadIdx.x;
  asm volatile("" : "+v"(tid));
  const int lane = tid & 63, r = lane & 31, h = lane >> 5, w = tid >> 6, m = w >> 2, wsub = w & 3;
  constexpr bool late = false;
  const int q0 = qt * 128 + wsub * 32;
  const int nt = 2 * qt + 2;
  const int my_nt = (q0 >> 6) + 1;
  uint4 qraw[4];
  {
    const u16* Q = (const u16*)(p.ws + WS_QB) + (size_t)(b * SEQ + q0 + r) * 512 + hb * 128 + m * 64 + 8 * h;
#pragma unroll
    for (int s = 0; s < 4; ++s) gld16(qraw[s], Q + 16 * s);
  }
  f32x16 O[4];
#pragma unroll
  for (int dt = 0; dt < 4; ++dt)
#pragma unroll
    for (int e = 0; e < 16; ++e) O[dt][e] = 0.f;
  float Mx = -INFINITY;
  f2 L2 = {0.f, 0.f};
  const u16* gk = (const u16*)(p.ws + WS_KB) + (size_t)(b * SEQ + (tid >> 4)) * 512 + hb * 128 + (tid & 15) * 8;
  const u16* gv = (const u16*)(p.ws + WS_VBT) + (size_t)(b * 512 + hb * 128 + (tid >> 3)) * SEQ + (tid & 7) * 8;
  const int lk = BLK_K + ((tid >> 3) & 1) * 8192 + (tid >> 4) * 128 + ((((tid & 7) ^ ((tid >> 5) & 7))) << 4);
  const int lv = BLK_V + (tid >> 3) * 128 + ((((tid & 7) ^ ((tid >> 4) & 7))) << 4);
  const int rr = rho(r);
  const int swk = (rr >> 1) & 7, swv = (r >> 1) & 7;
  uint4 sk0, sk1, sv0, sv1;
  gld16(sk0, gk); gld16(sk1, gk + (size_t)32 * 512);
  gld16(sv0, gv); gld16(sv1, gv + (size_t)64 * SEQ);
  wait_vm0();
  *(uint4*)(lds + lk) = sk0; *(uint4*)(lds + lk + 4096) = sk1;
  *(uint4*)(lds + lv) = sv0; *(uint4*)(lds + lv + 8192) = sv1;
  asm volatile("s_waitcnt lgkmcnt(0)" ::: "memory");
  gld16(sk0, gk + (size_t)64 * 512); gld16(sk1, gk + (size_t)96 * 512);
  gld16(sv0, gv + 64); gld16(sv1, gv + (size_t)64 * SEQ + 64);
  wait_vm0();
  *(uint4*)(lds + lk + 16384) = sk0; *(uint4*)(lds + lk + 16384 + 4096) = sk1;
  *(uint4*)(lds + lv + 16384) = sv0; *(uint4*)(lds + lv + 16384 + 8192) = sv1;
  bf16x8 qf[4];
#pragma unroll
  for (int s = 0; s < 4; ++s) qf[s] = __builtin_bit_cast(bf16x8, qraw[s]);
  bf16x8 pf[4];
#pragma unroll
  for (int s = 0; s < 4; ++s) pf[s] = qf[s];
  __syncthreads();
  for (int t = 0; t < nt; ++t) {
    if (t + 2 < nt) {
      gld16(sk0, gk + (size_t)(64 * (t + 2)) * 512);
      gld16(sk1, gk + (size_t)(64 * (t + 2) + 32) * 512);
      gld16(sv0, gv + 64 * (t + 2));
      gld16(sv1, gv + (size_t)64 * SEQ + 64 * (t + 2));
    }
    __builtin_amdgcn_sched_barrier(0);
    if (t < my_nt) {
      const char* kb = lds + BLK_K + (t & 3) * 16384 + m * 8192;
      f32x16 S0, S1;
#pragma unroll
      for (int e = 0; e < 16; ++e) { S0[e] = 0.f; S1[e] = 0.f; }
      bf16x8 ka[4], kc[4];
#pragma unroll
      for (int s = 0; s < 4; ++s) {
        const int co = (((2 * s + h) ^ swk) << 4);
        ka[s] = *(const bf16x8*)(kb + rr * 128 + co);
        kc[s] = *(const bf16x8*)(kb + (32 + rr) * 128 + co);
      }
#pragma unroll
      for (int s = 0; s < 4; ++s) {
        S0 = MFMA(ka[s], qf[s], S0);
        S1 = MFMA(kc[s], qf[s], S1);
      }
      f2 tv[16];
      const f2 cc = {SM_C, SM_C};
#pragma unroll
      for (int e = 0; e < 8; ++e) {
        f2 a = {S0[2 * e], S0[2 * e + 1]}; tv[e] = a * cc;
        f2 c = {S1[2 * e], S1[2 * e + 1]}; tv[8 + e] = c * cc;
      }
      float mx = fmaxf(tv[0].x, tv[0].y);
#pragma unroll
      for (int e = 1; e < 16; ++e) mx = fmaxf(mx, fmaxf(tv[e].x, tv[e].y));
      mx = half_max(mx);
      if (__any(mx > Mx + 8.f)) {
        const float mn = fmaxf(Mx, mx);
        const float al = __builtin_amdgcn_exp2f(Mx - mn);
        Mx = mn; L2 *= al;
#pragma unroll
        for (int dt = 0; dt < 4; ++dt)
#pragma unroll
          for (int e = 0; e < 16; ++e) O[dt][e] *= al;
      }
      const f2 nm = {-Mx, -Mx};
#pragma unroll
      for (int e = 0; e < 16; ++e) {
        f2 d = tv[e] + nm;
        d.x = __builtin_amdgcn_exp2f(d.x); d.y = __builtin_amdgcn_exp2f(d.y);
        L2 += d;
        tv[e] = d;
      }
#pragma unroll
      for (int s2 = 0; s2 < 4; ++s2) {
        uint4 pa;
        pa.x = pk2(tv[4 * s2].x, tv[4 * s2].y); pa.y = pk2(tv[4 * s2 + 1].x, tv[4 * s2 + 1].y);
        pa.z = pk2(tv[4 * s2 + 2].x, tv[4 * s2 + 2].y); pa.w = pk2(tv[4 * s2 + 3].x, tv[4 * s2 + 3].y);
        pf[s2] = __builtin_bit_cast(bf16x8, pa);
      }
      if (!late) {
        const char* vb = lds + BLK_V + (t & 3) * 16384;
#pragma unroll
        for (int ks = 0; ks < 4; ++ks) {
          const int co = (((2 * ks + h) ^ swv) << 4);
#pragma unroll
          for (int dt = 0; dt < 4; ++dt) {
            bf16x8 v = *(const bf16x8*)(vb + (32 * dt + r) * 128 + co);
            O[dt] = MFMA(v, pf[ks], O[dt]);
          }
        }
      }
    }
    if (t + 2 < nt) {
      const int sl = ((t + 2) & 3) * 16384;
      wait_vm0();
      *(uint4*)(lds + lk + sl) = sk0; *(uint4*)(lds + lk + sl + 4096) = sk1;
      *(uint4*)(lds + lv + sl) = sv0; *(uint4*)(lds + lv + sl + 8192) = sv1;
    }
    if (t & 1) __syncthreads();
  }
  float L = L2.x + L2.y;
  L += __shfl_xor(L, 32);
  attnB_epilogue(p, O, L, b * SEQ + q0, hb, lam, (float*)(lds + BLK_XCH));
}

DI float phase2_setup(const Params& p, char* lds) {
  const int tid = threadIdx.x, lane = tid & 63;
  float* bias = (float*)(lds + LDS_BIAS);
  for (int i = tid; i < 8 * 257; i += 512) { int hh = i / 257, k = i - hh * 257; bias[hh * 260 + k] = p.rel_bias[i] * 1.4426950408889634f; }
  float a = p.lq1[lane] * p.lk1[lane], b = p.lq2[lane] * p.lk2[lane];
  a = wave_sum(a); b = wave_sum(b);
  __syncthreads();
  return expf(a) - expf(b) + 0.2f;
}
DI void p3_tile(const Params& p, char* lds, int tok0) {
  int tid = threadIdx.x;
  asm volatile("" : "+v"(tid));
  const int lane = tid & 63, w = tid >> 6, r = lane & 31, h = lane >> 5;
  const u16* OB = (const u16*)(p.ws + WS_HN);
  float* red = (float*)(lds + 131072);
  __syncthreads();
#pragma unroll
  for (int half = 0; half < 2; ++half) {
    uint4 a[8];
#pragma unroll
    for (int it = 0; it < 8; ++it) a[it] = *(const uint4*)(OB + (size_t)(tok0 + half * 32 + it * 4 + (tid >> 7)) * 1024 + (tid & 127) * 8);
#pragma unroll
    for (int it = 0; it < 8; ++it) {
      const int row = half * 32 + it * 4 + (tid >> 7);
      *(uint4*)(lds + row * 2048 + ((((tid & 127) ^ (row & 15))) << 4)) = a[it];
    }
  }
  f32x16 acc[2][4];
#pragma unroll
  for (int i = 0; i < 2; ++i)
#pragma unroll
    for (int j = 0; j < 4; ++j)
#pragma unroll
      for (int e = 0; e < 16; ++e) acc[i][j][e] = 0.f;
  const char* wp = p.ws + WS_WOUTT + ((size_t)(w * 4) * 4096 + lane) * 16;
  const char* ap = lds + r * 2048;
  const int akey = r & 15;
  uint4 bq[4][4];
#pragma unroll
  for (int s = 0; s < 4; ++s)
#pragma unroll
    for (int j = 0; j < 4; ++j) gld16(bq[s][j], wp + (size_t)(j * 4096 + s * 64) * 16);
  __syncthreads();
#define P3_KSTEP(KS, SLOT, WAITN, REFILL)                                                        \
  {                                                                                              \
    const int co_ = ((((2 * (KS) + h) ^ akey)) << 4);                                            \
    const bf16x8 a0_ = *(const bf16x8*)(ap + co_);                                               \
    const bf16x8 a1_ = *(const bf16x8*)(ap + 65536 + co_);                                       \
    WAIT_VM(WAITN);                                                                              \
    __builtin_amdgcn_sched_barrier(0);                                                           \
    __builtin_amdgcn_s_setprio(1);                                                               \
    _Pragma("unroll") for (int j = 0; j < 4; ++j) {                                              \
      const bf16x8 bf_ = __builtin_bit_cast(bf16x8, bq[SLOT][j]);                                \
      acc[0][j] = MFMA(a0_, bf_, acc[0][j]);                                                     \
      acc[1][j] = MFMA(a1_, bf_, acc[1][j]);                                                     \
    }                                                                                            \
    __builtin_amdgcn_s_setprio(0);                                                               \
    __builtin_amdgcn_sched_barrier(0);                                                           \
    if (REFILL) {                                                                                \
      _Pragma("unroll") for (int j = 0; j < 4; ++j) gld16(bq[SLOT][j], wp + (size_t)(j * 4096 + ((KS) + 4) * 64) * 16); \
    }                                                                                            \
    __builtin_amdgcn_sched_barrier(0);                                                           \
  }
#pragma unroll 1
  for (int g = 0; g < 15; ++g) {
    P3_KSTEP(4 * g, 0, 12, true)
    P3_KSTEP(4 * g + 1, 1, 12, true)
    P3_KSTEP(4 * g + 2, 2, 12, true)
    P3_KSTEP(4 * g + 3, 3, 12, true)
  }
  P3_KSTEP(60, 0, 12, false)
  P3_KSTEP(61, 1, 8, false)
  P3_KSTEP(62, 2, 4, false)
  P3_KSTEP(63, 3, 0, false)
  WAIT_VM(0);
  const float* xr = tok0 < NTOKP ? p.x_prompt + (size_t)tok0 * 1024 : p.x_sample + (size_t)(tok0 - NTOKP) * 1024;
  const unsigned cb = w * 128 + r;
#pragma unroll
  for (int i = 0; i < 2; ++i) {
#pragma unroll
    for (int e = 0; e < 16; ++e) {
      const int row = 32 * i + 8 * (e >> 2) + 4 * h + (e & 3);
      unsigned off = row * 1024 + cb;
      asm volatile("" : "+v"(off));
      float ssv = 0.f;
#pragma unroll
      for (int j = 0; j < 4; ++j) {
        const float y = acc[i][j][e] + xr[off + j * 32];
        acc[i][j][e] = y; ssv += y * y;
      }
      ssv += __shfl_xor(ssv, 1); ssv += __shfl_xor(ssv, 2); ssv += __shfl_xor(ssv, 4); ssv += __shfl_xor(ssv, 8); ssv += __shfl_xor(ssv, 16);
      if (r == 0) red[w * 64 + row] = ssv;
      if ((e & 3) == 3) __builtin_amdgcn_sched_barrier(0);
    }
  }
  __syncthreads();
  if (tid < 64) {
    float t = 0.f;
#pragma unroll
    for (int k = 0; k < 8; ++k) t += red[k * 64 + tid];
    red[512 + tid] = rsqrtf(t * (1.f / 1024.f) + 1e-6f);
  }
  __syncthreads();
  float* yr = p.out + O_YP + (size_t)tok0 * 1024;
  float gj[4];
#pragma unroll
  for (int j = 0; j < 4; ++j) gj[j] = p.final_gain[cb + j * 32];
#pragma unroll
  for (int i = 0; i < 2; ++i) {
#pragma unroll
    for (int e = 0; e < 16; ++e) {
      const int row = 32 * i + 8 * (e >> 2) + 4 * h + (e & 3);
      unsigned off = row * 1024 + cb;
      asm volatile("" : "+v"(off));
      const float ri = red[512 + row];
#pragma unroll
      for (int j = 0; j < 4; ++j) yr[off + j * 32] = acc[i][j][e] * ri * gj[j];
      if ((e & 3) == 3) __builtin_amdgcn_sched_barrier(0);
    }
  }
}

constexpr int NQUEUE = 14;
DI int q_pop(unsigned* ctr, int* slot) {
  __syncthreads();
  if (threadIdx.x == 0) *slot = (int)__hip_atomic_fetch_add(ctr, 1u, __ATOMIC_RELAXED, __HIP_MEMORY_SCOPE_AGENT);
  __syncthreads();
  return *slot;
}
DI void p2_all(const Params& p, char* lds, float lam) {
  const int w = threadIdx.x >> 6;
  unsigned* Q = (unsigned*)(p.ws + WS_QUEUE);
  int* slot = (int*)(lds + LDS_BIAS + 8320);
  float* xch = (float*)(lds + 65536);
  const float* bias = (const float*)(lds + LDS_BIAS);
  const u16* QA = (const u16*)(p.ws + WS_QA);
  const u16* QB = (const u16*)(p.ws + WS_QB);
#pragma unroll 1
  for (;;) {
    const int i = q_pop(Q + 64 * 12, slot);
    if (i >= 32) break;
    p1_dispatch<2>(p, lds, 64, i * 128);
    asm volatile("s_waitcnt vmcnt(0)" ::: "memory");
    __syncthreads();
    if (threadIdx.x == 0) {
      __builtin_amdgcn_fence(__ATOMIC_RELEASE, "agent");
      __hip_atomic_fetch_add(Q + 64 * 13, 1u, __ATOMIC_RELAXED, __HIP_MEMORY_SCOPE_AGENT);
    }
  }
  {
    const int it = q_pop(Q, slot);
    if (it < 16) {
      if (threadIdx.x == 0) {
        while (__hip_atomic_load(Q + 64 * 13, __ATOMIC_RELAXED, __HIP_MEMORY_SCOPE_AGENT) < 32u) __builtin_amdgcn_s_sleep(2);
        __builtin_amdgcn_fence(__ATOMIC_ACQUIRE, "agent");
      }
      __syncthreads();
    }
    if (it < 8) {
      const int m = w >> 2, wsub = w & 3, id = it * 4 + wsub, b = id >> 2, hb = id & 3;
      attnB_item(p, QB + (size_t)(NTOKP + b * 32) * 512 + hb * 128 + m * 64,
                 (const u16*)(p.ws + WS_KBS) + (size_t)(b * 1056) * 512 + hb * 128 + m * 64,
                 (const u16*)(p.ws + WS_VBTS) + (size_t)(b * 512 + hb * 128) * 1056, 1056, 33, NTOKP + b * 32, hb, lam, xch);
    } else if (it < 16) {
      const int b = it - 8;
      attnA_item<1>(p, QA + (size_t)(NTOKP + b * 32) * 512 + w * 64,
                    (const u16*)(p.ws + WS_KAS) + (size_t)(b * 544) * 512 + w * 64,
                    (const u16*)(p.ws + WS_VATS) + (size_t)(b * 512 + w * 64) * 544, 544, 17, 512, bias + w * 260,
                    NTOKP + b * 32, w);
    }
    if (it < 16) {
      asm volatile("s_waitcnt vmcnt(0)" ::: "memory");
      __syncthreads();
      if (threadIdx.x == 0) {
        __builtin_amdgcn_fence(__ATOMIC_RELEASE, "agent");
        __hip_atomic_fetch_add(Q + 64 * 11, 1u, __ATOMIC_RELAXED, __HIP_MEMORY_SCOPE_AGENT);
      }
    }
  }
  bool didA = false;
  int k = 0;
#pragma unroll 1
  for (;;) {
    int i = q_pop(Q + 64 * (1 + ((blockIdx.x + k) & 7)), slot);
    if (i >= 64) { if (++k < 8) continue; i = -1; }
    if ((i < 0 || i >= 40) && !didA) {
      didA = true;
#pragma unroll 1
      for (;;) {
        const int it = q_pop(Q + 64 * 10, slot);
        if (it >= 4) break;
        if (threadIdx.x == 0) {
          while (__hip_atomic_load(Q + 64 * 11, __ATOMIC_RELAXED, __HIP_MEMORY_SCOPE_AGENT) < 16u) __builtin_amdgcn_s_sleep(2);
          __builtin_amdgcn_fence(__ATOMIC_ACQUIRE, "agent");
        }
        __syncthreads();
        p3_tile(p, lds, NTOKP + it * 64);
      }
#pragma unroll 1
      for (;;) {
        const int it = q_pop(Q + 64 * 9, slot);
        if (it >= 256) break;
        const int b = it >> 7, c = it & 127, cs = c > 8 ? c - 8 : 0;
        int tl = threadIdx.x;
        asm volatile("" : "+v"(tl));
        const int ww = tl >> 6;
        attnA_item<2>(p, (const u16*)(p.ws + WS_QA) + (size_t)(b * SEQ + c * 64) * 512 + ww * 64,
                      (const u16*)(p.ws + WS_KA) + (size_t)(b * SEQ + cs * 64) * 512 + ww * 64,
                      (const u16*)(p.ws + WS_VAT) + (size_t)(b * 512 + ww * 64) * SEQ + cs * 64, SEQ,
                      (c + 1 - cs) * 2, 64 * (c - cs), (const float*)(lds + LDS_BIAS) + ww * 260, b * SEQ + c * 64, ww);
      }
    }
    if (i < 0) break;
    const int x = (blockIdx.x + k) & 7;
    attnB_block(p, x >> 2, x & 3, 63 - i, lam, lds);
  }
}

DI void phase4(const Params& p) {
  const int lane = threadIdx.x & 63, w = threadIdx.x >> 6;
  for (int row = blockIdx.x * 8 + w; row < NTOK; row += gridDim.x * 8) {
    float* y = p.out + O_YP + (size_t)row * 1024;
    float4 v[4]; float ss = 0.f;
#pragma unroll
    for (int it = 0; it < 4; ++it) { v[it] = *(const float4*)(y + it * 256 + lane * 4); ss += v[it].x * v[it].x + v[it].y * v[it].y + v[it].z * v[it].z + v[it].w * v[it].w; }
    ss = wave_sum(ss);
    const float inv = rsqrtf(ss * (1.f / 1024.f) + 1e-6f);
#pragma unroll
    for (int it = 0; it < 4; ++it) {
      float4 g = *(const float4*)(p.final_gain + it * 256 + lane * 4);
      *(float4*)(y + it * 256 + lane * 4) = make_float4(v[it].x * inv * g.x, v[it].y * inv * g.y, v[it].z * inv * g.z, v[it].w * inv * g.w);
    }
  }
}

__global__ void __launch_bounds__(512) fwd_megakernel(Params p) {
  __shared__ __attribute__((aligned(16))) char lds[155904];
  cg::grid_group grid = cg::this_grid();
  unsigned* ctr = (unsigned*)(p.ws + WS_BAR);
  const unsigned G = gridDim.x;
  if (p.out == nullptr) grid.sync();
  phase0(p, lds);
  ctr_barrier(ctr, G);
  phase1(p, lds);
  ctr_barrier(ctr, 2 * G);
  {
    const float lam = phase2_setup(p, lds);
    p2_all(p, lds, lam);
  }
  ctr_barrier(ctr, 3 * G);
  for (int t = blockIdx.x; t < 256; t += gridDim.x) p3_tile(p, lds, t * 64);
}

extern "C" void kernel_launch(void* const* d_in, const int* in_sizes, int n_in, void* d_out, int out_size, void* d_ws,
                              size_t ws_size, hipStream_t stream) {
  static int grid_blocks = 0;
  if (!grid_blocks) {
    int dev = 0, cus = 0, per_cu = 0;
    hipGetDevice(&dev);
    hipDeviceGetAttribute(&cus, hipDeviceAttributeMultiprocessorCount, dev);
    hipOccupancyMaxActiveBlocksPerMultiprocessor(&per_cu, fwd_megakernel, 512, 0);
    if (per_cu < 1) per_cu = 1;
    grid_blocks = cus;
  }
  Params p{};
  p.x_prompt = (const float*)d_in[0]; p.x_sample = (const float*)d_in[1];
  p.cache_a_k = (const float*)d_in[2]; p.cache_a_v = (const float*)d_in[3];
  p.cache_b_k = (const float*)d_in[4]; p.cache_b_v = (const float*)d_in[5];
  p.norm_gain = (const float*)d_in[6]; p.w_in = (const float*)d_in[7]; p.w_out = (const float*)d_in[8];
  p.rel_bias = (const float*)d_in[9];
  p.lq1 = (const float*)d_in[10]; p.lk1 = (const float*)d_in[11]; p.lq2 = (const float*)d_in[12]; p.lk2 = (const float*)d_in[13];
  p.subln = (const float*)d_in[14]; p.final_gain = (const float*)d_in[15];
  p.out = (float*)d_out; p.ws = (char*)d_ws;
  void* args[] = {&p};
  (void)hipMemsetAsync((char*)d_ws + WS_BAR, 0, 12288, stream);
  hipError_t e = hipLaunchCooperativeKernel((void*)fwd_megakernel, dim3(grid_blocks), dim3(512), args, 0, stream);
  if (e != hipSuccess) fprintf(stderr, "cooperative launch failed: %s (grid %d)\n", hipGetErrorString(e), grid_blocks);
}
```

```cpp
#include <hip/hip_runtime.h>
#include <hip/hip_cooperative_groups.h>
#include <cstdio>
namespace cg = cooperative_groups;

typedef short bf16x8 __attribute__((ext_vector_type(8)));
typedef float f32x16 __attribute__((ext_vector_type(16)));
typedef __bf16 bf2_t __attribute__((ext_vector_type(2)));
typedef float f2_t __attribute__((ext_vector_type(2)));
typedef unsigned u32;
typedef unsigned short u16;
#define DI __device__ __forceinline__
#define MFMA(a, b, c) __builtin_amdgcn_mfma_f32_32x32x16_bf16((a), (b), (c), 0, 0, 0)

constexpr int NTOKP = 16384;
constexpr int NTOK = 16640;
constexpr int SEQ = 8192;
constexpr size_t O_YP = 0;
constexpr size_t O_AKP = 17039360, O_AVP = 17563648, O_BKP = 18087936, O_BVP = 26476544;
constexpr size_t O_AKS = 34865152, O_AVS = 36962304, O_BKS = 39059456, O_BVS = 39190528;
constexpr size_t WS_WINT = 0;
constexpr size_t WS_WOUTT = WS_WINT + 8388608;
constexpr size_t WS_HN = WS_WOUTT + 2097152;
constexpr size_t WS_QA = WS_HN + 34078720;
constexpr size_t WS_KA = WS_QA + 17039360;
constexpr size_t WS_KAS = WS_KA + 16777216;
constexpr size_t WS_VAT = WS_KAS + 4456448;
constexpr size_t WS_VATS = WS_VAT + 16777216;
constexpr size_t WS_GA = WS_VATS + 4456448;
constexpr size_t WS_QB = WS_GA + 17039360;
constexpr size_t WS_KB = WS_QB + 17039360;
constexpr size_t WS_KBS = WS_KB + 16777216;
constexpr size_t WS_VBT = WS_KBS + 8650752;
constexpr size_t WS_VBTS = WS_VBT + 16777216;
constexpr size_t WS_GB = WS_VBTS + 8650752;
constexpr size_t WS_ROPE = WS_GB + 17039360;
constexpr size_t WS_BAR = WS_ROPE + 524288;
constexpr size_t WS_QUEUE = WS_BAR + 4096;
constexpr size_t WS_END = WS_QUEUE + 8192;

struct Params {
  const float* x_prompt; const float* x_sample;
  const float* cache_a_k; const float* cache_a_v; const float* cache_b_k; const float* cache_b_v;
  const float* norm_gain; const float* w_in; const float* w_out; const float* rel_bias;
  const float* lq1; const float* lk1; const float* lq2; const float* lk2;
  const float* subln; const float* final_gain;
  float* out; char* ws;
};

DI u32 pk2(float a, float b) { f2_t v = {a, b}; bf2_t r = __builtin_convertvector(v, bf2_t); return __builtin_bit_cast(u32, r); }
DI float bflo(u32 v) { return __uint_as_float(v << 16); }
DI float bfhi(u32 v) { return __uint_as_float(v & 0xffff0000u); }
DI int rho(int r) { return (r & ~12) | ((r & 4) << 1) | ((r & 8) >> 1); }
DI void gld16(uint4& dst, const void* p) { asm volatile("global_load_dwordx4 %0, %1, off" : "=v"(dst) : "v"(p) : "memory"); }
#define WAIT_VM(n) asm volatile("s_waitcnt vmcnt(" #n ")" ::: "memory")
DI void wait_vm0() { asm volatile("s_waitcnt vmcnt(0)" ::: "memory"); }
DI float wave_sum(float v) {
#pragma unroll
  for (int o = 32; o > 0; o >>= 1) v += __shfl_xor(v, o);
  return v;
}


DI void ctr_barrier(unsigned* ctr, unsigned target) {
  __syncthreads();
  if (threadIdx.x == 0) {
    __builtin_amdgcn_fence(__ATOMIC_RELEASE, "agent");
    __hip_atomic_fetch_add(ctr, 1u, __ATOMIC_RELAXED, __HIP_MEMORY_SCOPE_AGENT);
    while (__hip_atomic_load(ctr, __ATOMIC_RELAXED, __HIP_MEMORY_SCOPE_AGENT) < target) __builtin_amdgcn_s_sleep(1);
    __builtin_amdgcn_fence(__ATOMIC_ACQUIRE, "agent");
  }
  __syncthreads();
}

DI void phase0(const Params& p, char* lds) {
  const int tid = threadIdx.x, bid = blockIdx.x, nb = gridDim.x;
  const int lane = tid & 63, w = tid >> 6;
  float* tile = (float*)lds;
  for (int i = bid * 512 + tid; i < 131072; i += nb * 512) {
    const int ln = i & 63, s_ = (i >> 6) & 63, ct = i >> 12, r_ = ln & 31, h_ = ln >> 5;
    float v[8];
#pragma unroll
    for (int j = 0; j < 8; ++j) v[j] = p.w_out[(size_t)(16 * s_ + 8 * h_ + j) * 1024 + ct * 32 + r_];
    uint4 o; o.x = pk2(v[0], v[1]); o.y = pk2(v[2], v[3]); o.z = pk2(v[4], v[5]); o.w = pk2(v[6], v[7]);
    *(uint4*)(p.ws + WS_WOUTT + (size_t)i * 16) = o;
  }
  for (int t = bid; t < 1024; t += nb) {
    const float* W; u16* WT; int N, kt, nt;
    { W = p.w_in; WT = (u16*)(p.ws + WS_WINT); N = 4096; kt = t >> 6; nt = t & 63; }
#pragma unroll
    for (int it = 0; it < 8; ++it) {
      int idx = it * 512 + tid, kk = idx >> 6, nn = idx & 63;
      tile[kk * 65 + nn] = W[(size_t)(kt * 64 + kk) * N + nt * 64 + nn];
    }
    __syncthreads();
    {
      int n = tid >> 3, kg = tid & 7;
      float v[8];
#pragma unroll
      for (int j = 0; j < 8; ++j) v[j] = tile[(kg * 8 + j) * 65 + n];
      uint4 o; o.x = pk2(v[0], v[1]); o.y = pk2(v[2], v[3]); o.z = pk2(v[4], v[5]); o.w = pk2(v[6], v[7]);
      *(uint4*)(WT + (size_t)(nt * 64 + n) * 1024 + kt * 64 + kg * 8) = o;
    }
    __syncthreads();
  }
  {
    u16* HN = (u16*)(p.ws + WS_HN);
    for (int row = bid * 8 + w; row < NTOK; row += nb * 16) {
      const int row1 = row + nb * 8 < NTOK ? row + nb * 8 : row;
      const float* s0 = row < NTOKP ? p.x_prompt + (size_t)row * 1024 : p.x_sample + (size_t)(row - NTOKP) * 1024;
      const float* s1 = row1 < NTOKP ? p.x_prompt + (size_t)row1 * 1024 : p.x_sample + (size_t)(row1 - NTOKP) * 1024;
      float4 v[4], u[4]; float ss = 0.f, st = 0.f;
#pragma unroll
      for (int it = 0; it < 4; ++it) { v[it] = *(const float4*)(s0 + it * 256 + lane * 4); u[it] = *(const float4*)(s1 + it * 256 + lane * 4); }
#pragma unroll
      for (int it = 0; it < 4; ++it) {
        ss += v[it].x * v[it].x + v[it].y * v[it].y + v[it].z * v[it].z + v[it].w * v[it].w;
        st += u[it].x * u[it].x + u[it].y * u[it].y + u[it].z * u[it].z + u[it].w * u[it].w;
      }
      ss = wave_sum(ss); st = wave_sum(st);
      const float inv = rsqrtf(ss * (1.f / 1024.f) + 1e-6f), inu = rsqrtf(st * (1.f / 1024.f) + 1e-6f);
#pragma unroll
      for (int it = 0; it < 4; ++it) {
        float4 g = *(const float4*)(p.norm_gain + it * 256 + lane * 4);
        uint2 o; o.x = pk2(v[it].x * inv * g.x, v[it].y * inv * g.y); o.y = pk2(v[it].z * inv * g.z, v[it].w * inv * g.w);
        *(uint2*)(HN + (size_t)row * 1024 + it * 256 + lane * 4) = o;
        o.x = pk2(u[it].x * inu * g.x, u[it].y * inu * g.y); o.y = pk2(u[it].z * inu * g.z, u[it].w * inu * g.w);
        *(uint2*)(HN + (size_t)row1 * 1024 + it * 256 + lane * 4) = o;
      }
    }
  }
  const int gt = bid * 512 + tid, gn = nb * 512;
  {
    u16* KAS = (u16*)(p.ws + WS_KAS);
#pragma unroll 4
    for (int i = gt; i < 524288; i += gn) {
      int e = i * 4, b = e >> 18, key = (e >> 9) & 511, f = e & 511;
      float4 v = *(const float4*)(p.cache_a_k + e);
      uint2 o; o.x = pk2(v.x, v.y); o.y = pk2(v.z, v.w);
      *(uint2*)(KAS + (size_t)(b * 544 + key) * 512 + f) = o;
      if (key >= 32) *(float4*)(p.out + O_AKS + (size_t)(b * 512 + key - 32) * 512 + f) = v;
    }
    u16* KBS = (u16*)(p.ws + WS_KBS);
#pragma unroll 4
    for (int i = gt; i < 1048576; i += gn) {
      int e = i * 4, b = e >> 19, key = (e >> 9) & 1023, f = e & 511;
      float4 v = *(const float4*)(p.cache_b_k + e);
      uint2 o; o.x = pk2(v.x, v.y); o.y = pk2(v.z, v.w);
      *(uint2*)(KBS + (size_t)(b * 1056 + key) * 512 + f) = o;
    }
    u16* VATS = (u16*)(p.ws + WS_VATS);
#pragma unroll 2
    for (int i = gt; i < 262144; i += gn) {
      int f = i & 511, kg = (i >> 9) & 63, b = i >> 15;
      float v[8];
#pragma unroll
      for (int j = 0; j < 8; ++j) v[j] = p.cache_a_v[(size_t)(b * 512 + kg * 8 + j) * 512 + f];
      uint4 o; o.x = pk2(v[0], v[1]); o.y = pk2(v[2], v[3]); o.z = pk2(v[4], v[5]); o.w = pk2(v[6], v[7]);
      *(uint4*)(VATS + (size_t)(b * 512 + f) * 544 + kg * 8) = o;
      if (kg >= 4) {
#pragma unroll
        for (int j = 0; j < 8; ++j) p.out[O_AVS + (size_t)(b * 512 + kg * 8 + j - 32) * 512 + f] = v[j];
      }
    }
    u16* VBTS = (u16*)(p.ws + WS_VBTS);
#pragma unroll 2
    for (int i = gt; i < 524288; i += gn) {
      int f = i & 511, kg = (i >> 9) & 127, b = i >> 16;
      float v[8];
#pragma unroll
      for (int j = 0; j < 8; ++j) v[j] = p.cache_b_v[(size_t)(b * 1024 + kg * 8 + j) * 512 + f];
      uint4 o; o.x = pk2(v[0], v[1]); o.y = pk2(v[2], v[3]); o.z = pk2(v[4], v[5]); o.w = pk2(v[6], v[7]);
      *(uint4*)(VBTS + (size_t)(b * 512 + f) * 1056 + kg * 8) = o;
    }
  }
  {
    float2* RT = (float2*)(p.ws + WS_ROPE);
    for (int i = gt; i < 65536; i += gn) {
      int pos = i >> 3, m = i & 7;
      float inv = powf(500000.f, -(float)m * 0.125f);
      float ang = (float)pos * inv;
      RT[i] = make_float2(cosf(ang), sinf(ang));
    }
  }
}

template <int NJ>
DI void gemm_mainloop(const u16* __restrict__ A, const u16* __restrict__ Bt, int row0, int col0, char* lds, f32x16 (&acc)[2][NJ]) {
  constexpr int STAGE = 32768 + NJ * 8192;
  int tid = threadIdx.x;
  asm volatile("" : "+v"(tid));
  const int lane = tid & 63, w = tid >> 6, wm = w >> 1, wn = w & 1;
  const int r = lane & 31, h = lane >> 5;
  const u16* pa = A + (size_t)(row0 + (tid >> 3)) * 1024 + (tid & 7) * 8;
  const u16* pb = Bt + (size_t)(col0 + (tid >> 3)) * 1024 + (tid & 7) * 8;
  const int wofs = (tid >> 3) * 128 + ((((tid & 7) ^ ((tid >> 4) & 7))) << 4);
  const int swr = (r >> 1) & 7;
#pragma unroll
  for (int i = 0; i < 2; ++i)
#pragma unroll
    for (int j = 0; j < NJ; ++j)
#pragma unroll
      for (int e = 0; e < 16; ++e) acc[i][j][e] = 0.f;
  uint4 ra[4], rb[NJ];
#define GM_ISSUE(KB)                                                                          \
  { _Pragma("unroll") for (int it = 0; it < 4; ++it) gld16(ra[it], pa + (size_t)it * 65536 + (KB) * 64); \
    _Pragma("unroll") for (int it = 0; it < NJ; ++it) gld16(rb[it], pb + (size_t)it * 65536 + (KB) * 64); }
#define GM_PARK(ST)                                                                           \
  { char* bw_ = lds + (ST) * STAGE;                                                           \
    _Pragma("unroll") for (int it = 0; it < 4; ++it) *(uint4*)(bw_ + it * 8192 + wofs) = ra[it]; \
    _Pragma("unroll") for (int it = 0; it < NJ; ++it) *(uint4*)(bw_ + 32768 + it * 8192 + wofs) = rb[it]; }
  GM_ISSUE(0)
  WAIT_VM(0);
  GM_PARK(0)
  __syncthreads();
#pragma unroll 1
  for (int kt = 0; kt < 16; ++kt) {
    if (kt + 1 < 16) GM_ISSUE(kt + 1)
    __builtin_amdgcn_sched_barrier(0);
    const char* ba = lds + (kt & 1) * STAGE;
    const char* bb = ba + 32768;
    bf16x8 hf[2][2], wf[NJ];
    {
      const int co = ((h ^ swr) << 4);
#pragma unroll
      for (int i = 0; i < 2; ++i) hf[0][i] = *(const bf16x8*)(ba + (wm * 64 + i * 32 + r) * 128 + co);
#pragma unroll
      for (int j = 0; j < NJ; ++j) wf[j] = *(const bf16x8*)(bb + (wn * 32 * NJ + j * 32 + r) * 128 + co);
    }
#pragma unroll
    for (int s = 0; s < 4; ++s) {
      const int co = (((2 * (s + 1) + h) ^ swr) << 4);
      if (s < 3) {
#pragma unroll
        for (int i = 0; i < 2; ++i) hf[(s + 1) & 1][i] = *(const bf16x8*)(ba + (wm * 64 + i * 32 + r) * 128 + co);
      }
      __builtin_amdgcn_s_setprio(1);
#pragma unroll
      for (int j = 0; j < NJ; ++j) {
        acc[0][j] = MFMA(hf[s & 1][0], wf[j], acc[0][j]);
        acc[1][j] = MFMA(hf[s & 1][1], wf[j], acc[1][j]);
        if (s < 3) wf[j] = *(const bf16x8*)(bb + (wn * 32 * NJ + j * 32 + r) * 128 + co);
      }
      __builtin_amdgcn_s_setprio(0);
      __builtin_amdgcn_sched_barrier(0);
      if (kt + 1 < 16 && s == 1) {
        asm volatile("s_waitcnt vmcnt(%0)" :: "n"(NJ) : "memory");
        char* bw_ = lds + ((kt + 1) & 1) * STAGE;
#pragma unroll
        for (int it = 0; it < 4; ++it) *(uint4*)(bw_ + it * 8192 + wofs) = ra[it];
        __builtin_amdgcn_sched_barrier(0);
      }
      if (kt + 1 < 16 && s == 2) {
        WAIT_VM(0);
        char* bw_ = lds + ((kt + 1) & 1) * STAGE;
#pragma unroll
        for (int it = 0; it < NJ; ++it) *(uint4*)(bw_ + 32768 + it * 8192 + wofs) = rb[it];
        __builtin_amdgcn_sched_barrier(0);
      }
    }
    __syncthreads();
  }
#undef GM_ISSUE
#undef GM_PARK
}

DI float silu(float x) { return x * __builtin_amdgcn_rcpf(1.f + __expf(-x)); }

DI float dpp_x1(float v) { return __int_as_float(__builtin_amdgcn_update_dpp(0, __float_as_int(v), 0xB1, 0xF, 0xF, true)); }
DI float dpp_x8(float v) { return __int_as_float(__builtin_amdgcn_update_dpp(0, __float_as_int(v), 0x128, 0xF, 0xF, true)); }
DI void store_bf16_tile(const f32x16& a, u16* base  , size_t ld, int h, int odd) {
#pragma unroll
  for (int g = 0; g < 4; ++g)
#pragma unroll
    for (int e = 0; e < 4; e += 2) {
      const float v0 = a[4 * g + e], v1 = a[4 * g + e + 1];
      const float n0 = dpp_x1(v0), n1 = dpp_x1(v1);
      const u32 o = odd ? pk2(n1, v1) : pk2(v0, n0);
      *(u32*)(base + (size_t)(8 * g + 4 * h + e + odd) * ld) = o;
      if (e == 2) __builtin_amdgcn_sched_barrier(0);
    }
}
template <int NJ, int sec>
DI void p1_tile(const Params& p, char* lds, int tm, int col0) {
  constexpr int WN = 32 * NJ;
  const u16* HN = (const u16*)(p.ws + WS_HN);
  const u16* WT = (const u16*)(p.ws + WS_WINT);
  const float2* RT = (const float2*)(p.ws + WS_ROPE);
  const int fbase = col0 & 511;
  const bool sample = (tm == 64);
  f32x16 acc[2][NJ];
  gemm_mainloop<NJ>(HN, WT, tm * 256, col0, lds, acc);
  int tid = threadIdx.x;
  asm volatile("" : "+v"(tid));
  const int lane = tid & 63, w = tid >> 6, wm = w >> 1, wn = w & 1;
  const int r = lane & 31, h = lane >> 5, odd = r & 1;
  const int tb = tm * 256 + wm * 64;
  const int fb = fbase + wn * WN;
  if (sec == 2 || sec == 6) {
#pragma unroll
    for (int i = 0; i < 2; ++i) {
      float* dbase = nullptr;
      {
        const int t0 = tb + i * 32;
        if (!sample) {
          const int b = t0 >> 13, s0 = t0 & 8191;
          if (sec == 6) dbase = p.out + O_BVP + (size_t)t0 * 512;
          else if (s0 >= 7680) dbase = p.out + O_AVP + ((size_t)(b * 512 + s0 - 7680)) * 512;
        } else {
          const int ts = t0 - NTOKP, b = ts >> 5;
          if (sec == 6) dbase = p.out + O_BVS + (size_t)ts * 512;
          else dbase = p.out + O_AVS + ((size_t)(b * 512 + 480)) * 512;
        }
      }
#pragma unroll
      for (int j = 0; j < NJ; ++j) {
        unsigned lo = (wn * WN + j * 32 + r) * 528 + (wm * 64 + i * 32 + 4 * h) * 2;
        asm volatile("" : "+v"(lo));
#pragma unroll
        for (int g = 0; g < 4; ++g) {
          const float v0 = acc[i][j][4 * g], v1 = acc[i][j][4 * g + 1], v2 = acc[i][j][4 * g + 2], v3 = acc[i][j][4 * g + 3];
          uint2 o; o.x = pk2(v0, v1); o.y = pk2(v2, v3);
          *(uint2*)(lds + lo + g * 16) = o;
          if (dbase) {
            unsigned off = (8 * g + 4 * h) * 512 + fb + j * 32 + r;
            asm volatile("" : "+v"(off));
            dbase[off] = v0; dbase[off + 512] = v1; dbase[off + 1024] = v2; dbase[off + 1536] = v3;
          }
          __builtin_amdgcn_sched_barrier(0);
        }
      }
    }
    __syncthreads();
    {
      u16* VT; size_t ldv;
      if (sec == 2) { VT = (u16*)(p.ws + (sample ? WS_VATS : WS_VAT)); ldv = sample ? 544 : 8192; }
      else { VT = (u16*)(p.ws + (sample ? WS_VBTS : WS_VBT)); ldv = sample ? 1056 : 8192; }
      const int sofs = sample ? (sec == 2 ? 512 : 1024) : 0;
#pragma unroll
      for (int it = 0; it < 4 * NJ; ++it) {
        const int id = it * 512 + tid, row = id >> 5, c = id & 31;
        const uint4 v = *(const uint4*)(lds + row * 528 + c * 16);
        const int fs = fbase + row;
        if (!sample) {
          const int t0 = tm * 256 + c * 8, b = t0 >> 13, s = t0 & 8191;
          *(uint4*)(VT + ((size_t)(b * 512 + fs)) * ldv + s) = v;
        } else {
          const int b = c >> 2, tt = (c & 3) * 8;
          *(uint4*)(VT + ((size_t)(b * 512 + fs)) * ldv + sofs + tt) = v;
        }
        if ((it & 3) == 3) __builtin_amdgcn_sched_barrier(0);
      }
    }
    __syncthreads();
  } else {
    if (sec == 4 || sec == 5) {
      const float sgn = (r & 8) ? 1.f : -1.f;
      const int pos0 = sample ? (1024 + 4 * h) : ((tb & 8191) + 4 * h);
      const float2* rt = RT + pos0 * 8 + (r & 7);
#pragma unroll
      for (int i = 0; i < 2; ++i)
#pragma unroll
        for (int g = 0; g < 4; ++g) {
          const int po = (sample ? 0 : i * 32) + 8 * g;
          float2 cs[4];
#pragma unroll
          for (int e = 0; e < 4; ++e) cs[e] = rt[(po + e) * 8];
          __builtin_amdgcn_sched_barrier(0);
#pragma unroll
          for (int j = 0; j < NJ; j += 2)
#pragma unroll
            for (int e = 0; e < 4; ++e) {
              const float x = acc[i][j][4 * g + e];
              const float xp = dpp_x8(x);
              if (r < 16) acc[i][j][4 * g + e] = x * cs[e].x + sgn * xp * cs[e].y;
            }
          __builtin_amdgcn_sched_barrier(0);
        }
    }
    if (sec == 3 || sec == 7) {
#pragma unroll
      for (int i = 0; i < 2; ++i)
#pragma unroll
        for (int j = 0; j < NJ; ++j)
#pragma unroll
          for (int e = 0; e < 16; ++e) acc[i][j][e] = silu(acc[i][j][e]);
    }
    u16* dst; size_t trow0;
    if (sec == 0) { dst = (u16*)(p.ws + WS_QA); trow0 = tb; }
    else if (sec == 3) { dst = (u16*)(p.ws + WS_GA); trow0 = tb; }
    else if (sec == 4) { dst = (u16*)(p.ws + WS_QB); trow0 = tb; }
    else if (sec == 7) { dst = (u16*)(p.ws + WS_GB); trow0 = tb; }
    else if (sec == 1) {
      if (!sample) { dst = (u16*)(p.ws + WS_KA); trow0 = tb; }
      else { dst = (u16*)(p.ws + WS_KAS); trow0 = (size_t)(wm * 2) * 544 + 512; }
    } else {
      if (!sample) { dst = (u16*)(p.ws + WS_KB); trow0 = tb; }
      else { dst = (u16*)(p.ws + WS_KBS); trow0 = (size_t)(wm * 2) * 1056 + 1024; }
    }
    const size_t istep = sample ? (sec == 1 ? 544 : (sec == 5 ? 1056 : 32)) : 32;
#pragma unroll
    for (int i = 0; i < 2; ++i)
#pragma unroll
      for (int j = 0; j < NJ; ++j)
        store_bf16_tile(acc[i][j], dst + (trow0 + i * istep) * 512 + fb + j * 32 + (r & ~1), 512, h, odd);
    if (sec == 1 || sec == 5) {
#pragma unroll
      for (int i = 0; i < 2; ++i) {
        float* d = nullptr;
        const int t0 = tb + i * 32;
        if (!sample) {
          const int b = t0 >> 13, s = t0 & 8191;
          if (sec == 5) d = p.out + O_BKP + (size_t)t0 * 512;
          else if (s >= 7680) d = p.out + O_AKP + ((size_t)(b * 512 + s - 7680)) * 512;
        } else {
          const int ts = t0 - NTOKP, b = ts >> 5;
          if (sec == 5) d = p.out + O_BKS + (size_t)ts * 512;
          else d = p.out + O_AKS + ((size_t)(b * 512 + 480)) * 512;
        }
        if (d) {
#pragma unroll
          for (int j = 0; j < NJ; ++j)
#pragma unroll
            for (int e = 0; e < 16; ++e) {
              d[(size_t)(8 * (e >> 2) + 4 * h + (e & 3)) * 512 + fb + j * 32 + r] = acc[i][j][e];
              if ((e & 3) == 3) __builtin_amdgcn_sched_barrier(0);
            }
        }
      }
    }
  }
}
template <int NJ>
DI void p1_dispatch(const Params& p, char* lds, int tm, int col0) {
  switch (col0 >> 9) {
    case 0: p1_tile<NJ, 0>(p, lds, tm, col0); break;
    case 1: p1_tile<NJ, 1>(p, lds, tm, col0); break;
    case 2: p1_tile<NJ, 2>(p, lds, tm, col0); break;
    case 3: p1_tile<NJ, 3>(p, lds, tm, col0); break;
    case 4: p1_tile<NJ, 4>(p, lds, tm, col0); break;
    case 5: p1_tile<NJ, 5>(p, lds, tm, col0); break;
    case 6: p1_tile<NJ, 6>(p, lds, tm, col0); break;
    default: p1_tile<NJ, 7>(p, lds, tm, col0); break;
  }
}
DI void phase1(const Params& p, char* lds) {
  for (int tile = blockIdx.x; tile < 1024; tile += gridDim.x) {
    const int k = tile >> 8, b = tile & 255, xcd = b & 7, idx = b >> 3;
    const int tm = 16 * k + (xcd >> 1) * 4 + (idx & 3), tn = (xcd & 1) * 8 + (idx >> 2);
    p1_dispatch<4>(p, lds, tm, tn * 256);
  }
}

constexpr float SM_C = 0.125f * 1.4426950408889634f;
template <int NQT, int DVT, bool BIAS>
DI void attn_wave(const u16* __restrict__ Q, int ldq, const u16* __restrict__ K, int ldk,
                  const u16* __restrict__ Vt, int ldv, int nkt, const float* bias_l2, int rel0,
                  f32x16 (&O)[NQT][DVT], float (&Mx)[NQT], float (&L)[NQT]) {
  const int lane = threadIdx.x & 63, r = lane & 31, h = lane >> 5;
  bf16x8 qf[NQT][4];
#pragma unroll
  for (int u = 0; u < NQT; ++u)
#pragma unroll
    for (int s = 0; s < 4; ++s) qf[u][s] = *(const bf16x8*)(Q + (size_t)(32 * u + r) * ldq + 16 * s + 8 * h);
#pragma unroll
  for (int u = 0; u < NQT; ++u) {
    Mx[u] = -INFINITY; L[u] = 0.f;
#pragma unroll
    for (int dt = 0; dt < DVT; ++dt)
#pragma unroll
      for (int e = 0; e < 16; ++e) O[u][dt][e] = 0.f;
  }
  const u16* kp = K + (size_t)rho(r) * ldk + 8 * h;
  const u16* vp = Vt + (size_t)r * ldv + 8 * h;
  bf16x8 kf[4];
#pragma unroll
  for (int s = 0; s < 4; ++s) kf[s] = *(const bf16x8*)(kp + 16 * s);
  for (int kt = 0; kt < nkt; ++kt) {
    bf16x8 vf[DVT][2];
#pragma unroll
    for (int dt = 0; dt < DVT; ++dt)
#pragma unroll
      for (int s2 = 0; s2 < 2; ++s2) vf[dt][s2] = *(const bf16x8*)(vp + (size_t)(32 * dt) * ldv + 32 * kt + 16 * s2);
    bf16x8 kn[4];
    {
      const int ktn = (kt + 1 < nkt) ? kt + 1 : kt;
#pragma unroll
      for (int s = 0; s < 4; ++s) kn[s] = *(const bf16x8*)(kp + (size_t)(32 * ktn) * ldk + 16 * s);
    }
    bf16x8 pf[NQT][2];
#pragma unroll
    for (int u = 0; u < NQT; ++u) {
      f32x16 S;
#pragma unroll
      for (int e = 0; e < 16; ++e) S[e] = 0.f;
#pragma unroll
      for (int s = 0; s < 4; ++s) S = MFMA(kf[s], qf[u][s], S);
      float t[16];
      if (BIAS) {
        const int relb = rel0 + 32 * u + r - 32 * kt - 8 * h;
        if (rel0 - 32 * kt - 31 >= 128) {
          const float bv = bias_l2[256];
#pragma unroll
          for (int e = 0; e < 16; ++e) t[e] = S[e] * SM_C + bv;
        } else {
#pragma unroll
          for (int e = 0; e < 16; ++e) {
            int rel = relb - ((e & 7) + 16 * (e >> 3));
            rel = rel < -128 ? -128 : (rel > 128 ? 128 : rel);
            t[e] = S[e] * SM_C + bias_l2[rel + 128];
          }
        }
      } else {
#pragma unroll
        for (int e = 0; e < 16; ++e) t[e] = S[e] * SM_C;
      }
      float mx = t[0];
#pragma unroll
      for (int e = 1; e < 16; ++e) mx = fmaxf(mx, t[e]);
      mx = fmaxf(mx, __shfl_xor(mx, 32));
      if (__any(mx > Mx[u] + 8.f)) {
        const float mn = fmaxf(Mx[u], mx);
        const float al = __builtin_amdgcn_exp2f(Mx[u] - mn);
        Mx[u] = mn; L[u] *= al;
#pragma unroll
        for (int dt = 0; dt < DVT; ++dt)
#pragma unroll
          for (int e = 0; e < 16; ++e) O[u][dt][e] *= al;
      }
      float ps = 0.f;
#pragma unroll
      for (int e = 0; e < 16; ++e) { t[e] = __builtin_amdgcn_exp2f(t[e] - Mx[u]); ps += t[e]; }
      L[u] += ps;
#pragma unroll
      for (int s2 = 0; s2 < 2; ++s2) {
        uint4 pk;
        pk.x = pk2(t[8 * s2], t[8 * s2 + 1]); pk.y = pk2(t[8 * s2 + 2], t[8 * s2 + 3]);
        pk.z = pk2(t[8 * s2 + 4], t[8 * s2 + 5]); pk.w = pk2(t[8 * s2 + 6], t[8 * s2 + 7]);
        pf[u][s2] = __builtin_bit_cast(bf16x8, pk);
      }
    }
#pragma unroll
    for (int u = 0; u < NQT; ++u)
#pragma unroll
      for (int dt = 0; dt < DVT; ++dt)
#pragma unroll
        for (int s2 = 0; s2 < 2; ++s2) O[u][dt] = MFMA(vf[dt][s2], pf[u][s2], O[u][dt]);
#pragma unroll
    for (int s = 0; s < 4; ++s) kf[s] = kn[s];
  }
#pragma unroll
  for (int u = 0; u < NQT; ++u) L[u] += __shfl_xor(L[u], 32);
}

template <int NQT>
DI void attnA_item(const Params& p, const u16* Q, const u16* K, const u16* Vt, int ldv, int nkt, int rel0,
                   const float* bias_l2, int tok0, int head) {
  f32x16 O[NQT][2]; float Mx[NQT], L[NQT];
  attn_wave<NQT, 2, true>(Q, 512, K, 512, Vt, ldv, nkt, bias_l2, rel0, O, Mx, L);
  const int lane = threadIdx.x & 63, r = lane & 31, h = lane >> 5;
  const u16* GA = (const u16*)(p.ws + WS_GA);
  u16* OB = (u16*)(p.ws + WS_HN);
#pragma unroll
  for (int u = 0; u < NQT; ++u) {
    const float inv = 1.f / L[u];
    const size_t tok = (size_t)(tok0 + 32 * u + r);
#pragma unroll
    for (int dt = 0; dt < 2; ++dt)
#pragma unroll
      for (int g = 0; g < 4; ++g) {
        const int dv = 32 * dt + 8 * g + 4 * h;
        const uint2 gg = *(const uint2*)(GA + tok * 512 + head * 64 + dv);
        uint2 o;
        o.x = pk2(O[u][dt][4 * g] * inv * bflo(gg.x), O[u][dt][4 * g + 1] * inv * bfhi(gg.x));
        o.y = pk2(O[u][dt][4 * g + 2] * inv * bflo(gg.y), O[u][dt][4 * g + 3] * inv * bfhi(gg.y));
        *(uint2*)(OB + tok * 1024 + head * 64 + dv) = o;
      }
  }
}

DI void attnB_epilogue(const Params& p, f32x16 (&O)[4], float Lsum, int tok0, int hb, float lam, float* xch) {
  const int lane = threadIdx.x & 63, r = lane & 31, h = lane >> 5, w = threadIdx.x >> 6, m = w >> 2, wsub = w & 3;
  const float inv = 1.f / Lsum;
  float* xw = xch + wsub * 4096 + lane;
  if (m == 1) {
    const float sc = inv * lam;
#pragma unroll
    for (int dt = 0; dt < 4; ++dt)
#pragma unroll
      for (int e = 0; e < 16; ++e) xw[(dt * 16 + e) * 64] = O[dt][e] * sc;
  }
  __syncthreads();
  if (m == 0) {
    float ss = 0.f;
#pragma unroll
    for (int dt = 0; dt < 4; ++dt)
#pragma unroll
      for (int e = 0; e < 16; ++e) { float o = O[dt][e] * inv - xw[(dt * 16 + e) * 64]; O[dt][e] = o; ss += o * o; }
    ss += __shfl_xor(ss, 32);
    const float rn = rsqrtf(ss * (1.f / 128.f) + 1e-6f) * 0.8f;
    const u16* GB = (const u16*)(p.ws + WS_GB);
    u16* OB = (u16*)(p.ws + WS_HN);
    const size_t tok = (size_t)(tok0 + r);
#pragma unroll
    for (int dt = 0; dt < 4; ++dt)
#pragma unroll
      for (int g = 0; g < 4; ++g) {
        const int dv = 32 * dt + 8 * g + 4 * h;
        const uint2 gg = *(const uint2*)(GB + tok * 512 + hb * 128 + dv);
        const float4 sg = *(const float4*)(p.subln + dv);
        uint2 o;
        o.x = pk2(O[dt][4 * g] * rn * sg.x * bflo(gg.x), O[dt][4 * g + 1] * rn * sg.y * bfhi(gg.x));
        o.y = pk2(O[dt][4 * g + 2] * rn * sg.z * bflo(gg.y), O[dt][4 * g + 3] * rn * sg.w * bfhi(gg.y));
        *(uint2*)(OB + tok * 1024 + 512 + hb * 128 + dv) = o;
      }
  }
  __syncthreads();
}

DI void attnB_item(const Params& p, const u16* Q, const u16* K, const u16* Vt, int ldv, int nkt, int tok0, int hb,
                   float lam, float* xch) {
  f32x16 O[1][4]; float Mx[1], L[1];
  attn_wave<1, 4, false>(Q, 512, K, 512, Vt, ldv, nkt, nullptr, 0, O, Mx, L);
  attnB_epilogue(p, O[0], L[0], tok0, hb, lam, xch);
}

typedef float f2 __attribute__((ext_vector_type(2)));
constexpr int BLK_V = 0, BLK_K = 65536, BLK_XCH = 0, LDS_BIAS = 147456;
DI float half_max(float v) {
  auto rr = __builtin_amdgcn_permlane32_swap(__float_as_uint(v), __float_as_uint(v), false, false);
  return fmaxf(__uint_as_float(rr[0]), __uint_as_float(rr[1]));
}
DI void attnB_block(const Params& p, int b, int hb, int qt, float lam, char* lds) {
  int tid = threadIdx.x;
  asm volatile("" : "+v"(tid));
  const int lane = tid & 63, r = lane & 31, h = lane >> 5, w = tid >> 6, m = w >> 2, wsub = w & 3;
  constexpr bool late = false;
  const int q0 = qt * 128 + wsub * 32;
  const int nt = 2 * qt + 2;
  const int my_nt = (q0 >> 6) + 1;
  uint4 qraw[4];
  {
    const u16* Q = (const u16*)(p.ws + WS_QB) + (size_t)(b * SEQ + q0 + r) * 512 + hb * 128 + m * 64 + 8 * h;
#pragma unroll
    for (int s = 0; s < 4; ++s) gld16(qraw[s], Q + 16 * s);
  }
  f32x16 O[4];
#pragma unroll
  for (int dt = 0; dt < 4; ++dt)
#pragma unroll
    for (int e = 0; e < 16; ++e) O[dt][e] = 0.f;
  float Mx = -INFINITY;
  f2 L2 = {0.f, 0.f};
  const u16* gk = (const u16*)(p.ws + WS_KB) + (size_t)(b * SEQ + (tid >> 4)) * 512 + hb * 128 + (tid & 15) * 8;
  const u16* gv = (const u16*)(p.ws + WS_VBT) + (size_t)(b * 512 + hb * 128 + (tid >> 3)) * SEQ + (tid & 7) * 8;
  const int lk = BLK_K + ((tid >> 3) & 1) * 8192 + (tid >> 4) * 128 + ((((tid & 7) ^ ((tid >> 5) & 7))) << 4);
  const int lv = BLK_V + (tid >> 3) * 128 + ((((tid & 7) ^ ((tid >> 4) & 7))) << 4);
  const int rr = rho(r);
  const int swk = (rr >> 1) & 7, swv = (r >> 1) & 7;
  uint4 sk0, sk1, sv0, sv1;
  gld16(sk0, gk); gld16(sk1, gk + (size_t)32 * 512);
  gld16(sv0, gv); gld16(sv1, gv + (size_t)64 * SEQ);
  wait_vm0();
  *(uint4*)(lds + lk) = sk0; *(uint4*)(lds + lk + 4096) = sk1;
  *(uint4*)(lds + lv) = sv0; *(uint4*)(lds + lv + 8192) = sv1;
  asm volatile("s_waitcnt lgkmcnt(0)" ::: "memory");
  gld16(sk0, gk + (size_t)64 * 512); gld16(sk1, gk + (size_t)96 * 512);
  gld16(sv0, gv + 64); gld16(sv1, gv + (size_t)64 * SEQ + 64);
  wait_vm0();
  *(uint4*)(lds + lk + 16384) = sk0; *(uint4*)(lds + lk + 16384 + 4096) = sk1;
  *(uint4*)(lds + lv + 16384) = sv0; *(uint4*)(lds + lv + 16384 + 8192) = sv1;
  bf16x8 qf[4];
#pragma unroll
  for (int s = 0; s < 4; ++s) qf[s] = __builtin_bit_cast(bf16x8, qraw[s]);
  bf16x8 pf[4];
#pragma unroll
  for (int s = 0; s < 4; ++s) pf[s] = qf[s];
  __syncthreads();
  for (int t = 0; t < nt; ++t) {
    if (t + 2 < nt) {
      gld16(sk0, gk + (size_t)(64 * (t + 2)) * 512);
      gld16(sk1, gk + (size_t)(64 * (t + 2) + 32) * 512);
      gld16(sv0, gv + 64 * (t + 2));
      gld16(sv1, gv + (size_t)64 * SEQ + 64 * (t + 2));
    }
    __builtin_amdgcn_sched_barrier(0);
    if (t < my_nt) {
      const char* kb = lds + BLK_K + (t & 3) * 16384 + m * 8192;
      f32x16 S0, S1;
#pragma unroll
      for (int e = 0; e < 16; ++e) { S0[e] = 0.f; S1[e] = 0.f; }
      bf16x8 ka[4], kc[4];
#pragma unroll
      for (int s = 0; s < 4; ++s) {
        const int co = (((2 * s + h) ^ swk) << 4);
        ka[s] = *(const bf16x8*)(kb + rr * 128 + co);
        kc[s] = *(const bf16x8*)(kb + (32 + rr) * 128 + co);
      }
#pragma unroll
      for (int s = 0; s < 4; ++s) {
        S0 = MFMA(ka[s], qf[s], S0);
        S1 = MFMA(kc[s], qf[s], S1);
      }
      f2 tv[16];
      const f2 cc = {SM_C, SM_C};
#pragma unroll
      for (int e = 0; e < 8; ++e) {
        f2 a = {S0[2 * e], S0[2 * e + 1]}; tv[e] = a * cc;
        f2 c = {S1[2 * e], S1[2 * e + 1]}; tv[8 + e] = c * cc;
      }
      float mx = fmaxf(tv[0].x, tv[0].y);
#pragma unroll
      for (int e = 1; e < 16; ++e) mx = fmaxf(mx, fmaxf(tv[e].x, tv[e].y));
      mx = half_max(mx);
      if (__any(mx > Mx + 8.f)) {
        const float mn = fmaxf(Mx, mx);
        const float al = __builtin_amdgcn_exp2f(Mx - mn);
        Mx = mn; L2 *= al;
#pragma unroll
        for (int dt = 0; dt < 4; ++dt)
#pragma unroll
          for (int e = 0; e < 16; ++e) O[dt][e] *= al;
      }
      const f2 nm = {-Mx, -Mx};
#pragma unroll
      for (int e = 0; e < 16; ++e) {
        f2 d = tv[e] + nm;
        d.x = __builtin_amdgcn_exp2f(d.x); d.y = __builtin_amdgcn_exp2f(d.y);
        L2 += d;
        tv[e] = d;
      }
#pragma unroll
      for (int s2 = 0; s2 < 4; ++s2) {
        uint4 pa;
        pa.x = pk2(tv[4 * s2].x, tv[4 * s2].y); pa.y = pk2(tv[4 * s2 + 1].x, tv[4 * s2 + 1].y);
        pa.z = pk2(tv[4 * s2 + 2].x, tv[4 * s2 + 2].y); pa.w = pk2(tv[4 * s2 + 3].x, tv[4 * s2 + 3].y);
        pf[s2] = __builtin_bit_cast(bf16x8, pa);
      }
      if (!late) {
        const char* vb = lds + BLK_V + (t & 3) * 16384;
#pragma unroll
        for (int ks = 0; ks < 4; ++ks) {
          const int co = (((2 * ks + h) ^ swv) << 4);
#pragma unroll
          for (int dt = 0; dt < 4; ++dt) {
            bf16x8 v = *(const bf16x8*)(vb + (32 * dt + r) * 128 + co);
            O[dt] = MFMA(v, pf[ks], O[dt]);
          }
        }
      }
    }
    if (t + 2 < nt) {
      const int sl = ((t + 2) & 3) * 16384;
      wait_vm0();
      *(uint4*)(lds + lk + sl) = sk0; *(uint4*)(lds + lk + sl + 4096) = sk1;
      *(uint4*)(lds + lv + sl) = sv0; *(uint4*)(lds + lv + sl + 8192) = sv1;
    }
    if (t & 1) __syncthreads();
  }
  float L = L2.x + L2.y;
  L += __shfl_xor(L, 32);
  attnB_epilogue(p, O, L, b * SEQ + q0, hb, lam, (float*)(lds + BLK_XCH));
}

DI float phase2_setup(const Params& p, char* lds) {
  const int tid = threadIdx.x, lane = tid & 63;
  float* bias = (float*)(lds + LDS_BIAS);
  for (int i = tid; i < 8 * 257; i += 512) { int hh = i / 257, k = i - hh * 257; bias[hh * 260 + k] = p.rel_bias[i] * 1.4426950408889634f; }
  float a = p.lq1[lane] * p.lk1[lane], b = p.lq2[lane] * p.lk2[lane];
  a = wave_sum(a); b = wave_sum(b);
  __syncthreads();
  return expf(a) - expf(b) + 0.2f;
}
DI void p3_tile(const Params& p, char* lds, int tok0) {
  int tid = threadIdx.x;
  asm volatile("" : "+v"(tid));
  const int lane = tid & 63, w = tid >> 6, r = lane & 31, h = lane >> 5;
  const u16* OB = (const u16*)(p.ws + WS_HN);
  float* red = (float*)(lds + 131072);
  __syncthreads();
#pragma unroll
  for (int half = 0; half < 2; ++half) {
    uint4 a[8];
#pragma unroll
    for (int it = 0; it < 8; ++it) a[it] = *(const uint4*)(OB + (size_t)(tok0 + half * 32 + it * 4 + (tid >> 7)) * 1024 + (tid & 127) * 8);
#pragma unroll
    for (int it = 0; it < 8; ++it) {
      const int row = half * 32 + it * 4 + (tid >> 7);
      *(uint4*)(lds + row * 2048 + ((((tid & 127) ^ (row & 15))) << 4)) = a[it];
    }
  }
  f32x16 acc[2][4];
#pragma unroll
  for (int i = 0; i < 2; ++i)
#pragma unroll
    for (int j = 0; j < 4; ++j)
#pragma unroll
      for (int e = 0; e < 16; ++e) acc[i][j][e] = 0.f;
  const char* wp = p.ws + WS_WOUTT + ((size_t)(w * 4) * 4096 + lane) * 16;
  const char* ap = lds + r * 2048;
  const int akey = r & 15;
  uint4 bq[4][4];
#pragma unroll
  for (int s = 0; s < 4; ++s)
#pragma unroll
    for (int j = 0; j < 4; ++j) gld16(bq[s][j], wp + (size_t)(j * 4096 + s * 64) * 16);
  __syncthreads();
#define P3_KSTEP(KS, SLOT, WAITN, REFILL)                                                        \
  {                                                                                              \
    const int co_ = ((((2 * (KS) + h) ^ akey)) << 4);                                            \
    const bf16x8 a0_ = *(const bf16x8*)(ap + co_);                                               \
    const bf16x8 a1_ = *(const bf16x8*)(ap + 65536 + co_);                                       \
    WAIT_VM(WAITN);                                                                              \
    __builtin_amdgcn_sched_barrier(0);                                                           \
    __builtin_amdgcn_s_setprio(1);                                                               \
    _Pragma("unroll") for (int j = 0; j < 4; ++j) {                                              \
      const bf16x8 bf_ = __builtin_bit_cast(bf16x8, bq[SLOT][j]);                                \
      acc[0][j] = MFMA(a0_, bf_, acc[0][j]);                                                     \
      acc[1][j] = MFMA(a1_, bf_, acc[1][j]);                                                     \
    }                                                                                            \
    __builtin_amdgcn_s_setprio(0);                                                               \
    __builtin_amdgcn_sched_barrier(0);                                                           \
    if (REFILL) {                                                                                \
      _Pragma("unroll") for (int j = 0; j < 4; ++j) gld16(bq[SLOT][j], wp + (size_t)(j * 4096 + ((KS) + 4) * 64) * 16); \
    }                                                                                            \
    __builtin_amdgcn_sched_barrier(0);                                                           \
  }
#pragma unroll 1
  for (int g = 0; g < 15; ++g) {
    P3_KSTEP(4 * g, 0, 12, true)
    P3_KSTEP(4 * g + 1, 1, 12, true)
    P3_KSTEP(4 * g + 2, 2, 12, true)
    P3_KSTEP(4 * g + 3, 3, 12, true)
  }
  P3_KSTEP(60, 0, 12, false)
  P3_KSTEP(61, 1, 8, false)
  P3_KSTEP(62, 2, 4, false)
  P3_KSTEP(63, 3, 0, false)
  WAIT_VM(0);
  const float* xr = tok0 < NTOKP ? p.x_prompt + (size_t)tok0 * 1024 : p.x_sample + (size_t)(tok0 - NTOKP) * 1024;
  const unsigned cb = w * 128 + r;
#pragma unroll
  for (int i = 0; i < 2; ++i) {
#pragma unroll
    for (int e = 0; e < 16; ++e) {
      const int row = 32 * i + 8 * (e >> 2) + 4 * h + (e & 3);
      unsigned off = row * 1024 + cb;
      asm volatile("" : "+v"(off));
      float ssv = 0.f;
#pragma unroll
      for (int j = 0; j < 4; ++j) {
        const float y = acc[i][j][e] + xr[off + j * 32];
        acc[i][j][e] = y; ssv += y * y;
      }
      ssv += __shfl_xor(ssv, 1); ssv += __shfl_xor(ssv, 2); ssv += __shfl_xor(ssv, 4); ssv += __shfl_xor(ssv, 8); ssv += __shfl_xor(ssv, 16);
      if (r == 0) red[w * 64 + row] = ssv;
      if ((e & 3) == 3) __builtin_amdgcn_sched_barrier(0);
    }
  }
  __syncthreads();
  if (tid < 64) {
    float t = 0.f;
#pragma unroll
    for (int k = 0; k < 8; ++k) t += red[k * 64 + tid];
    red[512 + tid] = rsqrtf(t * (1.f / 1024.f) + 1e-6f);
  }
  __syncthreads();
  float* yr = p.out + O_YP + (size_t)tok0 * 1024;
  float gj[4];
#pragma unroll
  for (int j = 0; j < 4; ++j) gj[j] = p.final_gain[cb + j * 32];
#pragma unroll
  for (int i = 0; i < 2; ++i) {
#pragma unroll
    for (int e = 0; e < 16; ++e) {
      const int row = 32 * i + 8 * (e >> 2) + 4 * h + (e & 3);
      unsigned off = row * 1024 + cb;
      asm volatile("" : "+v"(off));
      const float ri = red[512 + row];
#pragma unroll
      for (int j = 0; j < 4; ++j) yr[off + j * 32] = acc[i][j][e] * ri * gj[j];
      if ((e & 3) == 3) __builtin_amdgcn_sched_barrier(0);
    }
  }
}

constexpr int NQUEUE = 14;
DI int q_pop(unsigned* ctr, int* slot) {
  __syncthreads();
  if (threadIdx.x == 0) *slot = (int)__hip_atomic_fetch_add(ctr, 1u, __ATOMIC_RELAXED, __HIP_MEMORY_SCOPE_AGENT);
  __syncthreads();
  return *slot;
}
DI void p2_all(const Params& p, char* lds, float lam) {
  const int w = threadIdx.x >> 6;
  unsigned* Q = (unsigned*)(p.ws + WS_QUEUE);
  int* slot = (int*)(lds + LDS_BIAS + 8320);
  float* xch = (float*)(lds + 65536);
  const float* bias = (const float*)(lds + LDS_BIAS);
  const u16* QA = (const u16*)(p.ws + WS_QA);
  const u16* QB = (const u16*)(p.ws + WS_QB);
#pragma unroll 1
  for (;;) {
    const int i = q_pop(Q + 64 * 12, slot);
    if (i >= 32) break;
    p1_dispatch<2>(p, lds, 64, i * 128);
    asm volatile("s_waitcnt vmcnt(0)" ::: "memory");
    __syncthreads();
    if (threadIdx.x == 0) {
      __builtin_amdgcn_fence(__ATOMIC_RELEASE, "agent");
      __hip_atomic_fetch_add(Q + 64 * 13, 1u, __ATOMIC_RELAXED, __HIP_MEMORY_SCOPE_AGENT);
    }
  }
  {
    const int it = q_pop(Q, slot);
    if (it < 16) {
      if (threadIdx.x == 0) {
        while (__hip_atomic_load(Q + 64 * 13, __ATOMIC_RELAXED, __HIP_MEMORY_SCOPE_AGENT) < 32u) __builtin_amdgcn_s_sleep(2);
        __builtin_amdgcn_fence(__ATOMIC_ACQUIRE, "agent");
      }
      __syncthreads();
    }
    if (it < 8) {
      const int m = w >> 2, wsub = w & 3, id = it * 4 + wsub, b = id >> 2, hb = id & 3;
      attnB_item(p, QB + (size_t)(NTOKP + b * 32) * 512 + hb * 128 + m * 64,
                 (const u16*)(p.ws + WS_KBS) + (size_t)(b * 1056) * 512 + hb * 128 + m * 64,
                 (const u16*)(p.ws + WS_VBTS) + (size_t)(b * 512 + hb * 128) * 1056, 1056, 33, NTOKP + b * 32, hb, lam, xch);
    } else if (it < 16) {
      const int b = it - 8;
      attnA_item<1>(p, QA + (size_t)(NTOKP + b * 32) * 512 + w * 64,
                    (const u16*)(p.ws + WS_KAS) + (size_t)(b * 544) * 512 + w * 64,
                    (const u16*)(p.ws + WS_VATS) + (size_t)(b * 512 + w * 64) * 544, 544, 17, 512, bias + w * 260,
                    NTOKP + b * 32, w);
    }
    if (it < 16) {
      asm volatile("s_waitcnt vmcnt(0)" ::: "memory");
      __syncthreads();
      if (threadIdx.x == 0) {
        __builtin_amdgcn_fence(__ATOMIC_RELEASE, "agent");
        __hip_atomic_fetch_add(Q + 64 * 11, 1u, __ATOMIC_RELAXED, __HIP_MEMORY_SCOPE_AGENT);
      }
    }
  }
  unsigned* T = (unsigned*)(p.ws + WS_QUEUE + 4096);
  bool didA = false;
  int k = 0;
#pragma unroll 1
  for (;;) {
    int i = q_pop(Q + 64 * (1 + ((blockIdx.x + k) & 7)), slot);
    if (i >= 64) { if (++k < 8) continue; i = -1; }
    if ((i < 0 || i >= 40) && !didA) {
      didA = true;
#pragma unroll 1
      for (;;) {
        const int it = q_pop(Q + 64 * 9, slot);
        if (it >= 256) break;
        const int b = it >> 7, c = it & 127, cs = c > 8 ? c - 8 : 0;
        int tl = threadIdx.x;
        asm volatile("" : "+v"(tl));
        const int ww = tl >> 6;
        attnA_item<2>(p, (const u16*)(p.ws + WS_QA) + (size_t)(b * SEQ + c * 64) * 512 + ww * 64,
                      (const u16*)(p.ws + WS_KA) + (size_t)(b * SEQ + cs * 64) * 512 + ww * 64,
                      (const u16*)(p.ws + WS_VAT) + (size_t)(b * 512 + ww * 64) * SEQ + cs * 64, SEQ,
                      (c + 1 - cs) * 2, 64 * (c - cs), (const float*)(lds + LDS_BIAS) + ww * 260, b * SEQ + c * 64, ww);
        asm volatile("s_waitcnt vmcnt(0)" ::: "memory");
        __syncthreads();
        if (threadIdx.x == 0) {
          __builtin_amdgcn_fence(__ATOMIC_RELEASE, "agent");
          __hip_atomic_fetch_add(T + it, 1u, __ATOMIC_RELAXED, __HIP_MEMORY_SCOPE_AGENT);
        }
      }
    }
    if (i < 0) break;
    const int x = (blockIdx.x + k) & 7;
    attnB_block(p, x >> 2, x & 3, 63 - i, lam, lds);
    asm volatile("s_waitcnt vmcnt(0)" ::: "memory");
    __syncthreads();
    if (threadIdx.x == 0) {
      __builtin_amdgcn_fence(__ATOMIC_RELEASE, "agent");
      unsigned* tt = T + (x >> 2) * 128 + 2 * (63 - i);
      __hip_atomic_fetch_add(tt, 1u, __ATOMIC_RELAXED, __HIP_MEMORY_SCOPE_AGENT);
      __hip_atomic_fetch_add(tt + 1, 1u, __ATOMIC_RELAXED, __HIP_MEMORY_SCOPE_AGENT);
    }
  }
#pragma unroll 1
  for (;;) {
    const int it = q_pop(Q + 64 * 10, slot);
    if (it >= 260) break;
    int tok0;
    if (threadIdx.x == 0) {
      if (it < 4) { while (__hip_atomic_load(Q + 64 * 11, __ATOMIC_RELAXED, __HIP_MEMORY_SCOPE_AGENT) < 16u) __builtin_amdgcn_s_sleep(2); }
      else { while (__hip_atomic_load(T + (259 - it), __ATOMIC_RELAXED, __HIP_MEMORY_SCOPE_AGENT) < 5u) __builtin_amdgcn_s_sleep(2); }
      __builtin_amdgcn_fence(__ATOMIC_ACQUIRE, "agent");
    }
    __syncthreads();
    if (it < 4) tok0 = NTOKP + it * 64; else tok0 = (259 - it) * 64;
    p3_tile(p, lds, tok0);
  }
}

DI void phase4(const Params& p) {
  const int lane = threadIdx.x & 63, w = threadIdx.x >> 6;
  for (int row = blockIdx.x * 8 + w; row < NTOK; row += gridDim.x * 8) {
    float* y = p.out + O_YP + (size_t)row * 1024;
    float4 v[4]; float ss = 0.f;
#pragma unroll
    for (int it = 0; it < 4; ++it) { v[it] = *(const float4*)(y + it * 256 + lane * 4); ss += v[it].x * v[it].x + v[it].y * v[it].y + v[it].z * v[it].z + v[it].w * v[it].w; }
    ss = wave_sum(ss);
    const float inv = rsqrtf(ss * (1.f / 1024.f) + 1e-6f);
#pragma unroll
    for (int it = 0; it < 4; ++it) {
      float4 g = *(const float4*)(p.final_gain + it * 256 + lane * 4);
      *(float4*)(y + it * 256 + lane * 4) = make_float4(v[it].x * inv * g.x, v[it].y * inv * g.y, v[it].z * inv * g.z, v[it].w * inv * g.w);
    }
  }
}

__global__ void __launch_bounds__(512) fwd_megakernel(Params p) {
  __shared__ __attribute__((aligned(16))) char lds[155904];
  cg::grid_group grid = cg::this_grid();
  unsigned* ctr = (unsigned*)(p.ws + WS_BAR);
  const unsigned G = gridDim.x;
  if (p.out == nullptr) grid.sync();
  phase0(p, lds);
  ctr_barrier(ctr, G);
  phase1(p, lds);
  ctr_barrier(ctr, 2 * G);
  {
    const float lam = phase2_setup(p, lds);
    p2_all(p, lds, lam);
  }
}

extern "C" void kernel_launch(void* const* d_in, const int* in_sizes, int n_in, void* d_out, int out_size, void* d_ws,
                              size_t ws_size, hipStream_t stream) {
  static int grid_blocks = 0;
  if (!grid_blocks) {
    int dev = 0, cus = 0, per_cu = 0;
    hipGetDevice(&dev);
    hipDeviceGetAttribute(&cus, hipDeviceAttributeMultiprocessorCount, dev);
    hipOccupancyMaxActiveBlocksPerMultiprocessor(&per_cu, fwd_megakernel, 512, 0);
    if (per_cu < 1) per_cu = 1;
    grid_blocks = cus;
  }
  Params p{};
  p.x_prompt = (const float*)d_in[0]; p.x_sample = (const float*)d_in[1];
  p.cache_a_k = (const float*)d_in[2]; p.cache_a_v = (const float*)d_in[3];
  p.cache_b_k = (const float*)d_in[4]; p.cache_b_v = (const float*)d_in[5];
  p.norm_gain = (const float*)d_in[6]; p.w_in = (const float*)d_in[7]; p.w_out = (const float*)d_in[8];
  p.rel_bias = (const float*)d_in[9];
  p.lq1 = (const float*)d_in[10]; p.lk1 = (const float*)d_in[11]; p.lq2 = (const float*)d_in[12]; p.lk2 = (const float*)d_in[13];
  p.subln = (const float*)d_in[14]; p.final_gain = (const float*)d_in[15];
  p.out = (float*)d_out; p.ws = (char*)d_ws;
  void* args[] = {&p};
  (void)hipMemsetAsync((char*)d_ws + WS_BAR, 0, 12288, stream);
  hipError_t e = hipLaunchCooperativeKernel((void*)fwd_megakernel, dim3(grid_blocks), dim3(512), args, 0, stream);
  if (e != hipSuccess) fprintf(stderr, "cooperative launch failed: %s (grid %d)\n", hipGetErrorString(e), grid_blocks);
}
```

```cpp
#include <hip/hip_runtime.h>
#include <hip/hip_cooperative_groups.h>
#include <cstdio>
namespace cg = cooperative_groups;

typedef short bf16x8 __attribute__((ext_vector_type(8)));
typedef float f32x16 __attribute__((ext_vector_type(16)));
typedef __bf16 bf2_t __attribute__((ext_vector_type(2)));
typedef float f2_t __attribute__((ext_vector_type(2)));
typedef unsigned u32;
typedef unsigned short u16;
#define DI __device__ __forceinline__
#define MFMA(a, b, c) __builtin_amdgcn_mfma_f32_32x32x16_bf16((a), (b), (c), 0, 0, 0)

constexpr int NTOKP = 16384;
constexpr int NTOK = 16640;
constexpr int SEQ = 8192;
constexpr size_t O_YP = 0;
constexpr size_t O_AKP = 17039360, O_AVP = 17563648, O_BKP = 18087936, O_BVP = 26476544;
constexpr size_t O_AKS = 34865152, O_AVS = 36962304, O_BKS = 39059456, O_BVS = 39190528;
constexpr size_t WS_WINT = 0;
constexpr size_t WS_WOUTT = WS_WINT + 8388608;
constexpr size_t WS_HN = WS_WOUTT + 2097152;
constexpr size_t WS_QA = WS_HN + 34078720;
constexpr size_t WS_KA = WS_QA + 17039360;
constexpr size_t WS_KAS = WS_KA + 16777216;
constexpr size_t WS_VAT = WS_KAS + 4456448;
constexpr size_t WS_VATS = WS_VAT + 16777216;
constexpr size_t WS_GA = WS_VATS + 4456448;
constexpr size_t WS_QB = WS_GA + 17039360;
constexpr size_t WS_KB = WS_QB + 17039360;
constexpr size_t WS_KBS = WS_KB + 16777216;
constexpr size_t WS_VBT = WS_KBS + 8650752;
constexpr size_t WS_VBTS = WS_VBT + 16777216;
constexpr size_t WS_GB = WS_VBTS + 8650752;
constexpr size_t WS_ROPE = WS_GB + 17039360;
constexpr size_t WS_BAR = WS_ROPE + 524288;
constexpr size_t WS_QUEUE = WS_BAR + 4096;
constexpr size_t WS_END = WS_QUEUE + 8192;

struct Params {
  const float* x_prompt; const float* x_sample;
  const float* cache_a_k; const float* cache_a_v; const float* cache_b_k; const float* cache_b_v;
  const float* norm_gain; const float* w_in; const float* w_out; const float* rel_bias;
  const float* lq1; const float* lk1; const float* lq2; const float* lk2;
  const float* subln; const float* final_gain;
  float* out; char* ws;
};

DI u32 pk2(float a, float b) { f2_t v = {a, b}; bf2_t r = __builtin_convertvector(v, bf2_t); return __builtin_bit_cast(u32, r); }
DI float bflo(u32 v) { return __uint_as_float(v << 16); }
DI float bfhi(u32 v) { return __uint_as_float(v & 0xffff0000u); }
DI int rho(int r) { return (r & ~12) | ((r & 4) << 1) | ((r & 8) >> 1); }
DI void gld16(uint4& dst, const void* p) { asm volatile("global_load_dwordx4 %0, %1, off" : "=v"(dst) : "v"(p) : "memory"); }
#define WAIT_VM(n) asm volatile("s_waitcnt vmcnt(" #n ")" ::: "memory")
DI void wait_vm0() { asm volatile("s_waitcnt vmcnt(0)" ::: "memory"); }
DI float wave_sum(float v) {
#pragma unroll
  for (int o = 32; o > 0; o >>= 1) v += __shfl_xor(v, o);
  return v;
}


DI void ctr_barrier(unsigned* ctr, unsigned target) {
  __syncthreads();
  if (threadIdx.x == 0) {
    __builtin_amdgcn_fence(__ATOMIC_RELEASE, "agent");
    __hip_atomic_fetch_add(ctr, 1u, __ATOMIC_RELAXED, __HIP_MEMORY_SCOPE_AGENT);
    while (__hip_atomic_load(ctr, __ATOMIC_RELAXED, __HIP_MEMORY_SCOPE_AGENT) < target) __builtin_amdgcn_s_sleep(1);
    __builtin_amdgcn_fence(__ATOMIC_ACQUIRE, "agent");
  }
  __syncthreads();
}

DI void phase0(const Params& p, char* lds) {
  const int tid = threadIdx.x, bid = blockIdx.x, nb = gridDim.x;
  const int lane = tid & 63, w = tid >> 6;
  float* tile = (float*)lds;
  for (int i = bid * 512 + tid; i < 131072; i += nb * 512) {
    const int ln = i & 63, s_ = (i >> 6) & 63, ct = i >> 12, r_ = ln & 31, h_ = ln >> 5;
    float v[8];
#pragma unroll
    for (int j = 0; j < 8; ++j) v[j] = p.w_out[(size_t)(16 * s_ + 8 * h_ + j) * 1024 + ct * 32 + r_];
    uint4 o; o.x = pk2(v[0], v[1]); o.y = pk2(v[2], v[3]); o.z = pk2(v[4], v[5]); o.w = pk2(v[6], v[7]);
    *(uint4*)(p.ws + WS_WOUTT + (size_t)i * 16) = o;
  }
  for (int t = bid; t < 1024; t += nb) {
    const float* W; u16* WT; int N, kt, nt;
    { W = p.w_in; WT = (u16*)(p.ws + WS_WINT); N = 4096; kt = t >> 6; nt = t & 63; }
#pragma unroll
    for (int it = 0; it < 8; ++it) {
      int idx = it * 512 + tid, kk = idx >> 6, nn = idx & 63;
      tile[kk * 65 + nn] = W[(size_t)(kt * 64 + kk) * N + nt * 64 + nn];
    }
    __syncthreads();
    {
      int n = tid >> 3, kg = tid & 7;
      float v[8];
#pragma unroll
      for (int j = 0; j < 8; ++j) v[j] = tile[(kg * 8 + j) * 65 + n];
      uint4 o; o.x = pk2(v[0], v[1]); o.y = pk2(v[2], v[3]); o.z = pk2(v[4], v[5]); o.w = pk2(v[6], v[7]);
      *(uint4*)(WT + (size_t)(nt * 64 + n) * 1024 + kt * 64 + kg * 8) = o;
    }
    __syncthreads();
  }
  {
    u16* HN = (u16*)(p.ws + WS_HN);
    for (int row = bid * 8 + w; row < NTOK; row += nb * 16) {
      const int row1 = row + nb * 8 < NTOK ? row + nb * 8 : row;
      const float* s0 = row < NTOKP ? p.x_prompt + (size_t)row * 1024 : p.x_sample + (size_t)(row - NTOKP) * 1024;
      const float* s1 = row1 < NTOKP ? p.x_prompt + (size_t)row1 * 1024 : p.x_sample + (size_t)(row1 - NTOKP) * 1024;
      float4 v[4], u[4]; float ss = 0.f, st = 0.f;
#pragma unroll
      for (int it = 0; it < 4; ++it) { v[it] = *(const float4*)(s0 + it * 256 + lane * 4); u[it] = *(const float4*)(s1 + it * 256 + lane * 4); }
#pragma unroll
      for (int it = 0; it < 4; ++it) {
        ss += v[it].x * v[it].x + v[it].y * v[it].y + v[it].z * v[it].z + v[it].w * v[it].w;
        st += u[it].x * u[it].x + u[it].y * u[it].y + u[it].z * u[it].z + u[it].w * u[it].w;
      }
      ss = wave_sum(ss); st = wave_sum(st);
      const float inv = rsqrtf(ss * (1.f / 1024.f) + 1e-6f), inu = rsqrtf(st * (1.f / 1024.f) + 1e-6f);
#pragma unroll
      for (int it = 0; it < 4; ++it) {
        float4 g = *(const float4*)(p.norm_gain + it * 256 + lane * 4);
        uint2 o; o.x = pk2(v[it].x * inv * g.x, v[it].y * inv * g.y); o.y = pk2(v[it].z * inv * g.z, v[it].w * inv * g.w);
        *(uint2*)(HN + (size_t)row * 1024 + it * 256 + lane * 4) = o;
        o.x = pk2(u[it].x * inu * g.x, u[it].y * inu * g.y); o.y = pk2(u[it].z * inu * g.z, u[it].w * inu * g.w);
        *(uint2*)(HN + (size_t)row1 * 1024 + it * 256 + lane * 4) = o;
      }
    }
  }
  const int gt = bid * 512 + tid, gn = nb * 512;
  {
    u16* KAS = (u16*)(p.ws + WS_KAS);
#pragma unroll 4
    for (int i = gt; i < 524288; i += gn) {
      int e = i * 4, b = e >> 18, key = (e >> 9) & 511, f = e & 511;
      float4 v = *(const float4*)(p.cache_a_k + e);
      uint2 o; o.x = pk2(v.x, v.y); o.y = pk2(v.z, v.w);
      *(uint2*)(KAS + (size_t)(b * 544 + key) * 512 + f) = o;
      if (key >= 32) *(float4*)(p.out + O_AKS + (size_t)(b * 512 + key - 32) * 512 + f) = v;
    }
    u16* KBS = (u16*)(p.ws + WS_KBS);
#pragma unroll 4
    for (int i = gt; i < 1048576; i += gn) {
      int e = i * 4, b = e >> 19, key = (e >> 9) & 1023, f = e & 511;
      float4 v = *(const float4*)(p.cache_b_k + e);
      uint2 o; o.x = pk2(v.x, v.y); o.y = pk2(v.z, v.w);
      *(uint2*)(KBS + (size_t)(b * 1056 + key) * 512 + f) = o;
    }
    u16* VATS = (u16*)(p.ws + WS_VATS);
#pragma unroll 2
    for (int i = gt; i < 262144; i += gn) {
      int f = i & 511, kg = (i >> 9) & 63, b = i >> 15;
      float v[8];
#pragma unroll
      for (int j = 0; j < 8; ++j) v[j] = p.cache_a_v[(size_t)(b * 512 + kg * 8 + j) * 512 + f];
      uint4 o; o.x = pk2(v[0], v[1]); o.y = pk2(v[2], v[3]); o.z = pk2(v[4], v[5]); o.w = pk2(v[6], v[7]);
      *(uint4*)(VATS + (size_t)(b * 512 + f) * 544 + kg * 8) = o;
      if (kg >= 4) {
#pragma unroll
        for (int j = 0; j < 8; ++j) p.out[O_AVS + (size_t)(b * 512 + kg * 8 + j - 32) * 512 + f] = v[j];
      }
    }
    u16* VBTS = (u16*)(p.ws + WS_VBTS);
#pragma unroll 2
    for (int i = gt; i < 524288; i += gn) {
      int f = i & 511, kg = (i >> 9) & 127, b = i >> 16;
      float v[8];
#pragma unroll
      for (int j = 0; j < 8; ++j) v[j] = p.cache_b_v[(size_t)(b * 1024 + kg * 8 + j) * 512 + f];
      uint4 o; o.x = pk2(v[0], v[1]); o.y = pk2(v[2], v[3]); o.z = pk2(v[4], v[5]); o.w = pk2(v[6], v[7]);
      *(uint4*)(VBTS + (size_t)(b * 512 + f) * 1056 + kg * 8) = o;
    }
  }
  {
    float2* RT = (float2*)(p.ws + WS_ROPE);
    for (int i = gt; i < 65536; i += gn) {
      int pos = i >> 3, m = i & 7;
      float inv = powf(500000.f, -(float)m * 0.125f);
      float ang = (float)pos * inv;
      RT[i] = make_float2(cosf(ang), sinf(ang));
    }
  }
}

template <int NJ>
DI void gemm_mainloop(const u16* __restrict__ A, const u16* __restrict__ Bt, int row0, int col0, char* lds, f32x16 (&acc)[2][NJ]) {
  constexpr int STAGE = 32768 + NJ * 8192;
  int tid = threadIdx.x;
  asm volatile("" : "+v"(tid));
  const int lane = tid & 63, w = tid >> 6, wm = w >> 1, wn = w & 1;
  const int r = lane & 31, h = lane >> 5;
  const u16* pa = A + (size_t)(row0 + (tid >> 3)) * 1024 + (tid & 7) * 8;
  const u16* pb = Bt + (size_t)(col0 + (tid >> 3)) * 1024 + (tid & 7) * 8;
  const int wofs = (tid >> 3) * 128 + ((((tid & 7) ^ ((tid >> 4) & 7))) << 4);
  const int swr = (r >> 1) & 7;
#pragma unroll
  for (int i = 0; i < 2; ++i)
#pragma unroll
    for (int j = 0; j < NJ; ++j)
#pragma unroll
      for (int e = 0; e < 16; ++e) acc[i][j][e] = 0.f;
  uint4 ra[4], rb[NJ];
#define GM_ISSUE(KB)                                                                          \
  { _Pragma("unroll") for (int it = 0; it < 4; ++it) gld16(ra[it], pa + (size_t)it * 65536 + (KB) * 64); \
    _Pragma("unroll") for (int it = 0; it < NJ; ++it) gld16(rb[it], pb + (size_t)it * 65536 + (KB) * 64); }
#define GM_PARK(ST)                                                                           \
  { char* bw_ = lds + (ST) * STAGE;                                                           \
    _Pragma("unroll") for (int it = 0; it < 4; ++it) *(uint4*)(bw_ + it * 8192 + wofs) = ra[it]; \
    _Pragma("unroll") for (int it = 0; it < NJ; ++it) *(uint4*)(bw_ + 32768 + it * 8192 + wofs) = rb[it]; }
  GM_ISSUE(0)
  WAIT_VM(0);
  GM_PARK(0)
  __syncthreads();
#pragma unroll 1
  for (int kt = 0; kt < 16; ++kt) {
    if (kt + 1 < 16) GM_ISSUE(kt + 1)
    __builtin_amdgcn_sched_barrier(0);
    const char* ba = lds + (kt & 1) * STAGE;
    const char* bb = ba + 32768;
    bf16x8 hf[2][2], wf[NJ];
    {
      const int co = ((h ^ swr) << 4);
#pragma unroll
      for (int i = 0; i < 2; ++i) hf[0][i] = *(const bf16x8*)(ba + (wm * 64 + i * 32 + r) * 128 + co);
#pragma unroll
      for (int j = 0; j < NJ; ++j) wf[j] = *(const bf16x8*)(bb + (wn * 32 * NJ + j * 32 + r) * 128 + co);
    }
#pragma unroll
    for (int s = 0; s < 4; ++s) {
      const int co = (((2 * (s + 1) + h) ^ swr) << 4);
      if (s < 3) {
#pragma unroll
        for (int i = 0; i < 2; ++i) hf[(s + 1) & 1][i] = *(const bf16x8*)(ba + (wm * 64 + i * 32 + r) * 128 + co);
      }
      __builtin_amdgcn_s_setprio(1);
#pragma unroll
      for (int j = 0; j < NJ; ++j) {
        acc[0][j] = MFMA(hf[s & 1][0], wf[j], acc[0][j]);
        acc[1][j] = MFMA(hf[s & 1][1], wf[j], acc[1][j]);
        if (s < 3) wf[j] = *(const bf16x8*)(bb + (wn * 32 * NJ + j * 32 + r) * 128 + co);
      }
      __builtin_amdgcn_s_setprio(0);
      __builtin_amdgcn_sched_barrier(0);
      if (kt + 1 < 16 && s == 1) {
        asm volatile("s_waitcnt vmcnt(%0)" :: "n"(NJ) : "memory");
        char* bw_ = lds + ((kt + 1) & 1) * STAGE;
#pragma unroll
        for (int it = 0; it < 4; ++it) *(uint4*)(bw_ + it * 8192 + wofs) = ra[it];
        __builtin_amdgcn_sched_barrier(0);
      }
      if (kt + 1 < 16 && s == 2) {
        WAIT_VM(0);
        char* bw_ = lds + ((kt + 1) & 1) * STAGE;
#pragma unroll
        for (int it = 0; it < NJ; ++it) *(uint4*)(bw_ + 32768 + it * 8192 + wofs) = rb[it];
        __builtin_amdgcn_sched_barrier(0);
      }
    }
    __syncthreads();
  }
#undef GM_ISSUE
#undef GM_PARK
}

DI float silu(float x) { return x * __builtin_amdgcn_rcpf(1.f + __expf(-x)); }

DI float dpp_x1(float v) { return __int_as_float(__builtin_amdgcn_update_dpp(0, __float_as_int(v), 0xB1, 0xF, 0xF, true)); }
DI float dpp_x8(float v) { return __int_as_float(__builtin_amdgcn_update_dpp(0, __float_as_int(v), 0x128, 0xF, 0xF, true)); }
DI void store_bf16_tile(const f32x16& a, u16* base  , size_t ld, int h, int odd) {
#pragma unroll
  for (int g = 0; g < 4; ++g)
#pragma unroll
    for (int e = 0; e < 4; e += 2) {
      const float v0 = a[4 * g + e], v1 = a[4 * g + e + 1];
      const float n0 = dpp_x1(v0), n1 = dpp_x1(v1);
      const u32 o = odd ? pk2(n1, v1) : pk2(v0, n0);
      *(u32*)(base + (size_t)(8 * g + 4 * h + e + odd) * ld) = o;
      if (e == 2) __builtin_amdgcn_sched_barrier(0);
    }
}
template <int NJ, int sec>
DI void p1_tile(const Params& p, char* lds, int tm, int col0) {
  constexpr int WN = 32 * NJ;
  const u16* HN = (const u16*)(p.ws + WS_HN);
  const u16* WT = (const u16*)(p.ws + WS_WINT);
  const float2* RT = (const float2*)(p.ws + WS_ROPE);
  const int fbase = col0 & 511;
  const bool sample = (tm == 64);
  f32x16 acc[2][NJ];
  gemm_mainloop<NJ>(HN, WT, tm * 256, col0, lds, acc);
  int tid = threadIdx.x;
  asm volatile("" : "+v"(tid));
  const int lane = tid & 63, w = tid >> 6, wm = w >> 1, wn = w & 1;
  const int r = lane & 31, h = lane >> 5, odd = r & 1;
  const int tb = tm * 256 + wm * 64;
  const int fb = fbase + wn * WN;
  if (sec == 2 || sec == 6) {
#pragma unroll
    for (int i = 0; i < 2; ++i) {
      float* dbase = nullptr;
      {
        const int t0 = tb + i * 32;
        if (!sample) {
          const int b = t0 >> 13, s0 = t0 & 8191;
          if (sec == 6) dbase = p.out + O_BVP + (size_t)t0 * 512;
          else if (s0 >= 7680) dbase = p.out + O_AVP + ((size_t)(b * 512 + s0 - 7680)) * 512;
        } else {
          const int ts = t0 - NTOKP, b = ts >> 5;
          if (sec == 6) dbase = p.out + O_BVS + (size_t)ts * 512;
          else dbase = p.out + O_AVS + ((size_t)(b * 512 + 480)) * 512;
        }
      }
#pragma unroll
      for (int j = 0; j < NJ; ++j) {
        unsigned lo = (wn * WN + j * 32 + r) * 528 + (wm * 64 + i * 32 + 4 * h) * 2;
        asm volatile("" : "+v"(lo));
#pragma unroll
        for (int g = 0; g < 4; ++g) {
          const float v0 = acc[i][j][4 * g], v1 = acc[i][j][4 * g + 1], v2 = acc[i][j][4 * g + 2], v3 = acc[i][j][4 * g + 3];
          uint2 o; o.x = pk2(v0, v1); o.y = pk2(v2, v3);
          *(uint2*)(lds + lo + g * 16) = o;
          if (dbase) {
            unsigned off = (8 * g + 4 * h) * 512 + fb + j * 32 + r;
            asm volatile("" : "+v"(off));
            dbase[off] = v0; dbase[off + 512] = v1; dbase[off + 1024] = v2; dbase[off + 1536] = v3;
          }
          __builtin_amdgcn_sched_barrier(0);
        }
      }
    }
    __syncthreads();
    {
      u16* VT; size_t ldv;
      if (sec == 2) { VT = (u16*)(p.ws + (sample ? WS_VATS : WS_VAT)); ldv = sample ? 544 : 8192; }
      else { VT = (u16*)(p.ws + (sample ? WS_VBTS : WS_VBT)); ldv = sample ? 1056 : 8192; }
      const int sofs = sample ? (sec == 2 ? 512 : 1024) : 0;
#pragma unroll
      for (int it = 0; it < 4 * NJ; ++it) {
        const int id = it * 512 + tid, row = id >> 5, c = id & 31;
        const uint4 v = *(const uint4*)(lds + row * 528 + c * 16);
        const int fs = fbase + row;
        if (!sample) {
          const int t0 = tm * 256 + c * 8, b = t0 >> 13, s = t0 & 8191;
          *(uint4*)(VT + ((size_t)(b * 512 + fs)) * ldv + s) = v;
        } else {
          const int b = c >> 2, tt = (c & 3) * 8;
          *(uint4*)(VT + ((size_t)(b * 512 + fs)) * ldv + sofs + tt) = v;
        }
        if ((it & 3) == 3) __builtin_amdgcn_sched_barrier(0);
      }
    }
    __syncthreads();
  } else {
    if (sec == 4 || sec == 5) {
      const float sgn = (r & 8) ? 1.f : -1.f;
      const int pos0 = sample ? (1024 + 4 * h) : ((tb & 8191) + 4 * h);
      const float2* rt = RT + pos0 * 8 + (r & 7);
#pragma unroll
      for (int i = 0; i < 2; ++i)
#pragma unroll
        for (int g = 0; g < 4; ++g) {
          const int po = (sample ? 0 : i * 32) + 8 * g;
          float2 cs[4];
#pragma unroll
          for (int e = 0; e < 4; ++e) cs[e] = rt[(po + e) * 8];
          __builtin_amdgcn_sched_barrier(0);
#pragma unroll
          for (int j = 0; j < NJ; j += 2)
#pragma unroll
            for (int e = 0; e < 4; ++e) {
              const float x = acc[i][j][4 * g + e];
              const float xp = dpp_x8(x);
              if (r < 16) acc[i][j][4 * g + e] = x * cs[e].x + sgn * xp * cs[e].y;
            }
          __builtin_amdgcn_sched_barrier(0);
        }
    }
    if (sec == 3 || sec == 7) {
#pragma unroll
      for (int i = 0; i < 2; ++i)
#pragma unroll
        for (int j = 0; j < NJ; ++j)
#pragma unroll
          for (int e = 0; e < 16; ++e) acc[i][j][e] = silu(acc[i][j][e]);
    }
    u16* dst; size_t trow0;
    if (sec == 0) { dst = (u16*)(p.ws + WS_QA); trow0 = tb; }
    else if (sec == 3) { dst = (u16*)(p.ws + WS_GA); trow0 = tb; }
    else if (sec == 4) { dst = (u16*)(p.ws + WS_QB); trow0 = tb; }
    else if (sec == 7) { dst = (u16*)(p.ws + WS_GB); trow0 = tb; }
    else if (sec == 1) {
      if (!sample) { dst = (u16*)(p.ws + WS_KA); trow0 = tb; }
      else { dst = (u16*)(p.ws + WS_KAS); trow0 = (size_t)(wm * 2) * 544 + 512; }
    } else {
      if (!sample) { dst = (u16*)(p.ws + WS_KB); trow0 = tb; }
      else { dst = (u16*)(p.ws + WS_KBS); trow0 = (size_t)(wm * 2) * 1056 + 1024; }
    }
    const size_t istep = sample ? (sec == 1 ? 544 : (sec == 5 ? 1056 : 32)) : 32;
#pragma unroll
    for (int i = 0; i < 2; ++i)
#pragma unroll
      for (int j = 0; j < NJ; ++j)
        store_bf16_tile(acc[i][j], dst + (trow0 + i * istep) * 512 + fb + j * 32 + (r & ~1), 512, h, odd);
    if (sec == 1 || sec == 5) {
#pragma unroll
      for (int i = 0; i < 2; ++i) {
        float* d = nullptr;
        const int t0 = tb + i * 32;
        if (!sample) {
          const int b = t0 >> 13, s = t0 & 8191;
          if (sec == 5) d = p.out + O_BKP + (size_t)t0 * 512;
          else if (s >= 7680) d = p.out + O_AKP + ((size_t)(b * 512 + s - 7680)) * 512;
        } else {
          const int ts = t0 - NTOKP, b = ts >> 5;
          if (sec == 5) d = p.out + O_BKS + (size_t)ts * 512;
          else d = p.out + O_AKS + ((size_t)(b * 512 + 480)) * 512;
        }
        if (d) {
#pragma unroll
          for (int j = 0; j < NJ; ++j)
#pragma unroll
            for (int e = 0; e < 16; ++e) {
              d[(size_t)(8 * (e >> 2) + 4 * h + (e & 3)) * 512 + fb + j * 32 + r] = acc[i][j][e];
              if ((e & 3) == 3) __builtin_amdgcn_sched_barrier(0);
            }
        }
      }
    }
  }
}
template <int NJ>
DI void p1_dispatch(const Params& p, char* lds, int tm, int col0) {
  switch (col0 >> 9) {
    case 0: p1_tile<NJ, 0>(p, lds, tm, col0); break;
    case 1: p1_tile<NJ, 1>(p, lds, tm, col0); break;
    case 2: p1_tile<NJ, 2>(p, lds, tm, col0); break;
    case 3: p1_tile<NJ, 3>(p, lds, tm, col0); break;
    case 4: p1_tile<NJ, 4>(p, lds, tm, col0); break;
    case 5: p1_tile<NJ, 5>(p, lds, tm, col0); break;
    case 6: p1_tile<NJ, 6>(p, lds, tm, col0); break;
    default: p1_tile<NJ, 7>(p, lds, tm, col0); break;
  }
}
DI void phase1(const Params& p, char* lds) {
  for (int tile = blockIdx.x; tile < 1024; tile += gridDim.x) {
    const int k = tile >> 8, b = tile & 255, xcd = b & 7, idx = b >> 3;
    const int tm = 16 * k + (xcd >> 1) * 4 + (idx & 3), tn = (xcd & 1) * 8 + (idx >> 2);
    p1_dispatch<4>(p, lds, tm, tn * 256);
  }
}

constexpr float SM_C = 0.125f * 1.4426950408889634f;
template <int NQT, int DVT, bool BIAS>
DI void attn_wave(const u16* __restrict__ Q, int ldq, const u16* __restrict__ K, int ldk,
                  const u16* __restrict__ Vt, int ldv, int nkt, const float* bias_l2, int rel0,
                  f32x16 (&O)[NQT][DVT], float (&Mx)[NQT], float (&L)[NQT]) {
  const int lane = threadIdx.x & 63, r = lane & 31, h = lane >> 5;
  bf16x8 qf[NQT][4];
#pragma unroll
  for (int u = 0; u < NQT; ++u)
#pragma unroll
    for (int s = 0; s < 4; ++s) qf[u][s] = *(const bf16x8*)(Q + (size_t)(32 * u + r) * ldq + 16 * s + 8 * h);
#pragma unroll
  for (int u = 0; u < NQT; ++u) {
    Mx[u] = -INFINITY; L[u] = 0.f;
#pragma unroll
    for (int dt = 0; dt < DVT; ++dt)
#pragma unroll
      for (int e = 0; e < 16; ++e) O[u][dt][e] = 0.f;
  }
  const u16* kp = K + (size_t)rho(r) * ldk + 8 * h;
  const u16* vp = Vt + (size_t)r * ldv + 8 * h;
  bf16x8 kf[4];
#pragma unroll
  for (int s = 0; s < 4; ++s) kf[s] = *(const bf16x8*)(kp + 16 * s);
  for (int kt = 0; kt < nkt; ++kt) {
    bf16x8 vf[DVT][2];
#pragma unroll
    for (int dt = 0; dt < DVT; ++dt)
#pragma unroll
      for (int s2 = 0; s2 < 2; ++s2) vf[dt][s2] = *(const bf16x8*)(vp + (size_t)(32 * dt) * ldv + 32 * kt + 16 * s2);
    bf16x8 kn[4];
    {
      const int ktn = (kt + 1 < nkt) ? kt + 1 : kt;
#pragma unroll
      for (int s = 0; s < 4; ++s) kn[s] = *(const bf16x8*)(kp + (size_t)(32 * ktn) * ldk + 16 * s);
    }
    bf16x8 pf[NQT][2];
#pragma unroll
    for (int u = 0; u < NQT; ++u) {
      f32x16 S;
#pragma unroll
      for (int e = 0; e < 16; ++e) S[e] = 0.f;
#pragma unroll
      for (int s = 0; s < 4; ++s) S = MFMA(kf[s], qf[u][s], S);
      float t[16];
      if (BIAS) {
        const int relb = rel0 + 32 * u + r - 32 * kt - 8 * h;
        if (rel0 - 32 * kt - 31 >= 128) {
          const float bv = bias_l2[256];
#pragma unroll
          for (int e = 0; e < 16; ++e) t[e] = S[e] * SM_C + bv;
        } else {
#pragma unroll
          for (int e = 0; e < 16; ++e) {
            int rel = relb - ((e & 7) + 16 * (e >> 3));
            rel = rel < -128 ? -128 : (rel > 128 ? 128 : rel);
            t[e] = S[e] * SM_C + bias_l2[rel + 128];
          }
        }
      } else {
#pragma unroll
        for (int e = 0; e < 16; ++e) t[e] = S[e] * SM_C;
      }
      float mx = t[0];
#pragma unroll
      for (int e = 1; e < 16; ++e) mx = fmaxf(mx, t[e]);
      mx = fmaxf(mx, __shfl_xor(mx, 32));
      if (__any(mx > Mx[u] + 8.f)) {
        const float mn = fmaxf(Mx[u], mx);
        const float al = __builtin_amdgcn_exp2f(Mx[u] - mn);
        Mx[u] = mn; L[u] *= al;
#pragma unroll
        for (int dt = 0; dt < DVT; ++dt)
#pragma unroll
          for (int e = 0; e < 16; ++e) O[u][dt][e] *= al;
      }
      float ps = 0.f;
#pragma unroll
      for (int e = 0; e < 16; ++e) { t[e] = __builtin_amdgcn_exp2f(t[e] - Mx[u]); ps += t[e]; }
      L[u] += ps;
#pragma unroll
      for (int s2 = 0; s2 < 2; ++s2) {
        uint4 pk;
        pk.x = pk2(t[8 * s2], t[8 * s2 + 1]); pk.y = pk2(t[8 * s2 + 2], t[8 * s2 + 3]);
        pk.z = pk2(t[8 * s2 + 4], t[8 * s2 + 5]); pk.w = pk2(t[8 * s2 + 6], t[8 * s2 + 7]);
        pf[u][s2] = __builtin_bit_cast(bf16x8, pk);
      }
    }
#pragma unroll
    for (int u = 0; u < NQT; ++u)
#pragma unroll
      for (int dt = 0; dt < DVT; ++dt)
#pragma unroll
        for (int s2 = 0; s2 < 2; ++s2) O[u][dt] = MFMA(vf[dt][s2], pf[u][s2], O[u][dt]);
#pragma unroll
    for (int s = 0; s < 4; ++s) kf[s] = kn[s];
  }
#pragma unroll
  for (int u = 0; u < NQT; ++u) L[u] += __shfl_xor(L[u], 32);
}

template <int NQT>
DI void attnA_item(const Params& p, const u16* Q, const u16* K, const u16* Vt, int ldv, int nkt, int rel0,
                   const float* bias_l2, int tok0, int head) {
  f32x16 O[NQT][2]; float Mx[NQT], L[NQT];
  attn_wave<NQT, 2, true>(Q, 512, K, 512, Vt, ldv, nkt, bias_l2, rel0, O, Mx, L);
  const int lane = threadIdx.x & 63, r = lane & 31, h = lane >> 5;
  const u16* GA = (const u16*)(p.ws + WS_GA);
  u16* OB = (u16*)(p.ws + WS_HN);
#pragma unroll
  for (int u = 0; u < NQT; ++u) {
    const float inv = 1.f / L[u];
    const size_t tok = (size_t)(tok0 + 32 * u + r);
#pragma unroll
    for (int dt = 0; dt < 2; ++dt)
#pragma unroll
      for (int g = 0; g < 4; ++g) {
        const int dv = 32 * dt + 8 * g + 4 * h;
        const uint2 gg = *(const uint2*)(GA + tok * 512 + head * 64 + dv);
        uint2 o;
        o.x = pk2(O[u][dt][4 * g] * inv * bflo(gg.x), O[u][dt][4 * g + 1] * inv * bfhi(gg.x));
        o.y = pk2(O[u][dt][4 * g + 2] * inv * bflo(gg.y), O[u][dt][4 * g + 3] * inv * bfhi(gg.y));
        *(uint2*)(OB + tok * 1024 + head * 64 + dv) = o;
      }
  }
}

DI void attnB_epilogue(const Params& p, f32x16 (&O)[4], float Lsum, int tok0, int hb, float lam, float* xch) {
  const int lane = threadIdx.x & 63, r = lane & 31, h = lane >> 5, w = threadIdx.x >> 6, m = w >> 2, wsub = w & 3;
  const float inv = 1.f / Lsum;
  float* xw = xch + wsub * 4096 + lane;
  if (m == 1) {
    const float sc = inv * lam;
#pragma unroll
    for (int dt = 0; dt < 4; ++dt)
#pragma unroll
      for (int e = 0; e < 16; ++e) xw[(dt * 16 + e) * 64] = O[dt][e] * sc;
  }
  __syncthreads();
  if (m == 0) {
    float ss = 0.f;
#pragma unroll
    for (int dt = 0; dt < 4; ++dt)
#pragma unroll
      for (int e = 0; e < 16; ++e) { float o = O[dt][e] * inv - xw[(dt * 16 + e) * 64]; O[dt][e] = o; ss += o * o; }
    ss += __shfl_xor(ss, 32);
    const float rn = rsqrtf(ss * (1.f / 128.f) + 1e-6f) * 0.8f;
    const u16* GB = (const u16*)(p.ws + WS_GB);
    u16* OB = (u16*)(p.ws + WS_HN);
    const size_t tok = (size_t)(tok0 + r);
#pragma unroll
    for (int dt = 0; dt < 4; ++dt)
#pragma unroll
      for (int g = 0; g < 4; ++g) {
        const int dv = 32 * dt + 8 * g + 4 * h;
        const uint2 gg = *(const uint2*)(GB + tok * 512 + hb * 128 + dv);
        const float4 sg = *(const float4*)(p.subln + dv);
        uint2 o;
        o.x = pk2(O[dt][4 * g] * rn * sg.x * bflo(gg.x), O[dt][4 * g + 1] * rn * sg.y * bfhi(gg.x));
        o.y = pk2(O[dt][4 * g + 2] * rn * sg.z * bflo(gg.y), O[dt][4 * g + 3] * rn * sg.w * bfhi(gg.y));
        *(uint2*)(OB + tok * 1024 + 512 + hb * 128 + dv) = o;
      }
  }
  __syncthreads();
}

DI void attnB_item(const Params& p, const u16* Q, const u16* K, const u16* Vt, int ldv, int nkt, int tok0, int hb,
                   float lam, float* xch) {
  f32x16 O[1][4]; float Mx[1], L[1];
  attn_wave<1, 4, false>(Q, 512, K, 512, Vt, ldv, nkt, nullptr, 0, O, Mx, L);
  attnB_epilogue(p, O[0], L[0], tok0, hb, lam, xch);
}

typedef float f2 __attribute__((ext_vector_type(2)));
constexpr int BLK_V = 0, BLK_K = 65536, BLK_XCH = 0, LDS_BIAS = 147456;
DI float half_max(float v) {
  auto rr = __builtin_amdgcn_permlane32_swap(__float_as_uint(v), __float_as_uint(v), false, false);
  return fmaxf(__uint_as_float(rr[0]), __uint_as_float(rr[1]));
}
DI void attnB_block(const Params& p, int b, int hb, int qt, float lam, char* lds) {
  int tid = threadIdx.x;
  asm volatile("" : "+v"(tid));
  const int lane = tid & 63, r = lane & 31, h = lane >> 5, w = tid >> 6, m = w >> 2, wsub = w & 3;
  constexpr bool late = false;
  const int q0 = qt * 128 + wsub * 32;
  const int nt = 2 * qt + 2;
  const int my_nt = (q0 >> 6) + 1;
  uint4 qraw[4];
  {
    const u16* Q = (const u16*)(p.ws + WS_QB) + (size_t)(b * SEQ + q0 + r) * 512 + hb * 128 + m * 64 + 8 * h;
#pragma unroll
    for (int s = 0; s < 4; ++s) gld16(qraw[s], Q + 16 * s);
  }
  f32x16 O[4];
#pragma unroll
  for (int dt = 0; dt < 4; ++dt)
#pragma unroll
    for (int e = 0; e < 16; ++e) O[dt][e] = 0.f;
  float Mx = -INFINITY;
  f2 L2 = {0.f, 0.f};
  const u16* gk = (const u16*)(p.ws + WS_KB) + (size_t)(b * SEQ + (tid >> 4)) * 512 + hb * 128 + (tid & 15) * 8;
  const u16* gv = (const u16*)(p.ws + WS_VBT) + (size_t)(b * 512 + hb * 128 + (tid >> 3)) * SEQ + (tid & 7) * 8;
  const int lk = BLK_K + ((tid >> 3) & 1) * 8192 + (tid >> 4) * 128 + ((((tid & 7) ^ ((tid >> 5) & 7))) << 4);
  const int lv = BLK_V + (tid >> 3) * 128 + ((((tid & 7) ^ ((tid >> 4) & 7))) << 4);
  const int rr = rho(r);
  const int swk = (rr >> 1) & 7, swv = (r >> 1) & 7;
  uint4 sk0, sk1, sv0, sv1;
  gld16(sk0, gk); gld16(sk1, gk + (size_t)32 * 512);
  gld16(sv0, gv); gld16(sv1, gv + (size_t)64 * SEQ);
  wait_vm0();
  *(uint4*)(lds + lk) = sk0; *(uint4*)(lds + lk + 4096) = sk1;
  *(uint4*)(lds + lv) = sv0; *(uint4*)(lds + lv + 8192) = sv1;
  asm volatile("s_waitcnt lgkmcnt(0)" ::: "memory");
  gld16(sk0, gk + (size_t)64 * 512); gld16(sk1, gk + (size_t)96 * 512);
  gld16(sv0, gv + 64); gld16(sv1, gv + (size_t)64 * SEQ + 64);
  wait_vm0();
  *(uint4*)(lds + lk + 16384) = sk0; *(uint4*)(lds + lk + 16384 + 4096) = sk1;
  *(uint4*)(lds + lv + 16384) = sv0; *(uint4*)(lds + lv + 16384 + 8192) = sv1;
  bf16x8 qf[4];
#pragma unroll
  for (int s = 0; s < 4; ++s) qf[s] = __builtin_bit_cast(bf16x8, qraw[s]);
  bf16x8 pf[4];
#pragma unroll
  for (int s = 0; s < 4; ++s) pf[s] = qf[s];
  __syncthreads();
  for (int t = 0; t < nt; ++t) {
    if (t + 2 < nt) {
      gld16(sk0, gk + (size_t)(64 * (t + 2)) * 512);
      gld16(sk1, gk + (size_t)(64 * (t + 2) + 32) * 512);
      gld16(sv0, gv + 64 * (t + 2));
      gld16(sv1, gv + (size_t)64 * SEQ + 64 * (t + 2));
    }
    __builtin_amdgcn_sched_barrier(0);
    if (t < my_nt) {
      const char* kb = lds + BLK_K + (t & 3) * 16384 + m * 8192;
      f32x16 S0, S1;
#pragma unroll
      for (int e = 0; e < 16; ++e) { S0[e] = 0.f; S1[e] = 0.f; }
      bf16x8 ka[4], kc[4];
#pragma unroll
      for (int s = 0; s < 4; ++s) {
        const int co = (((2 * s + h) ^ swk) << 4);
        ka[s] = *(const bf16x8*)(kb + rr * 128 + co);
        kc[s] = *(const bf16x8*)(kb + (32 + rr) * 128 + co);
      }
#pragma unroll
      for (int s = 0; s < 4; ++s) {
        S0 = MFMA(ka[s], qf[s], S0);
        S1 = MFMA(kc[s], qf[s], S1);
      }
      f2 tv[16];
      const f2 cc = {SM_C, SM_C};
#pragma unroll
      for (int e = 0; e < 8; ++e) {
        f2 a = {S0[2 * e], S0[2 * e + 1]}; tv[e] = a * cc;
        f2 c = {S1[2 * e], S1[2 * e + 1]}; tv[8 + e] = c * cc;
      }
      float mx = fmaxf(tv[0].x, tv[0].y);
#pragma unroll
      for (int e = 1; e < 16; ++e) mx = fmaxf(mx, fmaxf(tv[e].x, tv[e].y));
      mx = half_max(mx);
      if (__any(mx > Mx + 8.f)) {
        const float mn = fmaxf(Mx, mx);
        const float al = __builtin_amdgcn_exp2f(Mx - mn);
        Mx = mn; L2 *= al;
#pragma unroll
        for (int dt = 0; dt < 4; ++dt)
#pragma unroll
          for (int e = 0; e < 16; ++e) O[dt][e] *= al;
      }
      const f2 nm = {-Mx, -Mx};
#pragma unroll
      for (int e = 0; e < 16; ++e) {
        f2 d = tv[e] + nm;
        d.x = __builtin_amdgcn_exp2f(d.x); d.y = __builtin_amdgcn_exp2f(d.y);
        L2 += d;
        tv[e] = d;
      }
#pragma unroll
      for (int s2 = 0; s2 < 4; ++s2) {
        uint4 pa;
        pa.x = pk2(tv[4 * s2].x, tv[4 * s2].y); pa.y = pk2(tv[4 * s2 + 1].x, tv[4 * s2 + 1].y);
        pa.z = pk2(tv[4 * s2 + 2].x, tv[4 * s2 + 2].y); pa.w = pk2(tv[4 * s2 + 3].x, tv[4 * s2 + 3].y);
        pf[s2] = __builtin_bit_cast(bf16x8, pa);
      }
      if (!late) {
        const char* vb = lds + BLK_V + (t & 3) * 16384;
#pragma unroll
        for (int ks = 0; ks < 4; ++ks) {
          const int co = (((2 * ks + h) ^ swv) << 4);
#pragma unroll
          for (int dt = 0; dt < 4; ++dt) {
            bf16x8 v = *(const bf16x8*)(vb + (32 * dt + r) * 128 + co);
            O[dt] = MFMA(v, pf[ks], O[dt]);
          }
        }
      }
    }
    if (t + 2 < nt) {
      const int sl = ((t + 2) & 3) * 16384;
      wait_vm0();
      *(uint4*)(lds + lk + sl) = sk0; *(uint4*)(lds + lk + sl + 4096) = sk1;
      *(uint4*)(lds + lv + sl) = sv0; *(uint4*)(lds + lv + sl + 8192) = sv1;
    }
    if (t & 1) __syncthreads();
  }
  float L = L2.x + L2.y;
  L += __shfl_xor(L, 32);
  attnB_epilogue(p, O, L, b * SEQ + q0, hb, lam, (float*)(lds + BLK_XCH));
}

DI float phase2_setup(const Params& p, char* lds) {
  const int tid = threadIdx.x, lane = tid & 63;
  float* bias = (float*)(lds + LDS_BIAS);
  for (int i = tid; i < 8 * 257; i += 512) { int hh = i / 257, k = i - hh * 257; bias[hh * 260 + k] = p.rel_bias[i] * 1.4426950408889634f; }
  float a = p.lq1[lane] * p.lk1[lane], b = p.lq2[lane] * p.lk2[lane];
  a = wave_sum(a); b = wave_sum(b);
  __syncthreads();
  return expf(a) - expf(b) + 0.2f;
}
DI void p3_tile(const Params& p, char* lds, int tok0) {
  int tid = threadIdx.x;
  asm volatile("" : "+v"(tid));
  const int lane = tid & 63, w = tid >> 6, r = lane & 31, h = lane >> 5;
  const u16* OB = (const u16*)(p.ws + WS_HN);
  float* red = (float*)(lds + 131072);
  __syncthreads();
#pragma unroll
  for (int half = 0; half < 2; ++half) {
    uint4 a[8];
#pragma unroll
    for (int it = 0; it < 8; ++it) a[it] = *(const uint4*)(OB + (size_t)(tok0 + half * 32 + it * 4 + (tid >> 7)) * 1024 + (tid & 127) * 8);
#pragma unroll
    for (int it = 0; it < 8; ++it) {
      const int row = half * 32 + it * 4 + (tid >> 7);
      *(uint4*)(lds + row * 2048 + ((((tid & 127) ^ (row & 15))) << 4)) = a[it];
    }
  }
  f32x16 acc[2][4];
#pragma unroll
  for (int i = 0; i < 2; ++i)
#pragma unroll
    for (int j = 0; j < 4; ++j)
#pragma unroll
      for (int e = 0; e < 16; ++e) acc[i][j][e] = 0.f;
  const char* wp = p.ws + WS_WOUTT + ((size_t)(w * 4) * 4096 + lane) * 16;
  const char* ap = lds + r * 2048;
  const int akey = r & 15;
  uint4 bq[4][4];
#pragma unroll
  for (int s = 0; s < 4; ++s)
#pragma unroll
    for (int j = 0; j < 4; ++j) gld16(bq[s][j], wp + (size_t)(j * 4096 + s * 64) * 16);
  __syncthreads();
#define P3_KSTEP(KS, SLOT, WAITN, REFILL)                                                        \
  {                                                                                              \
    const int co_ = ((((2 * (KS) + h) ^ akey)) << 4);                                            \
    const bf16x8 a0_ = *(const bf16x8*)(ap + co_);                                               \
    const bf16x8 a1_ = *(const bf16x8*)(ap + 65536 + co_);                                       \
    WAIT_VM(WAITN);                                                                              \
    __builtin_amdgcn_sched_barrier(0);                                                           \
    __builtin_amdgcn_s_setprio(1);                                                               \
    _Pragma("unroll") for (int j = 0; j < 4; ++j) {                                              \
      const bf16x8 bf_ = __builtin_bit_cast(bf16x8, bq[SLOT][j]);                                \
      acc[0][j] = MFMA(a0_, bf_, acc[0][j]);                                                     \
      acc[1][j] = MFMA(a1_, bf_, acc[1][j]);                                                     \
    }                                                                                            \
    __builtin_amdgcn_s_setprio(0);                                                               \
    __builtin_amdgcn_sched_barrier(0);                                                           \
    if (REFILL) {                                                                                \
      _Pragma("unroll") for (int j = 0; j < 4; ++j) gld16(bq[SLOT][j], wp + (size_t)(j * 4096 + ((KS) + 4) * 64) * 16); \
    }                                                                                            \
    __builtin_amdgcn_sched_barrier(0);                                                           \
  }
#pragma unroll 1
  for (int g = 0; g < 15; ++g) {
    P3_KSTEP(4 * g, 0, 12, true)
    P3_KSTEP(4 * g + 1, 1, 12, true)
    P3_KSTEP(4 * g + 2, 2, 12, true)
    P3_KSTEP(4 * g + 3, 3, 12, true)
  }
  P3_KSTEP(60, 0, 12, false)
  P3_KSTEP(61, 1, 8, false)
  P3_KSTEP(62, 2, 4, false)
  P3_KSTEP(63, 3, 0, false)
  WAIT_VM(0);
  const float* xr = tok0 < NTOKP ? p.x_prompt + (size_t)tok0 * 1024 : p.x_sample + (size_t)(tok0 - NTOKP) * 1024;
  const unsigned cb = w * 128 + r;
#pragma unroll
  for (int i = 0; i < 2; ++i) {
#pragma unroll
    for (int e = 0; e < 16; ++e) {
      const int row = 32 * i + 8 * (e >> 2) + 4 * h + (e & 3);
      unsigned off = row * 1024 + cb;
      asm volatile("" : "+v"(off));
      float ssv = 0.f;
#pragma unroll
      for (int j = 0; j < 4; ++j) {
        const float y = acc[i][j][e] + xr[off + j * 32];
        acc[i][j][e] = y; ssv += y * y;
      }
      ssv += __shfl_xor(ssv, 1); ssv += __shfl_xor(ssv, 2); ssv += __shfl_xor(ssv, 4); ssv += __shfl_xor(ssv, 8); ssv += __shfl_xor(ssv, 16);
      if (r == 0) red[w * 64 + row] = ssv;
      if ((e & 3) == 3) __builtin_amdgcn_sched_barrier(0);
    }
  }
  __syncthreads();
  if (tid < 64) {
    float t = 0.f;
#pragma unroll
    for (int k = 0; k < 8; ++k) t += red[k * 64 + tid];
    red[512 + tid] = rsqrtf(t * (1.f / 1024.f) + 1e-6f);
  }
  __syncthreads();
  float* yr = p.out + O_YP + (size_t)tok0 * 1024;
  float gj[4];
#pragma unroll
  for (int j = 0; j < 4; ++j) gj[j] = p.final_gain[cb + j * 32];
#pragma unroll
  for (int i = 0; i < 2; ++i) {
#pragma unroll
    for (int e = 0; e < 16; ++e) {
      const int row = 32 * i + 8 * (e >> 2) + 4 * h + (e & 3);
      unsigned off = row * 1024 + cb;
      asm volatile("" : "+v"(off));
      const float ri = red[512 + row];
#pragma unroll
      for (int j = 0; j < 4; ++j) yr[off + j * 32] = acc[i][j][e] * ri * gj[j];
      if ((e & 3) == 3) __builtin_amdgcn_sched_barrier(0);
    }
  }
}

constexpr int NQUEUE = 14;
DI int q_pop(unsigned* ctr, int* slot) {
  __syncthreads();
  if (threadIdx.x == 0) *slot = (int)__hip_atomic_fetch_add(ctr, 1u, __ATOMIC_RELAXED, __HIP_MEMORY_SCOPE_AGENT);
  __syncthreads();
  return *slot;
}
DI void p2_all(const Params& p, char* lds, float lam) {
  const int w = threadIdx.x >> 6;
  unsigned* Q = (unsigned*)(p.ws + WS_QUEUE);
  int* slot = (int*)(lds + LDS_BIAS + 8320);
  float* xch = (float*)(lds + 65536);
  const float* bias = (const float*)(lds + LDS_BIAS);
  const u16* QA = (const u16*)(p.ws + WS_QA);
  const u16* QB = (const u16*)(p.ws + WS_QB);
  int firstp = 1;
#pragma unroll 1
  for (;;) {
    const int i = firstp ? (int)blockIdx.x : 32;
    firstp = 0;
    if (i >= 32) break;
    p1_dispatch<2>(p, lds, 64, i * 128);
    asm volatile("s_waitcnt vmcnt(0)" ::: "memory");
    __syncthreads();
    if (threadIdx.x == 0) {
      __builtin_amdgcn_fence(__ATOMIC_RELEASE, "agent");
      __hip_atomic_fetch_add(Q + 64 * 13, 1u, __ATOMIC_RELAXED, __HIP_MEMORY_SCOPE_AGENT);
    }
  }
  {
    const int it = (int)blockIdx.x - 32 >= 0 ? (int)blockIdx.x - 32 : 16;
    if (it < 16) {
      if (threadIdx.x == 0) {
        while (__hip_atomic_load(Q + 64 * 13, __ATOMIC_RELAXED, __HIP_MEMORY_SCOPE_AGENT) < 32u) __builtin_amdgcn_s_sleep(2);
        __builtin_amdgcn_fence(__ATOMIC_ACQUIRE, "agent");
      }
      __syncthreads();
    }
    if (it < 8) {
      const int m = w >> 2, wsub = w & 3, id = it * 4 + wsub, b = id >> 2, hb = id & 3;
      attnB_item(p, QB + (size_t)(NTOKP + b * 32) * 512 + hb * 128 + m * 64,
                 (const u16*)(p.ws + WS_KBS) + (size_t)(b * 1056) * 512 + hb * 128 + m * 64,
                 (const u16*)(p.ws + WS_VBTS) + (size_t)(b * 512 + hb * 128) * 1056, 1056, 33, NTOKP + b * 32, hb, lam, xch);
    } else if (it < 16) {
      const int b = it - 8;
      attnA_item<1>(p, QA + (size_t)(NTOKP + b * 32) * 512 + w * 64,
                    (const u16*)(p.ws + WS_KAS) + (size_t)(b * 544) * 512 + w * 64,
                    (const u16*)(p.ws + WS_VATS) + (size_t)(b * 512 + w * 64) * 544, 544, 17, 512, bias + w * 260,
                    NTOKP + b * 32, w);
    }
    if (it < 16) {
      asm volatile("s_waitcnt vmcnt(0)" ::: "memory");
      __syncthreads();
      if (threadIdx.x == 0) {
        __builtin_amdgcn_fence(__ATOMIC_RELEASE, "agent");
        __hip_atomic_fetch_add(Q + 64 * 11, 1u, __ATOMIC_RELAXED, __HIP_MEMORY_SCOPE_AGENT);
      }
    }
  }
  unsigned* T = (unsigned*)(p.ws + WS_QUEUE + 4096);
  bool didA = false;
  int k = 0;
#pragma unroll 1
  for (;;) {
    int i = q_pop(Q + 64 * (1 + ((blockIdx.x + k) & 7)), slot);
    if (i >= 64) { if (++k < 8) continue; i = -1; }
    if ((i < 0 || i >= 40) && !didA) {
      didA = true;
#pragma unroll 1
      for (;;) {
        const int it = q_pop(Q + 64 * 9, slot);
        if (it >= 256) break;
        const int b = it >> 7, c = it & 127, cs = c > 8 ? c - 8 : 0;
        int tl = threadIdx.x;
        asm volatile("" : "+v"(tl));
        const int ww = tl >> 6;
        attnA_item<2>(p, (const u16*)(p.ws + WS_QA) + (size_t)(b * SEQ + c * 64) * 512 + ww * 64,
                      (const u16*)(p.ws + WS_KA) + (size_t)(b * SEQ + cs * 64) * 512 + ww * 64,
                      (const u16*)(p.ws + WS_VAT) + (size_t)(b * 512 + ww * 64) * SEQ + cs * 64, SEQ,
                      (c + 1 - cs) * 2, 64 * (c - cs), (const float*)(lds + LDS_BIAS) + ww * 260, b * SEQ + c * 64, ww);
        asm volatile("s_waitcnt vmcnt(0)" ::: "memory");
        __syncthreads();
        if (threadIdx.x == 0) {
          __builtin_amdgcn_fence(__ATOMIC_RELEASE, "agent");
          __hip_atomic_fetch_add(T + it, 1u, __ATOMIC_RELAXED, __HIP_MEMORY_SCOPE_AGENT);
        }
      }
    }
    if (i < 0) break;
    const int x = (blockIdx.x + k) & 7;
    attnB_block(p, x >> 2, x & 3, 63 - i, lam, lds);
    asm volatile("s_waitcnt vmcnt(0)" ::: "memory");
    __syncthreads();
    if (threadIdx.x == 0) {
      __builtin_amdgcn_fence(__ATOMIC_RELEASE, "agent");
      unsigned* tt = T + (x >> 2) * 128 + 2 * (63 - i);
      __hip_atomic_fetch_add(tt, 1u, __ATOMIC_RELAXED, __HIP_MEMORY_SCOPE_AGENT);
      __hip_atomic_fetch_add(tt + 1, 1u, __ATOMIC_RELAXED, __HIP_MEMORY_SCOPE_AGENT);
    }
  }
#pragma unroll 1
  for (;;) {
    const int it = q_pop(Q + 64 * 10, slot);
    if (it >= 260) break;
    int tok0;
    if (threadIdx.x == 0) {
      if (it < 4) { while (__hip_atomic_load(Q + 64 * 11, __ATOMIC_RELAXED, __HIP_MEMORY_SCOPE_AGENT) < 16u) __builtin_amdgcn_s_sleep(2); }
      else { while (__hip_atomic_load(T + (259 - it), __ATOMIC_RELAXED, __HIP_MEMORY_SCOPE_AGENT) < 5u) __builtin_amdgcn_s_sleep(2); }
      __builtin_amdgcn_fence(__ATOMIC_ACQUIRE, "agent");
    }
    __syncthreads();
    if (it < 4) tok0 = NTOKP + it * 64; else tok0 = (259 - it) * 64;
    p3_tile(p, lds, tok0);
  }
}

DI void phase4(const Params& p) {
  const int lane = threadIdx.x & 63, w = threadIdx.x >> 6;
  for (int row = blockIdx.x * 8 + w; row < NTOK; row += gridDim.x * 8) {
    float* y = p.out + O_YP + (size_t)row * 1024;
    float4 v[4]; float ss = 0.f;
#pragma unroll
    for (int it = 0; it < 4; ++it) { v[it] = *(const float4*)(y + it * 256 + lane * 4); ss += v[it].x * v[it].x + v[it].y * v[it].y + v[it].z * v[it].z + v[it].w * v[it].w; }
    ss = wave_sum(ss);
    const float inv = rsqrtf(ss * (1.f / 1024.f) + 1e-6f);
#pragma unroll
    for (int it = 0; it < 4; ++it) {
      float4 g = *(const float4*)(p.final_gain + it * 256 + lane * 4);
      *(float4*)(y + it * 256 + lane * 4) = make_float4(v[it].x * inv * g.x, v[it].y * inv * g.y, v[it].z * inv * g.z, v[it].w * inv * g.w);
    }
  }
}

__global__ void __launch_bounds__(512) fwd_megakernel(Params p) {
  __shared__ __attribute__((aligned(16))) char lds[155904];
  cg::grid_group grid = cg::this_grid();
  unsigned* ctr = (unsigned*)(p.ws + WS_BAR);
  const unsigned G = gridDim.x;
  if (p.out == nullptr) grid.sync();
  phase0(p, lds);
  ctr_barrier(ctr, G);
  phase1(p, lds);
  ctr_barrier(ctr, 2 * G);
  {
    const float lam = phase2_setup(p, lds);
    p2_all(p, lds, lam);
  }
}

extern "C" void kernel_launch(void* const* d_in, const int* in_sizes, int n_in, void* d_out, int out_size, void* d_ws,
                              size_t ws_size, hipStream_t stream) {
  static int grid_blocks = 0;
  if (!grid_blocks) {
    int dev = 0, cus = 0, per_cu = 0;
    hipGetDevice(&dev);
    hipDeviceGetAttribute(&cus, hipDeviceAttributeMultiprocessorCount, dev);
    hipOccupancyMaxActiveBlocksPerMultiprocessor(&per_cu, fwd_megakernel, 512, 0);
    if (per_cu < 1) per_cu = 1;
    grid_blocks = cus;
  }
  Params p{};
  p.x_prompt = (const float*)d_in[0]; p.x_sample = (const float*)d_in[1];
  p.cache_a_k = (const float*)d_in[2]; p.cache_a_v = (const float*)d_in[3];
  p.cache_b_k = (const float*)d_in[4]; p.cache_b_v = (const float*)d_in[5];
  p.norm_gain = (const float*)d_in[6]; p.w_in = (const float*)d_in[7]; p.w_out = (const float*)d_in[8];
  p.rel_bias = (const float*)d_in[9];
  p.lq1 = (const float*)d_in[10]; p.lk1 = (const float*)d_in[11]; p.lq2 = (const float*)d_in[12]; p.lk2 = (const float*)d_in[13];
  p.subln = (const float*)d_in[14]; p.final_gain = (const float*)d_in[15];
  p.out = (float*)d_out; p.ws = (char*)d_ws;
  void* args[] = {&p};
  (void)hipMemsetAsync((char*)d_ws + WS_BAR, 0, 12288, stream);
  hipError_t e = hipLaunchCooperativeKernel((void*)fwd_megakernel, dim3(grid_blocks), dim3(512), args, 0, stream);
  if (e != hipSuccess) fprintf(stderr, "cooperative launch failed: %s (grid %d)\n", hipGetErrorString(e), grid_blocks);
}
```

```cpp
#include <hip/hip_runtime.h>
#include <hip/hip_cooperative_groups.h>
#include <cstdio>
namespace cg = cooperative_groups;

typedef short bf16x8 __attribute__((ext_vector_type(8)));
typedef float f32x16 __attribute__((ext_vector_type(16)));
typedef __bf16 bf2_t __attribute__((ext_vector_type(2)));
typedef float f2_t __attribute__((ext_vector_type(2)));
typedef unsigned u32;
typedef unsigned short u16;
#define DI __device__ __forceinline__
#define MFMA(a, b, c) __builtin_amdgcn_mfma_f32_32x32x16_bf16((a), (b), (c), 0, 0, 0)

constexpr int NTOKP = 16384;
constexpr int NTOK = 16640;
constexpr int SEQ = 8192;
constexpr size_t O_YP = 0;
constexpr size_t O_AKP = 17039360, O_AVP = 17563648, O_BKP = 18087936, O_BVP = 26476544;
constexpr size_t O_AKS = 34865152, O_AVS = 36962304, O_BKS = 39059456, O_BVS = 39190528;
constexpr size_t WS_WINT = 0;
constexpr size_t WS_WOUTT = WS_WINT + 8388608;
constexpr size_t WS_HN = WS_WOUTT + 2097152;
constexpr size_t WS_QA = WS_HN + 34078720;
constexpr size_t WS_KA = WS_QA + 17039360;
constexpr size_t WS_KAS = WS_KA + 16777216;
constexpr size_t WS_VAT = WS_KAS + 4456448;
constexpr size_t WS_VATS = WS_VAT + 16777216;
constexpr size_t WS_GA = WS_VATS + 4456448;
constexpr size_t WS_QB = WS_GA + 17039360;
constexpr size_t WS_KB = WS_QB + 17039360;
constexpr size_t WS_KBS = WS_KB + 16777216;
constexpr size_t WS_VBT = WS_KBS + 8650752;
constexpr size_t WS_VBTS = WS_VBT + 16777216;
constexpr size_t WS_GB = WS_VBTS + 8650752;
constexpr size_t WS_ROPE = WS_GB + 17039360;
constexpr size_t WS_BAR = WS_ROPE + 524288;
constexpr size_t WS_QUEUE = WS_BAR + 4096;
constexpr size_t WS_END = WS_QUEUE + 8192;

struct Params {
  const float* x_prompt; const float* x_sample;
  const float* cache_a_k; const float* cache_a_v; const float* cache_b_k; const float* cache_b_v;
  const float* norm_gain; const float* w_in; const float* w_out; const float* rel_bias;
  const float* lq1; const float* lk1; const float* lq2; const float* lk2;
  const float* subln; const float* final_gain;
  float* out; char* ws;
};

DI u32 pk2(float a, float b) { f2_t v = {a, b}; bf2_t r = __builtin_convertvector(v, bf2_t); return __builtin_bit_cast(u32, r); }
DI float bflo(u32 v) { return __uint_as_float(v << 16); }
DI float bfhi(u32 v) { return __uint_as_float(v & 0xffff0000u); }
DI int rho(int r) { return (r & ~12) | ((r & 4) << 1) | ((r & 8) >> 1); }
DI void gld16(uint4& dst, const void* p) { asm volatile("global_load_dwordx4 %0, %1, off" : "=v"(dst) : "v"(p) : "memory"); }
#define WAIT_VM(n) asm volatile("s_waitcnt vmcnt(" #n ")" ::: "memory")
DI void wait_vm0() { asm volatile("s_waitcnt vmcnt(0)" ::: "memory"); }
DI float wave_sum(float v) {
#pragma unroll
  for (int o = 32; o > 0; o >>= 1) v += __shfl_xor(v, o);
  return v;
}


DI void ctr_barrier(unsigned* ctr, unsigned target) {
  __syncthreads();
  if (threadIdx.x == 0) {
    __builtin_amdgcn_fence(__ATOMIC_RELEASE, "agent");
    __hip_atomic_fetch_add(ctr, 1u, __ATOMIC_RELAXED, __HIP_MEMORY_SCOPE_AGENT);
    while (__hip_atomic_load(ctr, __ATOMIC_RELAXED, __HIP_MEMORY_SCOPE_AGENT) < target) __builtin_amdgcn_s_sleep(1);
    __builtin_amdgcn_fence(__ATOMIC_ACQUIRE, "agent");
  }
  __syncthreads();
}

DI void phase0(const Params& p, char* lds) {
  const int tid = threadIdx.x, bid = blockIdx.x, nb = gridDim.x;
  const int lane = tid & 63, w = tid >> 6;
  float* tile = (float*)lds;
  for (int i = bid * 512 + tid; i < 131072; i += nb * 512) {
    const int ln = i & 63, s_ = (i >> 6) & 63, ct = i >> 12, r_ = ln & 31, h_ = ln >> 5;
    float v[8];
#pragma unroll
    for (int j = 0; j < 8; ++j) v[j] = p.w_out[(size_t)(16 * s_ + 8 * h_ + j) * 1024 + ct * 32 + r_];
    uint4 o; o.x = pk2(v[0], v[1]); o.y = pk2(v[2], v[3]); o.z = pk2(v[4], v[5]); o.w = pk2(v[6], v[7]);
    *(uint4*)(p.ws + WS_WOUTT + (size_t)i * 16) = o;
  }
  for (int t = bid; t < 1024; t += nb) {
    const float* W; u16* WT; int N, kt, nt;
    { W = p.w_in; WT = (u16*)(p.ws + WS_WINT); N = 4096; kt = t >> 6; nt = t & 63; }
#pragma unroll
    for (int it = 0; it < 8; ++it) {
      int idx = it * 512 + tid, kk = idx >> 6, nn = idx & 63;
      tile[kk * 65 + nn] = W[(size_t)(kt * 64 + kk) * N + nt * 64 + nn];
    }
    __syncthreads();
    {
      int n = tid >> 3, kg = tid & 7;
      float v[8];
#pragma unroll
      for (int j = 0; j < 8; ++j) v[j] = tile[(kg * 8 + j) * 65 + n];
      uint4 o; o.x = pk2(v[0], v[1]); o.y = pk2(v[2], v[3]); o.z = pk2(v[4], v[5]); o.w = pk2(v[6], v[7]);
      *(uint4*)(WT + (size_t)(nt * 64 + n) * 1024 + kt * 64 + kg * 8) = o;
    }
    __syncthreads();
  }
  {
    u16* HN = (u16*)(p.ws + WS_HN);
    for (int row = bid * 8 + w; row < NTOK; row += nb * 16) {
      const int row1 = row + nb * 8 < NTOK ? row + nb * 8 : row;
      const float* s0 = row < NTOKP ? p.x_prompt + (size_t)row * 1024 : p.x_sample + (size_t)(row - NTOKP) * 1024;
      const float* s1 = row1 < NTOKP ? p.x_prompt + (size_t)row1 * 1024 : p.x_sample + (size_t)(row1 - NTOKP) * 1024;
      float4 v[4], u[4]; float ss = 0.f, st = 0.f;
#pragma unroll
      for (int it = 0; it < 4; ++it) { v[it] = *(const float4*)(s0 + it * 256 + lane * 4); u[it] = *(const float4*)(s1 + it * 256 + lane * 4); }
#pragma unroll
      for (int it = 0; it < 4; ++it) {
        ss += v[it].x * v[it].x + v[it].y * v[it].y + v[it].z * v[it].z + v[it].w * v[it].w;
        st += u[it].x * u[it].x + u[it].y * u[it].y + u[it].z * u[it].z + u[it].w * u[it].w;
      }
      ss = wave_sum(ss); st = wave_sum(st);
      const float inv = rsqrtf(ss * (1.f / 1024.f) + 1e-6f), inu = rsqrtf(st * (1.f / 1024.f) + 1e-6f);
#pragma unroll
      for (int it = 0; it < 4; ++it) {
        float4 g = *(const float4*)(p.norm_gain + it * 256 + lane * 4);
        uint2 o; o.x = pk2(v[it].x * inv * g.x, v[it].y * inv * g.y); o.y = pk2(v[it].z * inv * g.z, v[it].w * inv * g.w);
        *(uint2*)(HN + (size_t)row * 1024 + it * 256 + lane * 4) = o;
        o.x = pk2(u[it].x * inu * g.x, u[it].y * inu * g.y); o.y = pk2(u[it].z * inu * g.z, u[it].w * inu * g.w);
        *(uint2*)(HN + (size_t)row1 * 1024 + it * 256 + lane * 4) = o;
      }
    }
  }
  const int gt = bid * 512 + tid, gn = nb * 512;
  {
    u16* KAS = (u16*)(p.ws + WS_KAS);
#pragma unroll 4
    for (int i = gt; i < 524288; i += gn) {
      int e = i * 4, b = e >> 18, key = (e >> 9) & 511, f = e & 511;
      float4 v = *(const float4*)(p.cache_a_k + e);
      uint2 o; o.x = pk2(v.x, v.y); o.y = pk2(v.z, v.w);
      *(uint2*)(KAS + (size_t)(b * 544 + key) * 512 + f) = o;
      if (key >= 32) *(float4*)(p.out + O_AKS + (size_t)(b * 512 + key - 32) * 512 + f) = v;
    }
    u16* KBS = (u16*)(p.ws + WS_KBS);
#pragma unroll 4
    for (int i = gt; i < 1048576; i += gn) {
      int e = i * 4, b = e >> 19, key = (e >> 9) & 1023, f = e & 511;
      float4 v = *(const float4*)(p.cache_b_k + e);
      uint2 o; o.x = pk2(v.x, v.y); o.y = pk2(v.z, v.w);
      *(uint2*)(KBS + (size_t)(b * 1056 + key) * 512 + f) = o;
    }
    u16* VATS = (u16*)(p.ws + WS_VATS);
#pragma unroll 2
    for (int i = gt; i < 262144; i += gn) {
      int f = i & 511, kg = (i >> 9) & 63, b = i >> 15;
      float v[8];
#pragma unroll
      for (int j = 0; j < 8; ++j) v[j] = p.cache_a_v[(size_t)(b * 512 + kg * 8 + j) * 512 + f];
      uint4 o; o.x = pk2(v[0], v[1]); o.y = pk2(v[2], v[3]); o.z = pk2(v[4], v[5]); o.w = pk2(v[6], v[7]);
      *(uint4*)(VATS + (size_t)(b * 512 + f) * 544 + kg * 8) = o;
      if (kg >= 4) {
#pragma unroll
        for (int j = 0; j < 8; ++j) p.out[O_AVS + (size_t)(b * 512 + kg * 8 + j - 32) * 512 + f] = v[j];
      }
    }
    u16* VBTS = (u16*)(p.ws + WS_VBTS);
#pragma unroll 2
    for (int i = gt; i < 524288; i += gn) {
      int f = i & 511, kg = (i >> 9) & 127, b = i >> 16;
      float v[8];
#pragma unroll
      for (int j = 0; j < 8; ++j) v[j] = p.cache_b_v[(size_t)(b * 1024 + kg * 8 + j) * 512 + f];
      uint4 o; o.x = pk2(v[0], v[1]); o.y = pk2(v[2], v[3]); o.z = pk2(v[4], v[5]); o.w = pk2(v[6], v[7]);
      *(uint4*)(VBTS + (size_t)(b * 512 + f) * 1056 + kg * 8) = o;
    }
  }
  {
    float2* RT = (float2*)(p.ws + WS_ROPE);
    for (int i = gt; i < 65536; i += gn) {
      int pos = i >> 3, m = i & 7;
      float inv = powf(500000.f, -(float)m * 0.125f);
      float ang = (float)pos * inv;
      RT[i] = make_float2(cosf(ang), sinf(ang));
    }
  }
}

template <int NJ>
DI void gemm_mainloop(const u16* __restrict__ A, const u16* __restrict__ Bt, int row0, int col0, char* lds, f32x16 (&acc)[2][NJ]) {
  constexpr int STAGE = 32768 + NJ * 8192;
  int tid = threadIdx.x;
  asm volatile("" : "+v"(tid));
  const int lane = tid & 63, w = tid >> 6, wm = w >> 1, wn = w & 1;
  const int r = lane & 31, h = lane >> 5;
  const u16* pa = A + (size_t)(row0 + (tid >> 3)) * 1024 + (tid & 7) * 8;
  const u16* pb = Bt + (size_t)(col0 + (tid >> 3)) * 1024 + (tid & 7) * 8;
  const int wofs = (tid >> 3) * 128 + ((((tid & 7) ^ ((tid >> 4) & 7))) << 4);
  const int swr = (r >> 1) & 7;
#pragma unroll
  for (int i = 0; i < 2; ++i)
#pragma unroll
    for (int j = 0; j < NJ; ++j)
#pragma unroll
      for (int e = 0; e < 16; ++e) acc[i][j][e] = 0.f;
  uint4 ra[4], rb[NJ];
#define GM_ISSUE(KB)                                                                          \
  { _Pragma("unroll") for (int it = 0; it < 4; ++it) gld16(ra[it], pa + (size_t)it * 65536 + (KB) * 64); \
    _Pragma("unroll") for (int it = 0; it < NJ; ++it) gld16(rb[it], pb + (size_t)it * 65536 + (KB) * 64); }
#define GM_PARK(ST)                                                                           \
  { char* bw_ = lds + (ST) * STAGE;                                                           \
    _Pragma("unroll") for (int it = 0; it < 4; ++it) *(uint4*)(bw_ + it * 8192 + wofs) = ra[it]; \
    _Pragma("unroll") for (int it = 0; it < NJ; ++it) *(uint4*)(bw_ + 32768 + it * 8192 + wofs) = rb[it]; }
  GM_ISSUE(0)
  WAIT_VM(0);
  GM_PARK(0)
  __syncthreads();
#pragma unroll 1
  for (int kt = 0; kt < 16; ++kt) {
    if (kt + 1 < 16) GM_ISSUE(kt + 1)
    __builtin_amdgcn_sched_barrier(0);
    const char* ba = lds + (kt & 1) * STAGE;
    const char* bb = ba + 32768;
    bf16x8 hf[2][2], wf[NJ];
    {
      const int co = ((h ^ swr) << 4);
#pragma unroll
      for (int i = 0; i < 2; ++i) hf[0][i] = *(const bf16x8*)(ba + (wm * 64 + i * 32 + r) * 128 + co);
#pragma unroll
      for (int j = 0; j < NJ; ++j) wf[j] = *(const bf16x8*)(bb + (wn * 32 * NJ + j * 32 + r) * 128 + co);
    }
#pragma unroll
    for (int s = 0; s < 4; ++s) {
      const int co = (((2 * (s + 1) + h) ^ swr) << 4);
      if (s < 3) {
#pragma unroll
        for (int i = 0; i < 2; ++i) hf[(s + 1) & 1][i] = *(const bf16x8*)(ba + (wm * 64 + i * 32 + r) * 128 + co);
      }
      __builtin_amdgcn_s_setprio(1);
#pragma unroll
      for (int j = 0; j < NJ; ++j) {
        acc[0][j] = MFMA(hf[s & 1][0], wf[j], acc[0][j]);
        acc[1][j] = MFMA(hf[s & 1][1], wf[j], acc[1][j]);
        if (s < 3) wf[j] = *(const bf16x8*)(bb + (wn * 32 * NJ + j * 32 + r) * 128 + co);
      }
      __builtin_amdgcn_s_setprio(0);
      __builtin_amdgcn_sched_barrier(0);
      if (kt + 1 < 16 && s == 1) {
        asm volatile("s_waitcnt vmcnt(%0)" :: "n"(NJ) : "memory");
        char* bw_ = lds + ((kt + 1) & 1) * STAGE;
#pragma unroll
        for (int it = 0; it < 4; ++it) *(uint4*)(bw_ + it * 8192 + wofs) = ra[it];
        __builtin_amdgcn_sched_barrier(0);
      }
      if (kt + 1 < 16 && s == 2) {
        WAIT_VM(0);
        char* bw_ = lds + ((kt + 1) & 1) * STAGE;
#pragma unroll
        for (int it = 0; it < NJ; ++it) *(uint4*)(bw_ + 32768 + it * 8192 + wofs) = rb[it];
        __builtin_amdgcn_sched_barrier(0);
      }
    }
    __syncthreads();
  }
#undef GM_ISSUE
#undef GM_PARK
}

DI float silu(float x) { return x * __builtin_amdgcn_rcpf(1.f + __expf(-x)); }

DI float dpp_x1(float v) { return __int_as_float(__builtin_amdgcn_update_dpp(0, __float_as_int(v), 0xB1, 0xF, 0xF, true)); }
DI float dpp_x8(float v) { return __int_as_float(__builtin_amdgcn_update_dpp(0, __float_as_int(v), 0x128, 0xF, 0xF, true)); }
DI void store_bf16_tile(const f32x16& a, u16* base  , size_t ld, int h, int odd) {
#pragma unroll
  for (int g = 0; g < 4; ++g)
#pragma unroll
    for (int e = 0; e < 4; e += 2) {
      const float v0 = a[4 * g + e], v1 = a[4 * g + e + 1];
      const float n0 = dpp_x1(v0), n1 = dpp_x1(v1);
      const u32 o = odd ? pk2(n1, v1) : pk2(v0, n0);
      *(u32*)(base + (size_t)(8 * g + 4 * h + e + odd) * ld) = o;
      if (e == 2) __builtin_amdgcn_sched_barrier(0);
    }
}
template <int NJ, int sec>
DI void p1_tile(const Params& p, char* lds, int tm, int col0) {
  constexpr int WN = 32 * NJ;
  const u16* HN = (const u16*)(p.ws + WS_HN);
  const u16* WT = (const u16*)(p.ws + WS_WINT);
  const float2* RT = (const float2*)(p.ws + WS_ROPE);
  const int fbase = col0 & 511;
  const bool sample = (tm == 64);
  f32x16 acc[2][NJ];
  gemm_mainloop<NJ>(HN, WT, tm * 256, col0, lds, acc);
  int tid = threadIdx.x;
  asm volatile("" : "+v"(tid));
  const int lane = tid & 63, w = tid >> 6, wm = w >> 1, wn = w & 1;
  const int r = lane & 31, h = lane >> 5, odd = r & 1;
  const int tb = tm * 256 + wm * 64;
  const int fb = fbase + wn * WN;
  if (sec == 2 || sec == 6) {
#pragma unroll
    for (int i = 0; i < 2; ++i) {
      float* dbase = nullptr;
      {
        const int t0 = tb + i * 32;
        if (!sample) {
          const int b = t0 >> 13, s0 = t0 & 8191;
          if (sec == 6) dbase = p.out + O_BVP + (size_t)t0 * 512;
          else if (s0 >= 7680) dbase = p.out + O_AVP + ((size_t)(b * 512 + s0 - 7680)) * 512;
        } else {
          const int ts = t0 - NTOKP, b = ts >> 5;
          if (sec == 6) dbase = p.out + O_BVS + (size_t)ts * 512;
          else dbase = p.out + O_AVS + ((size_t)(b * 512 + 480)) * 512;
        }
      }
#pragma unroll
      for (int j = 0; j < NJ; ++j) {
        unsigned lo = (wn * WN + j * 32 + r) * 528 + (wm * 64 + i * 32 + 4 * h) * 2;
        asm volatile("" : "+v"(lo));
#pragma unroll
        for (int g = 0; g < 4; ++g) {
          const float v0 = acc[i][j][4 * g], v1 = acc[i][j][4 * g + 1], v2 = acc[i][j][4 * g + 2], v3 = acc[i][j][4 * g + 3];
          uint2 o; o.x = pk2(v0, v1); o.y = pk2(v2, v3);
          *(uint2*)(lds + lo + g * 16) = o;
          if (dbase) {
            unsigned off = (8 * g + 4 * h) * 512 + fb + j * 32 + r;
            asm volatile("" : "+v"(off));
            dbase[off] = v0; dbase[off + 512] = v1; dbase[off + 1024] = v2; dbase[off + 1536] = v3;
          }
          __builtin_amdgcn_sched_barrier(0);
        }
      }
    }
    __syncthreads();
    {
      u16* VT; size_t ldv;
      if (sec == 2) { VT = (u16*)(p.ws + (sample ? WS_VATS : WS_VAT)); ldv = sample ? 544 : 8192; }
      else { VT = (u16*)(p.ws + (sample ? WS_VBTS : WS_VBT)); ldv = sample ? 1056 : 8192; }
      const int sofs = sample ? (sec == 2 ? 512 : 1024) : 0;
#pragma unroll
      for (int it = 0; it < 4 * NJ; ++it) {
        const int id = it * 512 + tid, row = id >> 5, c = id & 31;
        const uint4 v = *(const uint4*)(lds + row * 528 + c * 16);
        const int fs = fbase + row;
        if (!sample) {
          const int t0 = tm * 256 + c * 8, b = t0 >> 13, s = t0 & 8191;
          *(uint4*)(VT + ((size_t)(b * 512 + fs)) * ldv + s) = v;
        } else {
          const int b = c >> 2, tt = (c & 3) * 8;
          *(uint4*)(VT + ((size_t)(b * 512 + fs)) * ldv + sofs + tt) = v;
        }
        if ((it & 3) == 3) __builtin_amdgcn_sched_barrier(0);
      }
    }
    __syncthreads();
  } else {
    if (sec == 4 || sec == 5) {
      const float sgn = (r & 8) ? 1.f : -1.f;
      const int pos0 = sample ? (1024 + 4 * h) : ((tb & 8191) + 4 * h);
      const float2* rt = RT + pos0 * 8 + (r & 7);
#pragma unroll
      for (int i = 0; i < 2; ++i)
#pragma unroll
        for (int g = 0; g < 4; ++g) {
          const int po = (sample ? 0 : i * 32) + 8 * g;
          float2 cs[4];
#pragma unroll
          for (int e = 0; e < 4; ++e) cs[e] = rt[(po + e) * 8];
          __builtin_amdgcn_sched_barrier(0);
#pragma unroll
          for (int j = 0; j < NJ; j += 2)
#pragma unroll
            for (int e = 0; e < 4; ++e) {
              const float x = acc[i][j][4 * g + e];
              const float xp = dpp_x8(x);
              if (r < 16) acc[i][j][4 * g + e] = x * cs[e].x + sgn * xp * cs[e].y;
            }
          __builtin_amdgcn_sched_barrier(0);
        }
    }
    if (sec == 3 || sec == 7) {
#pragma unroll
      for (int i = 0; i < 2; ++i)
#pragma unroll
        for (int j = 0; j < NJ; ++j)
#pragma unroll
          for (int e = 0; e < 16; ++e) acc[i][j][e] = silu(acc[i][j][e]);
    }
    u16* dst; size_t trow0;
    if (sec == 0) { dst = (u16*)(p.ws + WS_QA); trow0 = tb; }
    else if (sec == 3) { dst = (u16*)(p.ws + WS_GA); trow0 = tb; }
    else if (sec == 4) { dst = (u16*)(p.ws + WS_QB); trow0 = tb; }
    else if (sec == 7) { dst = (u16*)(p.ws + WS_GB); trow0 = tb; }
    else if (sec == 1) {
      if (!sample) { dst = (u16*)(p.ws + WS_KA); trow0 = tb; }
      else { dst = (u16*)(p.ws + WS_KAS); trow0 = (size_t)(wm * 2) * 544 + 512; }
    } else {
      if (!sample) { dst = (u16*)(p.ws + WS_KB); trow0 = tb; }
      else { dst = (u16*)(p.ws + WS_KBS); trow0 = (size_t)(wm * 2) * 1056 + 1024; }
    }
    const size_t istep = sample ? (sec == 1 ? 544 : (sec == 5 ? 1056 : 32)) : 32;
#pragma unroll
    for (int i = 0; i < 2; ++i)
#pragma unroll
      for (int j = 0; j < NJ; ++j)
        store_bf16_tile(acc[i][j], dst + (trow0 + i * istep) * 512 + fb + j * 32 + (r & ~1), 512, h, odd);
    if (sec == 1 || sec == 5) {
#pragma unroll
      for (int i = 0; i < 2; ++i) {
        float* d = nullptr;
        const int t0 = tb + i * 32;
        if (!sample) {
          const int b = t0 >> 13, s = t0 & 8191;
          if (sec == 5) d = p.out + O_BKP + (size_t)t0 * 512;
          else if (s >= 7680) d = p.out + O_AKP + ((size_t)(b * 512 + s - 7680)) * 512;
        } else {
          const int ts = t0 - NTOKP, b = ts >> 5;
          if (sec == 5) d = p.out + O_BKS + (size_t)ts * 512;
          else d = p.out + O_AKS + ((size_t)(b * 512 + 480)) * 512;
        }
        if (d) {
#pragma unroll
          for (int j = 0; j < NJ; ++j)
#pragma unroll
            for (int e = 0; e < 16; ++e) {
              d[(size_t)(8 * (e >> 2) + 4 * h + (e & 3)) * 512 + fb + j * 32 + r] = acc[i][j][e];
              if ((e & 3) == 3) __builtin_amdgcn_sched_barrier(0);
            }
        }
      }
    }
  }
}
template <int NJ>
DI void p1_dispatch(const Params& p, char* lds, int tm, int col0) {
  switch (col0 >> 9) {
    case 0: p1_tile<NJ, 0>(p, lds, tm, col0); break;
    case 1: p1_tile<NJ, 1>(p, lds, tm, col0); break;
    case 2: p1_tile<NJ, 2>(p, lds, tm, col0); break;
    case 3: p1_tile<NJ, 3>(p, lds, tm, col0); break;
    case 4: p1_tile<NJ, 4>(p, lds, tm, col0); break;
    case 5: p1_tile<NJ, 5>(p, lds, tm, col0); break;
    case 6: p1_tile<NJ, 6>(p, lds, tm, col0); break;
    default: p1_tile<NJ, 7>(p, lds, tm, col0); break;
  }
}
DI void phase1(const Params& p, char* lds) {
  for (int tile = blockIdx.x; tile < 1024; tile += gridDim.x) {
    const int k = tile >> 8, b = tile & 255, xcd = b & 7, idx = b >> 3;
    const int tm = 16 * k + (xcd >> 1) * 4 + (idx & 3), tn = (xcd & 1) * 8 + (idx >> 2);
    p1_dispatch<4>(p, lds, tm, tn * 256);
  }
}

constexpr float SM_C = 0.125f * 1.4426950408889634f;
template <int NQT, int DVT, bool BIAS>
DI void attn_wave(const u16* __restrict__ Q, int ldq, const u16* __restrict__ K, int ldk,
                  const u16* __restrict__ Vt, int ldv, int nkt, const float* bias_l2, int rel0,
                  f32x16 (&O)[NQT][DVT], float (&Mx)[NQT], float (&L)[NQT]) {
  const int lane = threadIdx.x & 63, r = lane & 31, h = lane >> 5;
  bf16x8 qf[NQT][4];
#pragma unroll
  for (int u = 0; u < NQT; ++u)
#pragma unroll
    for (int s = 0; s < 4; ++s) qf[u][s] = *(const bf16x8*)(Q + (size_t)(32 * u + r) * ldq + 16 * s + 8 * h);
#pragma unroll
  for (int u = 0; u < NQT; ++u) {
    Mx[u] = -INFINITY; L[u] = 0.f;
#pragma unroll
    for (int dt = 0; dt < DVT; ++dt)
#pragma unroll
      for (int e = 0; e < 16; ++e) O[u][dt][e] = 0.f;
  }
  const u16* kp = K + (size_t)rho(r) * ldk + 8 * h;
  const u16* vp = Vt + (size_t)r * ldv + 8 * h;
  bf16x8 kf[4];
#pragma unroll
  for (int s = 0; s < 4; ++s) kf[s] = *(const bf16x8*)(kp + 16 * s);
  for (int kt = 0; kt < nkt; ++kt) {
    bf16x8 vf[DVT][2];
#pragma unroll
    for (int dt = 0; dt < DVT; ++dt)
#pragma unroll
      for (int s2 = 0; s2 < 2; ++s2) vf[dt][s2] = *(const bf16x8*)(vp + (size_t)(32 * dt) * ldv + 32 * kt + 16 * s2);
    bf16x8 kn[4];
    {
      const int ktn = (kt + 1 < nkt) ? kt + 1 : kt;
#pragma unroll
      for (int s = 0; s < 4; ++s) kn[s] = *(const bf16x8*)(kp + (size_t)(32 * ktn) * ldk + 16 * s);
    }
    bf16x8 pf[NQT][2];
#pragma unroll
    for (int u = 0; u < NQT; ++u) {
      f32x16 S;
#pragma unroll
      for (int e = 0; e < 16; ++e) S[e] = 0.f;
#pragma unroll
      for (int s = 0; s < 4; ++s) S = MFMA(kf[s], qf[u][s], S);
      float t[16];
      if (BIAS) {
        const int relb = rel0 + 32 * u + r - 32 * kt - 8 * h;
        if (rel0 - 32 * kt - 31 >= 128) {
          const float bv = bias_l2[256];
#pragma unroll
          for (int e = 0; e < 16; ++e) t[e] = S[e] * SM_C + bv;
        } else {
#pragma unroll
          for (int e = 0; e < 16; ++e) {
            int rel = relb - ((e & 7) + 16 * (e >> 3));
            rel = rel < -128 ? -128 : (rel > 128 ? 128 : rel);
            t[e] = S[e] * SM_C + bias_l2[rel + 128];
          }
        }
      } else {
#pragma unroll
        for (int e = 0; e < 16; ++e) t[e] = S[e] * SM_C;
      }
      float mx = t[0];
#pragma unroll
      for (int e = 1; e < 16; ++e) mx = fmaxf(mx, t[e]);
      mx = fmaxf(mx, __shfl_xor(mx, 32));
      if (__any(mx > Mx[u] + 8.f)) {
        const float mn = fmaxf(Mx[u], mx);
        const float al = __builtin_amdgcn_exp2f(Mx[u] - mn);
        Mx[u] = mn; L[u] *= al;
#pragma unroll
        for (int dt = 0; dt < DVT; ++dt)
#pragma unroll
          for (int e = 0; e < 16; ++e) O[u][dt][e] *= al;
      }
      float ps = 0.f;
#pragma unroll
      for (int e = 0; e < 16; ++e) { t[e] = __builtin_amdgcn_exp2f(t[e] - Mx[u]); ps += t[e]; }
      L[u] += ps;
#pragma unroll
      for (int s2 = 0; s2 < 2; ++s2) {
        uint4 pk;
        pk.x = pk2(t[8 * s2], t[8 * s2 + 1]); pk.y = pk2(t[8 * s2 + 2], t[8 * s2 + 3]);
        pk.z = pk2(t[8 * s2 + 4], t[8 * s2 + 5]); pk.w = pk2(t[8 * s2 + 6], t[8 * s2 + 7]);
        pf[u][s2] = __builtin_bit_cast(bf16x8, pk);
      }
    }
#pragma unroll
    for (int u = 0; u < NQT; ++u)
#pragma unroll
      for (int dt = 0; dt < DVT; ++dt)
#pragma unroll
        for (int s2 = 0; s2 < 2; ++s2) O[u][dt] = MFMA(vf[dt][s2], pf[u][s2], O[u][dt]);
#pragma unroll
    for (int s = 0; s < 4; ++s) kf[s] = kn[s];
  }
#pragma unroll
  for (int u = 0; u < NQT; ++u) L[u] += __shfl_xor(L[u], 32);
}

template <int NQT>
DI void attnA_item(const Params& p, const u16* Q, const u16* K, const u16* Vt, int ldv, int nkt, int rel0,
                   const float* bias_l2, int tok0, int head) {
  f32x16 O[NQT][2]; float Mx[NQT], L[NQT];
  attn_wave<NQT, 2, true>(Q, 512, K, 512, Vt, ldv, nkt, bias_l2, rel0, O, Mx, L);
  const int lane = threadIdx.x & 63, r = lane & 31, h = lane >> 5;
  const u16* GA = (const u16*)(p.ws + WS_GA);
  u16* OB = (u16*)(p.ws + WS_HN);
#pragma unroll
  for (int u = 0; u < NQT; ++u) {
    const float inv = 1.f / L[u];
    const size_t tok = (size_t)(tok0 + 32 * u + r);
#pragma unroll
    for (int dt = 0; dt < 2; ++dt)
#pragma unroll
      for (int g = 0; g < 4; ++g) {
        const int dv = 32 * dt + 8 * g + 4 * h;
        const uint2 gg = *(const uint2*)(GA + tok * 512 + head * 64 + dv);
        uint2 o;
        o.x = pk2(O[u][dt][4 * g] * inv * bflo(gg.x), O[u][dt][4 * g + 1] * inv * bfhi(gg.x));
        o.y = pk2(O[u][dt][4 * g + 2] * inv * bflo(gg.y), O[u][dt][4 * g + 3] * inv * bfhi(gg.y));
        *(uint2*)(OB + tok * 1024 + head * 64 + dv) = o;
      }
  }
}

DI void attnB_epilogue(const Params& p, f32x16 (&O)[4], float Lsum, int tok0, int hb, float lam, float* xch) {
  const int lane = threadIdx.x & 63, r = lane & 31, h = lane >> 5, w = threadIdx.x >> 6, m = w >> 2, wsub = w & 3;
  const float inv = 1.f / Lsum;
  float* xw = xch + wsub * 4096 + lane;
  if (m == 1) {
    const float sc = inv * lam;
#pragma unroll
    for (int dt = 0; dt < 4; ++dt)
#pragma unroll
      for (int e = 0; e < 16; ++e) xw[(dt * 16 + e) * 64] = O[dt][e] * sc;
  }
  __syncthreads();
  if (m == 0) {
    float ss = 0.f;
#pragma unroll
    for (int dt = 0; dt < 4; ++dt)
#pragma unroll
      for (int e = 0; e < 16; ++e) { float o = O[dt][e] * inv - xw[(dt * 16 + e) * 64]; O[dt][e] = o; ss += o * o; }
    ss += __shfl_xor(ss, 32);
    const float rn = rsqrtf(ss * (1.f / 128.f) + 1e-6f) * 0.8f;
    const u16* GB = (const u16*)(p.ws + WS_GB);
    u16* OB = (u16*)(p.ws + WS_HN);
    const size_t tok = (size_t)(tok0 + r);
#pragma unroll
    for (int dt = 0; dt < 4; ++dt)
#pragma unroll
      for (int g = 0; g < 4; ++g) {
        const int dv = 32 * dt + 8 * g + 4 * h;
        const uint2 gg = *(const uint2*)(GB + tok * 512 + hb * 128 + dv);
        const float4 sg = *(const float4*)(p.subln + dv);
        uint2 o;
        o.x = pk2(O[dt][4 * g] * rn * sg.x * bflo(gg.x), O[dt][4 * g + 1] * rn * sg.y * bfhi(gg.x));
        o.y = pk2(O[dt][4 * g + 2] * rn * sg.z * bflo(gg.y), O[dt][4 * g + 3] * rn * sg.w * bfhi(gg.y));
        *(uint2*)(OB + tok * 1024 + 512 + hb * 128 + dv) = o;
      }
  }
  __syncthreads();
}

DI void attnB_item(const Params& p, const u16* Q, const u16* K, const u16* Vt, int ldv, int nkt, int tok0, int hb,
                   float lam, float* xch) {
  f32x16 O[1][4]; float Mx[1], L[1];
  attn_wave<1, 4, false>(Q, 512, K, 512, Vt, ldv, nkt, nullptr, 0, O, Mx, L);
  attnB_epilogue(p, O[0], L[0], tok0, hb, lam, xch);
}

typedef float f2 __attribute__((ext_vector_type(2)));
constexpr int BLK_V = 0, BLK_K = 65536, BLK_XCH = 0, LDS_BIAS = 147456;
DI float half_max(float v) {
  auto rr = __builtin_amdgcn_permlane32_swap(__float_as_uint(v), __float_as_uint(v), false, false);
  return fmaxf(__uint_as_float(rr[0]), __uint_as_float(rr[1]));
}
DI void attnB_block(const Params& p, int b, int hb, int qt, float lam, char* lds) {
  int tid = threadIdx.x;
  asm volatile("" : "+v"(tid));
  const int lane = tid & 63, r = lane & 31, h = lane >> 5, w = tid >> 6, m = w >> 2, wsub = w & 3;
  constexpr bool late = false;
  const int q0 = qt * 128 + wsub * 32;
  const int nt = 2 * qt + 2;
  const int my_nt = (q0 >> 6) + 1;
  uint4 qraw[4];
  {
    const u16* Q = (const u16*)(p.ws + WS_QB) + (size_t)(b * SEQ + q0 + r) * 512 + hb * 128 + m * 64 + 8 * h;
#pragma unroll
    for (int s = 0; s < 4; ++s) gld16(qraw[s], Q + 16 * s);
  }
  f32x16 O[4];
#pragma unroll
  for (int dt = 0; dt < 4; ++dt)
#pragma unroll
    for (int e = 0; e < 16; ++e) O[dt][e] = 0.f;
  float Mx = -INFINITY;
  f2 L2 = {0.f, 0.f};
  const u16* gk = (const u16*)(p.ws + WS_KB) + (size_t)(b * SEQ + (tid >> 4)) * 512 + hb * 128 + (tid & 15) * 8;
  const u16* gv = (const u16*)(p.ws + WS_VBT) + (size_t)(b * 512 + hb * 128 + (tid >> 3)) * SEQ + (tid & 7) * 8;
  const int lk = BLK_K + ((tid >> 3) & 1) * 8192 + (tid >> 4) * 128 + ((((tid & 7) ^ ((tid >> 5) & 7))) << 4);
  const int lv = BLK_V + (tid >> 3) * 128 + ((((tid & 7) ^ ((tid >> 4) & 7))) << 4);
  const int rr = rho(r);
  const int swk = (rr >> 1) & 7, swv = (r >> 1) & 7;
  uint4 sk0, sk1, sv0, sv1;
  gld16(sk0, gk); gld16(sk1, gk + (size_t)32 * 512);
  gld16(sv0, gv); gld16(sv1, gv + (size_t)64 * SEQ);
  wait_vm0();
  *(uint4*)(lds + lk) = sk0; *(uint4*)(lds + lk + 4096) = sk1;
  *(uint4*)(lds + lv) = sv0; *(uint4*)(lds + lv + 8192) = sv1;
  asm volatile("s_waitcnt lgkmcnt(0)" ::: "memory");
  gld16(sk0, gk + (size_t)64 * 512); gld16(sk1, gk + (size_t)96 * 512);
  gld16(sv0, gv + 64); gld16(sv1, gv + (size_t)64 * SEQ + 64);
  wait_vm0();
  *(uint4*)(lds + lk + 16384) = sk0; *(uint4*)(lds + lk + 16384 + 4096) = sk1;
  *(uint4*)(lds + lv + 16384) = sv0; *(uint4*)(lds + lv + 16384 + 8192) = sv1;
  bf16x8 qf[4];
#pragma unroll
  for (int s = 0; s < 4; ++s) qf[s] = __builtin_bit_cast(bf16x8, qraw[s]);
  bf16x8 pf[4];
#pragma unroll
  for (int s = 0; s < 4; ++s) pf[s] = qf[s];
  __syncthreads();
#define B_QK(T_, SA, SB)                                                                     \
  { const char* kb_ = lds + BLK_K + ((T_) & 3) * 16384 + m * 8192;                           \
    _Pragma("unroll") for (int e = 0; e < 16; ++e) { SA[e] = 0.f; SB[e] = 0.f; }             \
    bf16x8 ka_[4], kc_[4];                                                                   \
    _Pragma("unroll") for (int s = 0; s < 4; ++s) {                                          \
      const int co_ = (((2 * s + h) ^ swk) << 4);                                            \
      ka_[s] = *(const bf16x8*)(kb_ + rr * 128 + co_);                                       \
      kc_[s] = *(const bf16x8*)(kb_ + (32 + rr) * 128 + co_); }                              \
    _Pragma("unroll") for (int s = 0; s < 4; ++s) { SA = MFMA(ka_[s], qf[s], SA); SB = MFMA(kc_[s], qf[s], SB); } }
#define B_SOFTMAX(SA, SB, PF)                                                                \
  { f2 tv_[16]; const f2 cc_ = {SM_C, SM_C};                                                 \
    _Pragma("unroll") for (int e = 0; e < 8; ++e) {                                          \
      f2 a_ = {SA[2 * e], SA[2 * e + 1]}; tv_[e] = a_ * cc_;                                 \
      f2 c_ = {SB[2 * e], SB[2 * e + 1]}; tv_[8 + e] = c_ * cc_; }                           \
    float mx_ = fmaxf(tv_[0].x, tv_[0].y);                                                   \
    _Pragma("unroll") for (int e = 1; e < 16; ++e) mx_ = fmaxf(mx_, fmaxf(tv_[e].x, tv_[e].y)); \
    mx_ = half_max(mx_);                                                                     \
    if (__any(mx_ > Mx + 8.f)) {                                                             \
      const float mn_ = fmaxf(Mx, mx_);                                                      \
      const float al_ = __builtin_amdgcn_exp2f(Mx - mn_);                                    \
      Mx = mn_; L2 *= al_;                                                                   \
      _Pragma("unroll") for (int dt = 0; dt < 4; ++dt)                                       \
        _Pragma("unroll") for (int e = 0; e < 16; ++e) O[dt][e] *= al_; }                    \
    const f2 nm_ = {-Mx, -Mx};                                                               \
    _Pragma("unroll") for (int e = 0; e < 16; ++e) {                                         \
      f2 d_ = tv_[e] + nm_;                                                                  \
      d_.x = __builtin_amdgcn_exp2f(d_.x); d_.y = __builtin_amdgcn_exp2f(d_.y);              \
      L2 += d_; tv_[e] = d_; }                                                               \
    _Pragma("unroll") for (int s2 = 0; s2 < 4; ++s2) {                                       \
      uint4 pa_;                                                                             \
      pa_.x = pk2(tv_[4 * s2].x, tv_[4 * s2].y); pa_.y = pk2(tv_[4 * s2 + 1].x, tv_[4 * s2 + 1].y);         \
      pa_.z = pk2(tv_[4 * s2 + 2].x, tv_[4 * s2 + 2].y); pa_.w = pk2(tv_[4 * s2 + 3].x, tv_[4 * s2 + 3].y); \
      PF[s2] = __builtin_bit_cast(bf16x8, pa_); } }
#define B_PV(T_, PF)                                                                         \
  { const char* vb_ = lds + BLK_V + ((T_) & 3) * 16384;                                      \
    _Pragma("unroll") for (int ks = 0; ks < 4; ++ks) {                                       \
      const int co_ = (((2 * ks + h) ^ swv) << 4);                                           \
      _Pragma("unroll") for (int dt = 0; dt < 4; ++dt) {                                     \
        bf16x8 v_ = *(const bf16x8*)(vb_ + (32 * dt + r) * 128 + co_);                       \
        O[dt] = MFMA(v_, PF[ks], O[dt]); } } }
#define B_ISSUE(T_)                                                                          \
  { gld16(sk0, gk + (size_t)(64 * (T_)) * 512); gld16(sk1, gk + (size_t)(64 * (T_) + 32) * 512); \
    gld16(sv0, gv + 64 * (T_)); gld16(sv1, gv + (size_t)64 * SEQ + 64 * (T_)); }
#define B_PARK(T_)                                                                           \
  { const int sl_ = ((T_) & 3) * 16384; wait_vm0();                                          \
    *(uint4*)(lds + lk + sl_) = sk0; *(uint4*)(lds + lk + sl_ + 4096) = sk1;                 \
    *(uint4*)(lds + lv + sl_) = sv0; *(uint4*)(lds + lv + sl_ + 8192) = sv1; }
#pragma unroll 1
  for (int t = 0; t < nt; t += 2) {
    const bool two = t + 1 < my_nt;
    if (t + 2 < nt) B_ISSUE(t + 2)
    __builtin_amdgcn_sched_barrier(0);
    f32x16 Sa, Sb, Sc, Sd;
    bf16x8 pg[4];
    B_QK(t, Sa, Sb)
    if (two) B_QK(t + 1, Sc, Sd)
    B_SOFTMAX(Sa, Sb, pf)
    if (t + 2 < nt) { B_PARK(t + 2) asm volatile("s_waitcnt lgkmcnt(0)" ::: "memory"); B_ISSUE(t + 3) }
    B_PV(t, pf)
    if (two) {
      B_SOFTMAX(Sc, Sd, pg)
      B_PV(t + 1, pg)
    }
    if (t + 2 < nt) B_PARK(t + 3)
    __syncthreads();
  }
#undef B_QK
#undef B_SOFTMAX
#undef B_PV
#undef B_ISSUE
#undef B_PARK
  float L = L2.x + L2.y;
  L += __shfl_xor(L, 32);
  attnB_epilogue(p, O, L, b * SEQ + q0, hb, lam, (float*)(lds + BLK_XCH));
}

DI float phase2_setup(const Params& p, char* lds) {
  const int tid = threadIdx.x, lane = tid & 63;
  float* bias = (float*)(lds + LDS_BIAS);
  for (int i = tid; i < 8 * 257; i += 512) { int hh = i / 257, k = i - hh * 257; bias[hh * 260 + k] = p.rel_bias[i] * 1.4426950408889634f; }
  float a = p.lq1[lane] * p.lk1[lane], b = p.lq2[lane] * p.lk2[lane];
  a = wave_sum(a); b = wave_sum(b);
  __syncthreads();
  return expf(a) - expf(b) + 0.2f;
}
DI void p3_tile(const Params& p, char* lds, int tok0) {
  int tid = threadIdx.x;
  asm volatile("" : "+v"(tid));
  const int lane = tid & 63, w = tid >> 6, r = lane & 31, h = lane >> 5;
  const u16* OB = (const u16*)(p.ws + WS_HN);
  float* red = (float*)(lds + 131072);
  __syncthreads();
#pragma unroll
  for (int half = 0; half < 2; ++half) {
    uint4 a[8];
#pragma unroll
    for (int it = 0; it < 8; ++it) a[it] = *(const uint4*)(OB + (size_t)(tok0 + half * 32 + it * 4 + (tid >> 7)) * 1024 + (tid & 127) * 8);
#pragma unroll
    for (int it = 0; it < 8; ++it) {
      const int row = half * 32 + it * 4 + (tid >> 7);
      *(uint4*)(lds + row * 2048 + ((((tid & 127) ^ (row & 15))) << 4)) = a[it];
    }
  }
  f32x16 acc[2][4];
#pragma unroll
  for (int i = 0; i < 2; ++i)
#pragma unroll
    for (int j = 0; j < 4; ++j)
#pragma unroll
      for (int e = 0; e < 16; ++e) acc[i][j][e] = 0.f;
  const char* wp = p.ws + WS_WOUTT + ((size_t)(w * 4) * 4096 + lane) * 16;
  const char* ap = lds + r * 2048;
  const int akey = r & 15;
  uint4 bq[4][4];
#pragma unroll
  for (int s = 0; s < 4; ++s)
#pragma unroll
    for (int j = 0; j < 4; ++j) gld16(bq[s][j], wp + (size_t)(j * 4096 + s * 64) * 16);
  __syncthreads();
#define P3_KSTEP(KS, SLOT, WAITN, REFILL)                                                        \
  {                                                                                              \
    const int co_ = ((((2 * (KS) + h) ^ akey)) << 4);                                            \
    const bf16x8 a0_ = *(const bf16x8*)(ap + co_);                                               \
    const bf16x8 a1_ = *(const bf16x8*)(ap + 65536 + co_);                                       \
    WAIT_VM(WAITN);                                                                              \
    __builtin_amdgcn_sched_barrier(0);                                                           \
    __builtin_amdgcn_s_setprio(1);                                                               \
    _Pragma("unroll") for (int j = 0; j < 4; ++j) {                                              \
      const bf16x8 bf_ = __builtin_bit_cast(bf16x8, bq[SLOT][j]);                                \
      acc[0][j] = MFMA(a0_, bf_, acc[0][j]);                                                     \
      acc[1][j] = MFMA(a1_, bf_, acc[1][j]);                                                     \
    }                                                                                            \
    __builtin_amdgcn_s_setprio(0);                                                               \
    __builtin_amdgcn_sched_barrier(0);                                                           \
    if (REFILL) {                                                                                \
      _Pragma("unroll") for (int j = 0; j < 4; ++j) gld16(bq[SLOT][j], wp + (size_t)(j * 4096 + ((KS) + 4) * 64) * 16); \
    }                                                                                            \
    __builtin_amdgcn_sched_barrier(0);                                                           \
  }
#pragma unroll 1
  for (int g = 0; g < 15; ++g) {
    P3_KSTEP(4 * g, 0, 12, true)
    P3_KSTEP(4 * g + 1, 1, 12, true)
    P3_KSTEP(4 * g + 2, 2, 12, true)
    P3_KSTEP(4 * g + 3, 3, 12, true)
  }
  P3_KSTEP(60, 0, 12, false)
  P3_KSTEP(61, 1, 8, false)
  P3_KSTEP(62, 2, 4, false)
  P3_KSTEP(63, 3, 0, false)
  WAIT_VM(0);
  const float* xr = tok0 < NTOKP ? p.x_prompt + (size_t)tok0 * 1024 : p.x_sample + (size_t)(tok0 - NTOKP) * 1024;
  const unsigned cb = w * 128 + r;
#pragma unroll
  for (int i = 0; i < 2; ++i) {
#pragma unroll
    for (int e = 0; e < 16; ++e) {
      const int row = 32 * i + 8 * (e >> 2) + 4 * h + (e & 3);
      unsigned off = row * 1024 + cb;
      asm volatile("" : "+v"(off));
      float ssv = 0.f;
#pragma unroll
      for (int j = 0; j < 4; ++j) {
        const float y = acc[i][j][e] + xr[off + j * 32];
        acc[i][j][e] = y; ssv += y * y;
      }
      ssv += __shfl_xor(ssv, 1); ssv += __shfl_xor(ssv, 2); ssv += __shfl_xor(ssv, 4); ssv += __shfl_xor(ssv, 8); ssv += __shfl_xor(ssv, 16);
      if (r == 0) red[w * 64 + row] = ssv;
      if ((e & 3) == 3) __builtin_amdgcn_sched_barrier(0);
    }
  }
  __syncthreads();
  if (tid < 64) {
    float t = 0.f;
#pragma unroll
    for (int k = 0; k < 8; ++k) t += red[k * 64 + tid];
    red[512 + tid] = rsqrtf(t * (1.f / 1024.f) + 1e-6f);
  }
  __syncthreads();
  float* yr = p.out + O_YP + (size_t)tok0 * 1024;
  float gj[4];
#pragma unroll
  for (int j = 0; j < 4; ++j) gj[j] = p.final_gain[cb + j * 32];
#pragma unroll
  for (int i = 0; i < 2; ++i) {
#pragma unroll
    for (int e = 0; e < 16; ++e) {
      const int row = 32 * i + 8 * (e >> 2) + 4 * h + (e & 3);
      unsigned off = row * 1024 + cb;
      asm volatile("" : "+v"(off));
      const float ri = red[512 + row];
#pragma unroll
      for (int j = 0; j < 4; ++j) yr[off + j * 32] = acc[i][j][e] * ri * gj[j];
      if ((e & 3) == 3) __builtin_amdgcn_sched_barrier(0);
    }
  }
}

constexpr int NQUEUE = 14;
DI int q_pop(unsigned* ctr, int* slot) {
  __syncthreads();
  if (threadIdx.x == 0) *slot = (int)__hip_atomic_fetch_add(ctr, 1u, __ATOMIC_RELAXED, __HIP_MEMORY_SCOPE_AGENT);
  __syncthreads();
  return *slot;
}
DI void p2_all(const Params& p, char* lds, float lam) {
  const int w = threadIdx.x >> 6;
  unsigned* Q = (unsigned*)(p.ws + WS_QUEUE);
  int* slot = (int*)(lds + LDS_BIAS + 8320);
  float* xch = (float*)(lds + 65536);
  const float* bias = (const float*)(lds + LDS_BIAS);
  const u16* QA = (const u16*)(p.ws + WS_QA);
  const u16* QB = (const u16*)(p.ws + WS_QB);
  int firstp = 1;
#pragma unroll 1
  for (;;) {
    const int i = firstp ? (int)blockIdx.x : 32;
    firstp = 0;
    if (i >= 32) break;
    p1_dispatch<2>(p, lds, 64, i * 128);
    asm volatile("s_waitcnt vmcnt(0)" ::: "memory");
    __syncthreads();
    if (threadIdx.x == 0) {
      __builtin_amdgcn_fence(__ATOMIC_RELEASE, "agent");
      __hip_atomic_fetch_add(Q + 64 * 13, 1u, __ATOMIC_RELAXED, __HIP_MEMORY_SCOPE_AGENT);
    }
  }
  {
    const int it = (int)blockIdx.x - 32 >= 0 ? (int)blockIdx.x - 32 : 16;
    if (it < 16) {
      if (threadIdx.x == 0) {
        while (__hip_atomic_load(Q + 64 * 13, __ATOMIC_RELAXED, __HIP_MEMORY_SCOPE_AGENT) < 32u) __builtin_amdgcn_s_sleep(2);
        __builtin_amdgcn_fence(__ATOMIC_ACQUIRE, "agent");
      }
      __syncthreads();
    }
    if (it < 8) {
      const int m = w >> 2, wsub = w & 3, id = it * 4 + wsub, b = id >> 2, hb = id & 3;
      attnB_item(p, QB + (size_t)(NTOKP + b * 32) * 512 + hb * 128 + m * 64,
                 (const u16*)(p.ws + WS_KBS) + (size_t)(b * 1056) * 512 + hb * 128 + m * 64,
                 (const u16*)(p.ws + WS_VBTS) + (size_t)(b * 512 + hb * 128) * 1056, 1056, 33, NTOKP + b * 32, hb, lam, xch);
    } else if (it < 16) {
      const int b = it - 8;
      attnA_item<1>(p, QA + (size_t)(NTOKP + b * 32) * 512 + w * 64,
                    (const u16*)(p.ws + WS_KAS) + (size_t)(b * 544) * 512 + w * 64,
                    (const u16*)(p.ws + WS_VATS) + (size_t)(b * 512 + w * 64) * 544, 544, 17, 512, bias + w * 260,
                    NTOKP + b * 32, w);
    }
    if (it < 16) {
      asm volatile("s_waitcnt vmcnt(0)" ::: "memory");
      __syncthreads();
      if (threadIdx.x == 0) {
        __builtin_amdgcn_fence(__ATOMIC_RELEASE, "agent");
        __hip_atomic_fetch_add(Q + 64 * 11, 1u, __ATOMIC_RELAXED, __HIP_MEMORY_SCOPE_AGENT);
      }
    }
  }
  unsigned* T = (unsigned*)(p.ws + WS_QUEUE + 4096);
  bool didA = false;
  int k = 0;
#pragma unroll 1
  for (;;) {
    int i = q_pop(Q + 64 * (1 + ((blockIdx.x + k) & 7)), slot);
    if (i >= 64) { if (++k < 8) continue; i = -1; }
    if ((i < 0 || i >= 40) && !didA) {
      didA = true;
#pragma unroll 1
      for (;;) {
        const int it = q_pop(Q + 64 * 9, slot);
        if (it >= 256) break;
        const int b = it >> 7, c = it & 127, cs = c > 8 ? c - 8 : 0;
        int tl = threadIdx.x;
        asm volatile("" : "+v"(tl));
        const int ww = tl >> 6;
        attnA_item<2>(p, (const u16*)(p.ws + WS_QA) + (size_t)(b * SEQ + c * 64) * 512 + ww * 64,
                      (const u16*)(p.ws + WS_KA) + (size_t)(b * SEQ + cs * 64) * 512 + ww * 64,
                      (const u16*)(p.ws + WS_VAT) + (size_t)(b * 512 + ww * 64) * SEQ + cs * 64, SEQ,
                      (c + 1 - cs) * 2, 64 * (c - cs), (const float*)(lds + LDS_BIAS) + ww * 260, b * SEQ + c * 64, ww);
        asm volatile("s_waitcnt vmcnt(0)" ::: "memory");
        __syncthreads();
        if (threadIdx.x == 0) {
          __builtin_amdgcn_fence(__ATOMIC_RELEASE, "agent");
          __hip_atomic_fetch_add(T + it, 1u, __ATOMIC_RELAXED, __HIP_MEMORY_SCOPE_AGENT);
        }
      }
    }
    if (i < 0) break;
    const int x = (blockIdx.x + k) & 7;
    attnB_block(p, x >> 2, x & 3, 63 - i, lam, lds);
    asm volatile("s_waitcnt vmcnt(0)" ::: "memory");
    __syncthreads();
    if (threadIdx.x == 0) {
      __builtin_amdgcn_fence(__ATOMIC_RELEASE, "agent");
      unsigned* tt = T + (x >> 2) * 128 + 2 * (63 - i);
      __hip_atomic_fetch_add(tt, 1u, __ATOMIC_RELAXED, __HIP_MEMORY_SCOPE_AGENT);
      __hip_atomic_fetch_add(tt + 1, 1u, __ATOMIC_RELAXED, __HIP_MEMORY_SCOPE_AGENT);
    }
  }
#pragma unroll 1
  for (;;) {
    const int it = q_pop(Q + 64 * 10, slot);
    if (it >= 260) break;
    int tok0;
    if (threadIdx.x == 0) {
      if (it < 4) { while (__hip_atomic_load(Q + 64 * 11, __ATOMIC_RELAXED, __HIP_MEMORY_SCOPE_AGENT) < 16u) __builtin_amdgcn_s_sleep(2); }
      else { while (__hip_atomic_load(T + (259 - it), __ATOMIC_RELAXED, __HIP_MEMORY_SCOPE_AGENT) < 5u) __builtin_amdgcn_s_sleep(2); }
      __builtin_amdgcn_fence(__ATOMIC_ACQUIRE, "agent");
    }
    __syncthreads();
    if (it < 4) tok0 = NTOKP + it * 64; else tok0 = (259 - it) * 64;
    p3_tile(p, lds, tok0);
  }
}

DI void phase4(const Params& p) {
  const int lane = threadIdx.x & 63, w = threadIdx.x >> 6;
  for (int row = blockIdx.x * 8 + w; row < NTOK; row += gridDim.x * 8) {
    float* y = p.out + O_YP + (size_t)row * 1024;
    float4 v[4]; float ss = 0.f;
#pragma unroll
    for (int it = 0; it < 4; ++it) { v[it] = *(const float4*)(y + it * 256 + lane * 4); ss += v[it].x * v[it].x + v[it].y * v[it].y + v[it].z * v[it].z + v[it].w * v[it].w; }
    ss = wave_sum(ss);
    const float inv = rsqrtf(ss * (1.f / 1024.f) + 1e-6f);
#pragma unroll
    for (int it = 0; it < 4; ++it) {
      float4 g = *(const float4*)(p.final_gain + it * 256 + lane * 4);
      *(float4*)(y + it * 256 + lane * 4) = make_float4(v[it].x * inv * g.x, v[it].y * inv * g.y, v[it].z * inv * g.z, v[it].w * inv * g.w);
    }
  }
}

__global__ void __launch_bounds__(512) fwd_megakernel(Params p) {
  __shared__ __attribute__((aligned(16))) char lds[155904];
  cg::grid_group grid = cg::this_grid();
  unsigned* ctr = (unsigned*)(p.ws + WS_BAR);
  const unsigned G = gridDim.x;
  if (p.out == nullptr) grid.sync();
  phase0(p, lds);
  ctr_barrier(ctr, G);
  phase1(p, lds);
  ctr_barrier(ctr, 2 * G);
  {
    const float lam = phase2_setup(p, lds);
    p2_all(p, lds, lam);
  }
}

extern "C" void kernel_launch(void* const* d_in, const int* in_sizes, int n_in, void* d_out, int out_size, void* d_ws,
                              size_t ws_size, hipStream_t stream) {
  static int grid_blocks = 0;
  if (!grid_blocks) {
    int dev = 0, cus = 0, per_cu = 0;
    hipGetDevice(&dev);
    hipDeviceGetAttribute(&cus, hipDeviceAttributeMultiprocessorCount, dev);
    hipOccupancyMaxActiveBlocksPerMultiprocessor(&per_cu, fwd_megakernel, 512, 0);
    if (per_cu < 1) per_cu = 1;
    grid_blocks = cus;
  }
  Params p{};
  p.x_prompt = (const float*)d_in[0]; p.x_sample = (const float*)d_in[1];
  p.cache_a_k = (const float*)d_in[2]; p.cache_a_v = (const float*)d_in[3];
  p.cache_b_k = (const float*)d_in[4]; p.cache_b_v = (const float*)d_in[5];
  p.norm_gain = (const float*)d_in[6]; p.w_in = (const float*)d_in[7]; p.w_out = (const float*)d_in[8];
  p.rel_bias = (const float*)d_in[9];
  p.lq1 = (const float*)d_in[10]; p.lk1 = (const float*)d_in[11]; p.lq2 = (const float*)d_in[12]; p.lk2 = (const float*)d_in[13];
  p.subln = (const float*)d_in[14]; p.final_gain = (const float*)d_in[15];
  p.out = (float*)d_out; p.ws = (char*)d_ws;
  void* args[] = {&p};
  (void)hipMemsetAsync((char*)d_ws + WS_BAR, 0, 12288, stream);
  hipError_t e = hipLaunchCooperativeKernel((void*)fwd_megakernel, dim3(grid_blocks), dim3(512), args, 0, stream);
  if (e != hipSuccess) fprintf(stderr, "cooperative launch failed: %s (grid %d)\n", hipGetErrorString(e), grid_blocks);
}
```
